# Optimizing an MI355X kernel written in HIP

```python
import math
import jax, jax.numpy as jnp
from jax import lax
import numpy as np

D_MODEL = 2048
BATCH = 8
SEQ = 2048
DEPTH = 2

MLSTM_HEADS = 8
MLSTM_DH = 128
MLSTM_W = MLSTM_HEADS * MLSTM_DH
MLSTM_CHUNK = 64
QK_CONV = 4
NSA_HEADS = 8
NSA_KV_HEADS = 2
NSA_GROUP = NSA_HEADS // NSA_KV_HEADS
NSA_DH = 128
NSA_W = NSA_HEADS * NSA_DH
NSA_KV_W = NSA_KV_HEADS * NSA_DH
CMP_BLOCK = 32
CMP_STRIDE = 16
CMP_HIDDEN = 256
SEL_BLOCK = 64
SEL_TOPK = 16
SEL_QCHUNK = 64
WINDOW = 512
WIN_QBLOCK = 128
ROPE_THETA = 500000.0
ROPE_DIM = NSA_DH // 4
D_FF = 5632
FFN_CONV = 3
NORM_EPS = 1e-6
NEG = -1e30
FORCE_SCORE = 1e4

SPLIT_SIZES = (MLSTM_W, MLSTM_W, MLSTM_W, MLSTM_W, MLSTM_HEADS, MLSTM_HEADS,
               NSA_W, NSA_KV_W, NSA_KV_W, NSA_KV_W, NSA_KV_W, NSA_KV_W, NSA_KV_W,
               3 * NSA_HEADS)
N_IN = 4 * MLSTM_W + 2 * MLSTM_HEADS + NSA_W + 6 * NSA_KV_W + 3 * NSA_HEADS

kernel_name = "hymba_mlstm_nsa_convffn"


def rmsnorm(x, g):
    xf = x.astype(jnp.float32)
    y = xf * lax.rsqrt(jnp.mean(xf * xf, axis=-1, keepdims=True) + NORM_EPS)
    return (y * g.astype(jnp.float32)).astype(x.dtype)


def split_cols(z):
    pieces, start = [], 0
    for size in SPLIT_SIZES:
        pieces.append(z[..., start:start + size])
        start += size
    return pieces


def causal_dwconv(x, w, b):
    K, S = w.shape[0], x.shape[1]
    xp = jnp.pad(x, ((0, 0), (K - 1, 0), (0, 0)))
    y = b
    for j in range(K):
        y = y + xp[:, j:j + S] * w[j]
    return y


def rope_tables(seq):
    pos = jnp.arange(seq, dtype=jnp.float32)
    inv = ROPE_THETA ** (-jnp.arange(0, ROPE_DIM, 2, dtype=jnp.float32) / ROPE_DIM)
    ang = pos[:, None] * inv[None, :]
    return jnp.cos(ang), jnp.sin(ang)


def partial_rope(x, cos, sin):
    half = ROPE_DIM // 2
    c = cos[None, :, None, :].astype(x.dtype)
    s = sin[None, :, None, :].astype(x.dtype)
    x1, x2, rest = x[..., :half], x[..., half:ROPE_DIM], x[..., ROPE_DIM:]
    return jnp.concatenate([x1 * c - x2 * s, x2 * c + x1 * s, rest], axis=-1)


def mlstm_chunkwise(q, k, v, i_pre, f_pre):
    B, H, S, d = q.shape
    L = MLSTM_CHUNK
    nc = S // L
    qf = q.astype(jnp.float32)
    kf = k.astype(jnp.float32) * (d ** -0.5)
    vf = v.astype(jnp.float32)
    logf = jax.nn.log_sigmoid(f_pre)

    def chunks(a):
        return jnp.moveaxis(a.reshape((B, H, nc, L) + a.shape[3:]), 2, 0)

    causal = jnp.tril(jnp.ones((L, L), dtype=bool))

    def step(carry, inp):
        C, n, m = carry
        q_, k_, v_, i_, lf = inp
        b = jnp.cumsum(lf, axis=-1)
        a = b + m[..., None]
        D = b[..., :, None] - b[..., None, :] + i_[..., None, :]
        D = jnp.where(causal, D, -jnp.inf)
        m_t = jnp.maximum(a, jnp.max(D, axis=-1))
        w_inter = jnp.exp(a - m_t)
        W = jnp.exp(D - m_t[..., None])
        s_qk = jnp.einsum('bhtd,bhsd->bhts', q_, k_) * W
        num = (w_inter[..., None] * jnp.einsum('bhtd,bhvd->bhtv', q_, C)
               + jnp.einsum('bhts,bhsv->bhtv', s_qk, v_))
        den = w_inter * jnp.einsum('bhtd,bhd->bht', q_, n) + jnp.sum(s_qk, axis=-1)
        h = num / jnp.maximum(jnp.abs(den), jnp.exp(-m_t))[..., None]
        bL = b[..., -1]
        g = bL[..., None] - b + i_
        m_new = jnp.maximum(bL + m, jnp.max(g, axis=-1))
        decay = jnp.exp(bL + m - m_new)
        wk = jnp.exp(g - m_new[..., None])
        C_new = decay[..., None, None] * C + jnp.einsum('bhs,bhsv,bhsd->bhvd', wk, v_, k_)
        n_new = decay[..., None] * n + jnp.einsum('bhs,bhsd->bhd', wk, k_)
        return (C_new, n_new, m_new), h

    init = (jnp.zeros((B, H, d, d), jnp.float32), jnp.zeros((B, H, d), jnp.float32),
            jnp.zeros((B, H), jnp.float32))
    _, hc = lax.scan(step, init, (chunks(qf), chunks(kf), chunks(vf), chunks(i_pre), chunks(logf)))
    return jnp.moveaxis(hc, 0, 2).reshape(B, H, S, d)


def compress_blocks(k, pe, w1, w2):
    B, Hk, S, d = k.shape
    ncmp = (S - CMP_BLOCK) // CMP_STRIDE + 1
    idx = jnp.arange(ncmp)[:, None] * CMP_STRIDE + jnp.arange(CMP_BLOCK)[None, :]
    blk = k[:, :, idx] + pe.astype(k.dtype)
    blk = blk.reshape(B, Hk, ncmp, CMP_BLOCK * d)
    return jax.nn.gelu(blk @ w1) @ w2


def nsa_group(q, k_cmp, v_cmp, k_slc, v_slc, k_win, v_win, gate_pre,
              cmp_pe_k, cmp_pe_v, cmp_w1_k, cmp_w2_k, cmp_w1_v, cmp_w2_v):
    B, S, _, d = q.shape
    scale = d ** -0.5
    pos = jnp.arange(S)
    q5 = q.reshape(B, S, NSA_KV_HEADS, NSA_GROUP, d).transpose(0, 2, 3, 1, 4)
    heads = lambda a: a.transpose(0, 2, 1, 3)
    k_cmp, v_cmp, k_slc, v_slc, k_win, v_win = map(heads, (k_cmp, v_cmp, k_slc, v_slc, k_win, v_win))

    kc = compress_blocks(k_cmp, cmp_pe_k, cmp_w1_k, cmp_w2_k)
    vc = compress_blocks(v_cmp, cmp_pe_v, cmp_w1_v, cmp_w2_v)
    ncmp = kc.shape[2]
    block_end = jnp.arange(ncmp) * CMP_STRIDE + CMP_BLOCK - 1
    valid_c = block_end[None, :] <= pos[:, None]
    sc = jnp.einsum('bhgsd,bhcd->bhgsc', q5, kc).astype(jnp.float32) * scale
    p_cmp = jax.nn.softmax(jnp.where(valid_c, sc, NEG), axis=-1) * valid_c
    o_cmp = jnp.einsum('bhgsc,bhcd->bhgsd', p_cmp.astype(vc.dtype), vc)

    nsel = S // SEL_BLOCK
    n_top = min(SEL_TOPK, nsel)
    jb = jnp.arange(nsel)
    cstart = jnp.arange(ncmp) * CMP_STRIDE
    overlap = ((cstart[:, None] < (jb[None, :] + 1) * SEL_BLOCK)
               & (cstart[:, None] + CMP_BLOCK > jb[None, :] * SEL_BLOCK)).astype(jnp.float32)
    imp = jnp.einsum('bhgsc,cj->bhsj', p_cmp, overlap)
    cur = pos // SEL_BLOCK
    forced = (jb[None, :] == 0) | (jb[None, :] == cur[:, None]) | (jb[None, :] == cur[:, None] - 1)
    imp = jnp.where(forced, FORCE_SCORE, imp)
    imp = jnp.where(jb[None, :] <= cur[:, None], imp, -1.0)
    _, sel_idx = lax.top_k(imp, n_top)

    kb = k_slc.reshape(B, NSA_KV_HEADS, nsel, SEL_BLOCK, d)
    vb = v_slc.reshape(B, NSA_KV_HEADS, nsel, SEL_BLOCK, d)
    gather = jax.vmap(jax.vmap(lambda blocks, idx: blocks[idx]))
    QC = SEL_QCHUNK

    def sel_chunk(c):
        s0 = c * QC
        qc = lax.dynamic_slice_in_dim(q5, s0, QC, axis=3)
        ic = lax.dynamic_slice_in_dim(sel_idx, s0, QC, axis=2)
        ks = gather(kb, ic).reshape(B, NSA_KV_HEADS, QC, n_top * SEL_BLOCK, d)
        vs = gather(vb, ic).reshape(B, NSA_KV_HEADS, QC, n_top * SEL_BLOCK, d)
        kpos = (ic[..., None] * SEL_BLOCK + jnp.arange(SEL_BLOCK)).reshape(B, NSA_KV_HEADS, QC, n_top * SEL_BLOCK)
        qpos = s0 + jnp.arange(QC)
        mask = kpos <= qpos[None, None, :, None]
        s = jnp.einsum('bhgqd,bhqkd->bhgqk', qc, ks).astype(jnp.float32) * scale
        p = jax.nn.softmax(jnp.where(mask[:, :, None], s, NEG), axis=-1)
        return jnp.einsum('bhgqk,bhqkd->bhgqd', p.astype(vs.dtype), vs)

    o_slc = lax.map(sel_chunk, jnp.arange(S // QC))
    o_slc = jnp.moveaxis(o_slc, 0, 3).reshape(B, NSA_KV_HEADS, NSA_GROUP, S, d)

    QB, KW = WIN_QBLOCK, WINDOW + WIN_QBLOCK
    kp = jnp.pad(k_win, ((0, 0), (0, 0), (WINDOW, 0), (0, 0)))
    vp = jnp.pad(v_win, ((0, 0), (0, 0), (WINDOW, 0), (0, 0)))

    def win_block(c):
        s0 = c * QB
        qb = lax.dynamic_slice_in_dim(q5, s0, QB, axis=3)
        kw = lax.dynamic_slice_in_dim(kp, s0, KW, axis=2)
        vw = lax.dynamic_slice_in_dim(vp, s0, KW, axis=2)
        kpos = s0 - WINDOW + jnp.arange(KW)
        diff = (s0 + jnp.arange(QB))[:, None] - kpos[None, :]
        mask = (kpos[None, :] >= 0) & (diff >= 0) & (diff < WINDOW)
        s = jnp.einsum('bhgqd,bhkd->bhgqk', qb, kw).astype(jnp.float32) * scale
        p = jax.nn.softmax(jnp.where(mask, s, NEG), axis=-1)
        return jnp.einsum('bhgqk,bhkd->bhgqd', p.astype(vw.dtype), vw)

    o_win = lax.map(win_block, jnp.arange(S // QB))
    o_win = jnp.moveaxis(o_win, 0, 3).reshape(B, NSA_KV_HEADS, NSA_GROUP, S, d)

    g = jax.nn.sigmoid(gate_pre.astype(jnp.float32)).reshape(B, S, NSA_KV_HEADS, NSA_GROUP, 3)
    g = g.transpose(0, 2, 3, 1, 4).astype(q.dtype)
    o = g[..., 0:1] * o_cmp + g[..., 1:2] * o_slc + g[..., 2:3] * o_win
    return o.transpose(0, 3, 1, 2, 4).reshape(B, S, NSA_W)


def hybrid_mixer(h, w_in, qk_conv_w, qk_conv_b, i_bias, f_bias, mlstm_norm,
                 cmp_pe_k, cmp_pe_v, cmp_w1_k, cmp_w2_k, cmp_w1_v, cmp_w2_v,
                 nsa_norm, w_out, cos, sin):
    B, S, _ = h.shape
    (mq, mk, mv, mo, mi, mf, nq, kc, vc, ks, vs, kw, vw, ng) = split_cols(h @ w_in)

    qk = jax.nn.silu(causal_dwconv(jnp.concatenate([mq, mk], axis=-1), qk_conv_w, qk_conv_b))
    mq, mk = qk[..., :MLSTM_W], qk[..., MLSTM_W:]
    to_h = lambda a: a.reshape(B, S, MLSTM_HEADS, MLSTM_DH).transpose(0, 2, 1, 3)
    i_pre = (mi.astype(jnp.float32) + i_bias.astype(jnp.float32)).transpose(0, 2, 1)
    f_pre = (mf.astype(jnp.float32) + f_bias.astype(jnp.float32)).transpose(0, 2, 1)
    hm = mlstm_chunkwise(to_h(mq), to_h(mk), to_h(mv), i_pre, f_pre).transpose(0, 2, 1, 3)
    hm = rmsnorm(hm, mlstm_norm.reshape(MLSTM_HEADS, MLSTM_DH)).reshape(B, S, MLSTM_W)
    mix_a = hm.astype(h.dtype) * jax.nn.sigmoid(mo)

    q = partial_rope(nq.reshape(B, S, NSA_HEADS, NSA_DH), cos, sin)
    kv = lambda a: a.reshape(B, S, NSA_KV_HEADS, NSA_DH)
    rk = lambda a: partial_rope(kv(a), cos, sin)
    mix_b = nsa_group(q, rk(kc), kv(vc), rk(ks), kv(vs), rk(kw), kv(vw), ng,
                      cmp_pe_k, cmp_pe_v, cmp_w1_k, cmp_w2_k, cmp_w1_v, cmp_w2_v)
    mix_b = rmsnorm(mix_b, nsa_norm)

    return jnp.concatenate([mix_a, mix_b], axis=-1) @ w_out


def conv_gated_mlp(h, w_up, conv_w, conv_b, w_down):
    u = causal_dwconv(h @ w_up, conv_w, conv_b)
    gate, up = u[..., :D_FF], u[..., D_FF:]
    return (jax.nn.silu(gate) * up) @ w_down


def setup_inputs(seed: int = 0) -> dict:
    key = jax.random.key(seed)
    ks = jax.random.split(key, 32)
    f32 = jnp.float32
    nrm = lambda k, shape, fan_in: jax.random.normal(k, shape, f32) * (fan_in ** -0.5)
    gain = lambda k, shape: 1.0 + 0.02 * jax.random.normal(k, shape, f32)
    small = lambda k, shape, s: s * jax.random.normal(k, shape, f32)
    return {
        "x": jax.random.normal(ks[0], (BATCH, SEQ, D_MODEL), f32),
        "attn_norm": gain(ks[1], (DEPTH, D_MODEL)),
        "w_in": nrm(ks[2], (DEPTH, D_MODEL, N_IN), D_MODEL),
        "qk_conv_w": nrm(ks[3], (DEPTH, QK_CONV, 2 * MLSTM_W), QK_CONV),
        "qk_conv_b": small(ks[4], (DEPTH, 2 * MLSTM_W), 0.02),
        "i_bias": small(ks[5], (DEPTH, MLSTM_HEADS), 0.1),
        "f_bias": 3.0 + 3.0 * jax.random.uniform(ks[6], (DEPTH, MLSTM_HEADS), f32),
        "mlstm_norm": gain(ks[7], (DEPTH, MLSTM_W)),
        "cmp_pe_k": small(ks[8], (DEPTH, CMP_BLOCK, NSA_DH), 0.1),
        "cmp_pe_v": small(ks[9], (DEPTH, CMP_BLOCK, NSA_DH), 0.1),
        "cmp_w1_k": nrm(ks[10], (DEPTH, CMP_BLOCK * NSA_DH, CMP_HIDDEN), CMP_BLOCK * NSA_DH),
        "cmp_w2_k": nrm(ks[11], (DEPTH, CMP_HIDDEN, NSA_DH), CMP_HIDDEN),
        "cmp_w1_v": nrm(ks[12], (DEPTH, CMP_BLOCK * NSA_DH, CMP_HIDDEN), CMP_BLOCK * NSA_DH),
        "cmp_w2_v": nrm(ks[13], (DEPTH, CMP_HIDDEN, NSA_DH), CMP_HIDDEN),
        "nsa_norm": gain(ks[14], (DEPTH, NSA_W)),
        "w_out": nrm(ks[15], (DEPTH, D_MODEL, D_MODEL), D_MODEL),
        "ffn_norm": gain(ks[16], (DEPTH, D_MODEL)),
        "w_up": nrm(ks[17], (DEPTH, D_MODEL, 2 * D_FF), D_MODEL),
        "ffn_conv_w": nrm(ks[18], (DEPTH, FFN_CONV, 2 * D_FF), FFN_CONV),
        "ffn_conv_b": small(ks[19], (DEPTH, 2 * D_FF), 0.02),
        "w_down": nrm(ks[20], (DEPTH, D_FF, D_MODEL), D_FF),
        "final_norm": gain(ks[21], (D_MODEL,)),
    }


def reference(x, attn_norm, w_in, qk_conv_w, qk_conv_b, i_bias, f_bias, mlstm_norm,
              cmp_pe_k, cmp_pe_v, cmp_w1_k, cmp_w2_k, cmp_w1_v, cmp_w2_v, nsa_norm,
              w_out, ffn_norm, w_up, ffn_conv_w, ffn_conv_b, w_down, final_norm):
    cos, sin = rope_tables(x.shape[1])
    for l in range(DEPTH):
        h = rmsnorm(x, attn_norm[l])
        x = x + hybrid_mixer(h, w_in[l], qk_conv_w[l], qk_conv_b[l], i_bias[l], f_bias[l],
                             mlstm_norm[l], cmp_pe_k[l], cmp_pe_v[l], cmp_w1_k[l], cmp_w2_k[l],
                             cmp_w1_v[l], cmp_w2_v[l], nsa_norm[l], w_out[l], cos, sin)
        h = rmsnorm(x, ffn_norm[l])
        x = x + conv_gated_mlp(h, w_up[l], ffn_conv_w[l], ffn_conv_b[l], w_down[l])
    return rmsnorm(x, final_norm)
```

```cpp
#include <hip/hip_runtime.h>
#include <cstdio>
#include <cstdint>
#ifndef CONV_TAIL
#define CONV_TAIL 5
#endif
#ifndef PROBE_DUP
#define PROBE_DUP -1
#endif
namespace pg8 {
#define PG8_LAS __attribute__((address_space(3)))
typedef unsigned short bf16_t;
typedef short bf16x8 __attribute__((ext_vector_type(8)));
typedef float f32x4 __attribute__((ext_vector_type(4)));
typedef unsigned u32x4 __attribute__((ext_vector_type(4)));
constexpr int BM = 256, BK = 64, HALF = 128, HTB = HALF * BK * 2  , STAGE_BYTES = 8 * HTB, NXCD = 8, WGM = 8;

__host__ __device__ __forceinline__ int lds_byte(int r, int c) { const int st = (r >> 4) * 2 + (c >> 5), rr = r & 15, cc = c & 31, ob = rr * 64 + cc * 2; return st * 1024 + (ob ^ (((ob >> 9) & 1) << 5)); }
__host__ __device__ __forceinline__ void stage_rc(int b, int& R, int& C) { const int st = b / 1024, sb = b % 1024, swz = sb ^ (((sb >> 9) & 1) << 5); R = (st >> 1) * 16 + swz / 64; C = (st & 1) * 32 + (swz % 64) / 2; }
__host__ __device__ __forceinline__ int perm32(int rho) { const int n = rho >> 4, i = rho & 15; return 8 * (i >> 2) + 4 * n + (i & 3); }

struct Unit { int pm, pn; };
struct Gemm { const bf16_t* A; const bf16_t* Bt; int M, N, K; };

struct StaticOrder {
    int nM, nN, nwg, G, c;
    __host__ __device__ void init(int M, int N, int G_, int c_) { nM = M / BM; nN = N / BM; nwg = nM * nN; G = G_; c = c_; }
    __host__ __device__ bool next(int i, Unit& u) const {
        const long L = (long)i * G + c; if (L >= nwg) return false;
        int wgid = (int)L; { const int q = nwg / NXCD, r = nwg % NXCD, xcd = wgid % NXCD, off = wgid / NXCD; wgid = (xcd < r ? xcd * (q + 1) : r * (q + 1) + (xcd - r) * q) + off; }
        const int nig = WGM * nN, gid = wgid / nig, fm = gid * WGM, gsz = (nM - fm) < WGM ? (nM - fm) : WGM;
        u.pm = fm + ((wgid % nig) % gsz); u.pn = (wgid % nig) / gsz; return true;
    }
    __device__ __forceinline__ void a_ready(const Unit&) const {}
    __device__ __forceinline__ void done(const Unit&) const {}
};

__device__ __forceinline__ unsigned cvt_pk_bf16(float lo, float hi) { unsigned r; asm volatile("v_cvt_pk_bf16_f32 %0, %1, %2" : "=v"(r) : "v"(lo), "v"(hi)); return r; }
typedef float f32x2 __attribute__((ext_vector_type(2)));
typedef int i32x4 __attribute__((ext_vector_type(4)));
typedef int i32x8 __attribute__((ext_vector_type(8)));
constexpr float F8_GS = 8.f, F8_WS = 64.f;
__device__ __forceinline__ unsigned pk4_fp8(float a, float b, float c, float d) {
    a = __builtin_amdgcn_fmed3f(a, -448.f, 448.f); b = __builtin_amdgcn_fmed3f(b, -448.f, 448.f); c = __builtin_amdgcn_fmed3f(c, -448.f, 448.f); d = __builtin_amdgcn_fmed3f(d, -448.f, 448.f);
    unsigned w; asm volatile("v_cvt_pk_fp8_f32 %0, %1, %2\n\tv_cvt_pk_fp8_f32 %0, %3, %4 op_sel:[0,0,1]" : "=&v"(w) : "v"(a), "v"(b), "v"(c), "v"(d)); return w; }
__device__ __forceinline__ f32x2 gelu_pk(f32x2 v) {
    const f32x2 av = __builtin_elementwise_abs(v), d = av * 0.2316418882f + 1.0f;
    f32x2 t; t.x = __builtin_amdgcn_rcpf(d.x); t.y = __builtin_amdgcn_rcpf(d.y);
    f32x2 q = t * 0.5307027145f + (-0.7265760135f); q = q * t + 0.7107068705f; q = q * t + (-0.142248368f); q = q * t + 0.127414796f; q = q * t;
    const f32x2 s = (v * v) * (-0.72134752044f);
    f32x2 e; e.x = __builtin_amdgcn_exp2f(s.x); e.y = __builtin_amdgcn_exp2f(s.y);
    const f32x2 m = v * (q * e), r = v - m;
    f32x2 o; o.x = v.x < 0.f ? m.x : r.x; o.y = v.y < 0.f ? m.y : r.y; return o;
}

constexpr int RS_OFF = STAGE_BYTES;
struct RowScale {
    const float* part; float inv_n, eps;
    __device__ __forceinline__ void begin(const Unit& u, int slot, int tid, PG8_LAS unsigned char* lds) const {
        if (part != nullptr && tid < BM) { const f32x4* p = (const f32x4*)(part + (size_t)(u.pm * BM + tid) * 64); float s = 0.f;
#pragma unroll
            for (int j = 0; j < 16; ++j) { const f32x4 v = p[j]; s += (v[0] + v[1]) + (v[2] + v[3]); }
            ((PG8_LAS float*)(lds + RS_OFF))[slot * BM + tid] = 1.0f / sqrtf(s * inv_n + eps); }
    }
    __device__ __forceinline__ float get(PG8_LAS unsigned char* lds, int slot, int r) const { return part != nullptr ? ((const PG8_LAS float*)(lds + RS_OFF))[slot * BM + r] : 1.f; }
};
template <int ACT  > struct EpiBf16 {
    static constexpr bool PERM = true, AFTER_DRAIN = false; static_assert(ACT == 0 || ACT == 1, "EpiBf16: ACT is 0 (none) or 1 (gelu_pk)");
    bf16_t* O; int ldc; const float* bias; int split_cols; size_t split_stride; float scale0;
    RowScale rsc;
    __device__ __forceinline__ void begin(const Unit& u, int slot, int tid, PG8_LAS unsigned char* lds) const { rsc.begin(u, slot, tid, lds); }
    const float* rc; const float* rs; unsigned rmask; int posmask;
    static __device__ __forceinline__ float other32(float v, bool hi) { auto rr = __builtin_amdgcn_permlane32_swap(__builtin_bit_cast(unsigned, v), __builtin_bit_cast(unsigned, v), false, false); return __builtin_bit_cast(float, hi ? rr[0] : rr[1]); }
    __device__ __forceinline__ void operator()(const f32x4 (&acc)[2][2][4][2], const Unit& u, int wr, int wc, int fr, int fq, PG8_LAS unsigned char* lds, int slot) const {
        const int row0 = u.pm * BM + wr * 64 + fr; int colt = u.pn * BM; bf16_t* base = O;
        float sc = 1.f; if (split_cols) { const int t = colt / split_cols; base += (size_t)t * split_stride; colt -= t * split_cols; if (t == 0) sc = scale0; }
        const int col0 = colt + wc * 32 + 8 * fq, bcol0 = u.pn * BM + wc * 32 + 8 * fq;
        const bool do_rope = rc != nullptr && wc == 0 && ((rmask >> u.pn) & 1u);
        f32x4 bv[2][2];
#pragma unroll
        for (int bj = 0; bj < 2; ++bj)
#pragma unroll
            for (int n = 0; n < 2; ++n) bv[bj][n] = bias ? *(const f32x4*)(bias + bcol0 + bj * HALF + 4 * n) : (f32x4){0.f, 0.f, 0.f, 0.f};
#pragma unroll
        for (int ai = 0; ai < 2; ++ai)
#pragma unroll
            for (int m = 0; m < 4; ++m) { bf16_t* rowp = base + (size_t)(row0 + ai * HALF + m * 16) * ldc + col0;
                f32x4 c0 = {1.f, 1.f, 1.f, 1.f}, c1 = c0, s0 = {0.f, 0.f, 0.f, 0.f}, s1 = s0;
                if (do_rope) { const int pos = (row0 + ai * HALF + m * 16) & posmask; const float* tc = rc + pos * 16 + 8 * (fq & 1); const float* ts = rs + pos * 16 + 8 * (fq & 1);
                    c0 = *(const f32x4*)tc; c1 = *(const f32x4*)(tc + 4); s0 = *(const f32x4*)ts; s1 = *(const f32x4*)(ts + 4); if (fq < 2) { s0 = -s0; s1 = -s1; } }
                const float rsv = rsc.get(lds, slot, ai * HALF + wr * 64 + m * 16 + fr);
#pragma unroll
                for (int bj = 0; bj < 2; ++bj) { f32x4 v0 = (acc[ai][bj][m][0] + bv[bj][0]) * rsv, v1 = (acc[ai][bj][m][1] + bv[bj][1]) * rsv;
                    if (do_rope) {
#pragma unroll
                        for (int i = 0; i < 4; ++i) { const float p0 = other32(v0[i], fq >= 2), p1 = other32(v1[i], fq >= 2); v0[i] = v0[i] * c0[i] + p0 * s0[i]; v1[i] = v1[i] * c1[i] + p1 * s1[i]; } }
                    if (ACT == 1) { f32x2 a = gelu_pk((f32x2){v0[0], v0[1]}), b = gelu_pk((f32x2){v0[2], v0[3]}), c = gelu_pk((f32x2){v1[0], v1[1]}), d = gelu_pk((f32x2){v1[2], v1[3]});
                        v0 = (f32x4){a.x, a.y, b.x, b.y}; v1 = (f32x4){c.x, c.y, d.x, d.y}; }
                    v0 = v0 * sc; v1 = v1 * sc; u32x4 w; w.x = cvt_pk_bf16(v0[0], v0[1]); w.y = cvt_pk_bf16(v0[2], v0[3]); w.z = cvt_pk_bf16(v1[0], v1[1]); w.w = cvt_pk_bf16(v1[2], v1[3]);
                    *(u32x4*)(rowp + bj * HALF) = w; } }
    }
};
template <bool RF32, bool SC = false> struct EpiRes {
    static constexpr bool PERM = true, AFTER_DRAIN = false;
    bf16_t* X; const void* R; int ldc; float* SSQP; float osc = 1.f;
    const float* hssq = nullptr; int hM = 0;
    __device__ __forceinline__ void begin(const Unit& u, int slot, int tid, PG8_LAS unsigned char* lds) const {
        if (hssq != nullptr && tid < BM) { const float* p = hssq + u.pm * BM + tid; float s = 0.f;
#pragma unroll
            for (int h = 0; h < 8; ++h) s += p[(size_t)h * hM];
            ((PG8_LAS float*)(lds + RS_OFF))[slot * BM + tid] = 1.0f / sqrtf(s * (1.f / 1024.f) + 1e-6f); } }
    __device__ __forceinline__ void mid(f32x4 (&acc)[2][2][4][2], int wr, int fr, PG8_LAS unsigned char* lds, int slot) const {
#pragma unroll
        for (int ai = 0; ai < 2; ++ai)
#pragma unroll
            for (int m = 0; m < 4; ++m) { const float rs = ((const PG8_LAS float*)(lds + RS_OFF))[slot * BM + ai * HALF + wr * 64 + m * 16 + fr];
#pragma unroll
                for (int bj = 0; bj < 2; ++bj)
#pragma unroll
                    for (int n = 0; n < 2; ++n) acc[ai][bj][m][n] = acc[ai][bj][m][n] * rs; } }
    static __device__ __forceinline__ float sq8(const u32x4 w) { float s = 0.f; const unsigned a[4] = {w.x, w.y, w.z, w.w};
#pragma unroll
        for (int i = 0; i < 4; ++i) { const float lo = __builtin_bit_cast(float, a[i] << 16), hi = __builtin_bit_cast(float, a[i] & 0xffff0000u); s += lo * lo + hi * hi; } return s; }
    __device__ __forceinline__ void put_ssq(float ss, int row, const Unit& u, int wc, int fq) const {
        ss += __builtin_bit_cast(float, __builtin_amdgcn_ds_swizzle(__builtin_bit_cast(int, ss), 0x401F));
        if ((fq & 1) == 0) SSQP[(size_t)row * 64 + u.pn * 8 + wc * 2 + (fq >> 1)] = ss; }
    __device__ __forceinline__ void operator()(const f32x4 (&acc)[2][2][4][2], const Unit& u, int wr, int wc, int fr, int fq, PG8_LAS unsigned char* lds, int slot) const {
        const int row0 = u.pm * BM + wr * 64 + fr, col0 = u.pn * BM + wc * 32 + 8 * fq;
#pragma unroll
        for (int ai = 0; ai < 2; ++ai) {
            if constexpr (RF32) {
                f32x4 rv[4][2][2];
#pragma unroll
                for (int m = 0; m < 4; ++m) { const size_t off = (size_t)(row0 + ai * HALF + m * 16) * ldc + col0;
#pragma unroll
                    for (int bj = 0; bj < 2; ++bj)
#pragma unroll
                        for (int n = 0; n < 2; ++n) rv[m][bj][n] = *(const f32x4*)((const float*)R + off + bj * HALF + n * 4); }
#pragma unroll
                for (int m = 0; m < 4; ++m) { const size_t off = (size_t)(row0 + ai * HALF + m * 16) * ldc + col0; float ss = 0.f;
#pragma unroll
                    for (int bj = 0; bj < 2; ++bj) { const f32x4 v0 = acc[ai][bj][m][0] + rv[m][bj][0], v1 = acc[ai][bj][m][1] + rv[m][bj][1];
                        u32x4 w; w.x = cvt_pk_bf16(v0[0], v0[1]); w.y = cvt_pk_bf16(v0[2], v0[3]); w.z = cvt_pk_bf16(v1[0], v1[1]); w.w = cvt_pk_bf16(v1[2], v1[3]);
                        ss += sq8(w); *(u32x4*)(X + off + bj * HALF) = w; }
                    put_ssq(ss, row0 + ai * HALF + m * 16, u, wc, fq); }
            } else {
                u32x4 rv[4][2];
#pragma unroll
                for (int m = 0; m < 4; ++m) { const size_t off = (size_t)(row0 + ai * HALF + m * 16) * ldc + col0;
#pragma unroll
                    for (int bj = 0; bj < 2; ++bj) rv[m][bj] = *(const u32x4*)((const bf16_t*)R + off + bj * HALF); }
#pragma unroll
                for (int m = 0; m < 4; ++m) { const size_t off = (size_t)(row0 + ai * HALF + m * 16) * ldc + col0; float ss = 0.f;
#pragma unroll
                    for (int bj = 0; bj < 2; ++bj) { const u32x4 r = rv[m][bj];
                        const f32x4 r0 = (f32x4){__builtin_bit_cast(float, r.x << 16), __builtin_bit_cast(float, r.x & 0xffff0000u), __builtin_bit_cast(float, r.y << 16), __builtin_bit_cast(float, r.y & 0xffff0000u)};
                        const f32x4 r1 = (f32x4){__builtin_bit_cast(float, r.z << 16), __builtin_bit_cast(float, r.z & 0xffff0000u), __builtin_bit_cast(float, r.w << 16), __builtin_bit_cast(float, r.w & 0xffff0000u)};
                        const f32x4 v0 = SC ? acc[ai][bj][m][0] * osc + r0 : acc[ai][bj][m][0] + r0, v1 = SC ? acc[ai][bj][m][1] * osc + r1 : acc[ai][bj][m][1] + r1;
                        u32x4 w; w.x = cvt_pk_bf16(v0[0], v0[1]); w.y = cvt_pk_bf16(v0[2], v0[3]); w.z = cvt_pk_bf16(v1[0], v1[1]); w.w = cvt_pk_bf16(v1[2], v1[3]);
                        ss += sq8(w); *(u32x4*)(X + off + bj * HALF) = w; }
                    put_ssq(ss, row0 + ai * HALF + m * 16, u, wc, fq); }
            }
            asm volatile("" ::: "memory");
        }
    }
};

struct EpiGate {
    static constexpr bool PERM = true, AFTER_DRAIN = false;
    RowScale rsc;
    __device__ __forceinline__ void begin(const Unit& u, int slot, int tid, PG8_LAS unsigned char* lds) const { rsc.begin(u, slot, tid, lds); }
    bf16_t* G; int ldg; const float* cw; const float* cb; int dff; bf16_t* edge;
    __device__ __forceinline__ void operator()(const f32x4 (&acc)[2][2][4][2], const Unit& u, int wr, int wc, int fr, int fq, PG8_LAS unsigned char* lds, int slot) const {
        const int f0 = u.pn * 128 + wc * 32 + 8 * fq;
        const float m0 = fr == 0 ? 1.f : 0.f, m01 = fr < 2 ? 1.f : 0.f;
#define PG8_DPP(v, ctrl) __builtin_bit_cast(float, __builtin_amdgcn_update_dpp(0, __builtin_bit_cast(int, (v)), (ctrl), 0xf, 0xf, true))
#pragma unroll
        for (int ai = 0; ai < 2; ++ai) {
            const int rowb = u.pm * BM + ai * HALF + wr * 64;
            unsigned og[4][2];
            float rsv[4];
#pragma unroll
            for (int m = 0; m < 4; ++m) rsv[m] = rsc.get(lds, slot, ai * HALF + wr * 64 + 16 * m + fr);
#pragma unroll
            for (int n = 0; n < 2; ++n) {
                const float* pw = cw + f0 + 4 * n; const float* pb = cb + f0 + 4 * n;
                const f32x4 g0 = *(const f32x4*)pw, g1 = *(const f32x4*)(pw + 2 * dff), g2 = *(const f32x4*)(pw + 4 * dff), gb = *(const f32x4*)pb;
                const f32x4 u0 = *(const f32x4*)(pw + dff), u1 = *(const f32x4*)(pw + 3 * dff), u2 = *(const f32x4*)(pw + 5 * dff), ub = *(const f32x4*)(pb + dff);
#pragma unroll
                for (int m = 0; m < 4; ++m) {
                    float yo[4];
#pragma unroll
                    for (int i = 0; i < 4; ++i) {
                        const float xg = acc[ai][0][m][n][i] * rsv[m], xu = acc[ai][1][m][n][i] * rsv[m];
                        float yg = gb[i] + g2[i] * xg + g1[i] * PG8_DPP(xg, 0x111) + g0[i] * PG8_DPP(xg, 0x112);
                        float yu = ub[i] + u2[i] * xu + u1[i] * PG8_DPP(xu, 0x111) + u0[i] * PG8_DPP(xu, 0x112);
                        if (m > 0) { const float pg = acc[ai][0][m - 1][n][i] * rsv[m - 1], pu = acc[ai][1][m - 1][n][i] * rsv[m - 1];
                            yg += (g1[i] * m0) * PG8_DPP(pg, 0x121) + (g0[i] * m01) * PG8_DPP(pg, 0x122);
                            yu += (u1[i] * m0) * PG8_DPP(pu, 0x121) + (u0[i] * m01) * PG8_DPP(pu, 0x122); }
                        const float sg = yg * __builtin_amdgcn_rcpf(1.f + __builtin_amdgcn_exp2f(-1.4426950408889634f * yg));
                        yo[i] = sg * yu;
                    }
                    og[m][n] = pk4_fp8(yo[0] * F8_GS, yo[1] * F8_GS, yo[2] * F8_GS, yo[3] * F8_GS);
                }
            }
#pragma unroll
            for (int m = 0; m < 4; ++m) {
                if (m > 0 || fr >= 2) { unsigned long long w = (unsigned long long)og[m][0] | ((unsigned long long)og[m][1] << 32); *(unsigned long long*)((unsigned char*)G + (size_t)(rowb + 16 * m + fr) * ldg + f0) = w; }
            }
            if (fr < 2 || fr >= 14) { const int m = fr < 2 ? 0 : 3, e = fr < 2 ? fr : fr - 12;
                bf16_t* ep = edge + ((size_t)(rowb >> 6) * 4 + e) * (2 * dff) + f0;
                u32x4 wg, wu;
                if (fr < 2) { wg.x = cvt_pk_bf16((acc[ai][0][0][0][0] * rsv[0]), (acc[ai][0][0][0][1] * rsv[0])); wg.y = cvt_pk_bf16((acc[ai][0][0][0][2] * rsv[0]), (acc[ai][0][0][0][3] * rsv[0])); wg.z = cvt_pk_bf16((acc[ai][0][0][1][0] * rsv[0]), (acc[ai][0][0][1][1] * rsv[0])); wg.w = cvt_pk_bf16((acc[ai][0][0][1][2] * rsv[0]), (acc[ai][0][0][1][3] * rsv[0]));
                              wu.x = cvt_pk_bf16((acc[ai][1][0][0][0] * rsv[0]), (acc[ai][1][0][0][1] * rsv[0])); wu.y = cvt_pk_bf16((acc[ai][1][0][0][2] * rsv[0]), (acc[ai][1][0][0][3] * rsv[0])); wu.z = cvt_pk_bf16((acc[ai][1][0][1][0] * rsv[0]), (acc[ai][1][0][1][1] * rsv[0])); wu.w = cvt_pk_bf16((acc[ai][1][0][1][2] * rsv[0]), (acc[ai][1][0][1][3] * rsv[0])); }
                else {        wg.x = cvt_pk_bf16((acc[ai][0][3][0][0] * rsv[3]), (acc[ai][0][3][0][1] * rsv[3])); wg.y = cvt_pk_bf16((acc[ai][0][3][0][2] * rsv[3]), (acc[ai][0][3][0][3] * rsv[3])); wg.z = cvt_pk_bf16((acc[ai][0][3][1][0] * rsv[3]), (acc[ai][0][3][1][1] * rsv[3])); wg.w = cvt_pk_bf16((acc[ai][0][3][1][2] * rsv[3]), (acc[ai][0][3][1][3] * rsv[3]));
                              wu.x = cvt_pk_bf16((acc[ai][1][3][0][0] * rsv[3]), (acc[ai][1][3][0][1] * rsv[3])); wu.y = cvt_pk_bf16((acc[ai][1][3][0][2] * rsv[3]), (acc[ai][1][3][0][3] * rsv[3])); wu.z = cvt_pk_bf16((acc[ai][1][3][1][0] * rsv[3]), (acc[ai][1][3][1][1] * rsv[3])); wu.w = cvt_pk_bf16((acc[ai][1][3][1][2] * rsv[3]), (acc[ai][1][3][1][3] * rsv[3])); }
                (void)m; *(u32x4*)ep = wg; *(u32x4*)(ep + dff) = wu; }
        }
#undef PG8_DPP
    }
};

template <bool F8> struct Frag;
template <> struct Frag<false> { bf16x8 k[2]; __device__ __forceinline__ void ld(int i, const PG8_LAS unsigned char* p) { k[i] = *(const PG8_LAS bf16x8*)p; } };
template <> struct Frag<true> { i32x8 v; __device__ __forceinline__ void ld(int i, const PG8_LAS unsigned char* p) { if (i == 0) v.lo = *(const PG8_LAS i32x4*)p; else v.hi = *(const PG8_LAS i32x4*)p; } };
template <class Epi, class Sched, bool ALIGN_EPI = false, bool SP2 = false, bool F8 = false, bool KROT = false>
__device__ __forceinline__ void gemm_phase(PG8_LAS unsigned char* lds, const Gemm g, const Sched& S, const Epi& E, const int wave_id) {
    int lane_ = (int)__builtin_amdgcn_mbcnt_hi(~0u, __builtin_amdgcn_mbcnt_lo(~0u, 0u)); asm volatile("" : "+v"(lane_));
    const int tid = wave_id * 64 + lane_, wid = __builtin_amdgcn_readfirstlane(tid >> 6), lane = tid & 63, wr = wid >> 2, wc = wid & 3, fr = lane & 15, fq = lane >> 4;
    const int K = g.K, nt = K / BK;
    unsigned voffA[2], voffB[2];
#pragma unroll
    for (int i = 0; i < 2; ++i) { int R, C; stage_rc(tid * 16 + i * 8192, R, C); const int Rb = Epi::PERM ? ((R & ~31) + perm32(R & 31)) : R;
        voffA[i] = (unsigned)(R * K + C) * 2u; voffB[i] = (unsigned)(Rb * K + C) * 2u; }
    const size_t kstep = (size_t)(BK * 2);
    const size_t rot = KROT ? (size_t)(nt / 2) * kstep : 0;
#define PG8_KO(t) (KROT ? (size_t)(((t) + nt / 2) & (nt - 1)) * kstep : (size_t)(t) * kstep)
    const size_t hstep = (size_t)HALF * K * 2;
    const size_t tstep = 2 * hstep;
    const unsigned ldsw = (unsigned)wid * 1024u;
    const int aoff = lds_byte(wr * 64 + fr, fq * 8), boff = lds_byte(wc * 32 + fr, fq * 8);
#define PG8_SA(b, h) (((b) * 2 + (h)) * HTB)
#define PG8_SB(b, h) ((4 + (b) * 2 + (h)) * HTB)
#define PG8_STAGE(bufoff, gbase, voff) do { _Pragma("unroll") for (int _i = 0; _i < 2; ++_i) \
        __builtin_amdgcn_global_load_lds((const unsigned*)((const char*)(gbase) + (voff)[_i]), (PG8_LAS unsigned*)(lds + (bufoff) + ldsw + _i * 8192), 16, 0, 0); } while (0)
#define PG8_LDA(dst, b, h) do { _Pragma("unroll") for (int m = 0; m < 4; ++m) _Pragma("unroll") for (int k = 0; k < 2; ++k) dst[m].ld(k, lds + PG8_SA(b, h) + aoff + m * 2048 + k * 1024); } while (0)
#define PG8_LDB(dst, b, h) do { _Pragma("unroll") for (int n = 0; n < 2; ++n) _Pragma("unroll") for (int k = 0; k < 2; ++k) dst[n].ld(k, lds + PG8_SB(b, h) + boff + n * 2048 + k * 1024); } while (0)
#define PG8_MMA(ai, bj, At, Bt) do { __builtin_amdgcn_s_setprio(1); _Pragma("unroll") for (int m = 0; m < 4; ++m) _Pragma("unroll") for (int n = 0; n < 2; ++n) { \
        if constexpr (F8) asm volatile("v_mfma_f32_16x16x128_f8f6f4 %0, %1, %2, %0" : "+v"(acc[ai][bj][m][n]) : "v"(Bt[n].v), "v"(At[m].v));         \
        else { _Pragma("unroll") for (int k = 0; k < 2; ++k) acc[ai][bj][m][n] = __builtin_amdgcn_mfma_f32_16x16x32_bf16(Bt[n].k[k], At[m].k[k], acc[ai][bj][m][n], 0, 0, 0); } } __builtin_amdgcn_s_setprio(0); } while (0)
#define PG8_WAIT_V(n) asm volatile("s_waitcnt vmcnt(" #n ")" ::: "memory")
#define PG8_WAIT_L(n) asm volatile("s_waitcnt lgkmcnt(" #n ")" ::: "memory")
#define PG8_BAR __builtin_amdgcn_s_barrier()
#define PG8_SCHED __builtin_amdgcn_sched_barrier(0)
    Unit cur, nxt; int ui = 0;
    if (!S.next(0, cur)) return;
    f32x4 acc[2][2][4][2];
#pragma unroll
    for (int a = 0; a < 2; ++a)
#pragma unroll
        for (int b = 0; b < 2; ++b)
#pragma unroll
            for (int m = 0; m < 4; ++m)
#pragma unroll
                for (int n = 0; n < 2; ++n) acc[a][b][m][n] = (f32x4){0.f, 0.f, 0.f, 0.f};
    Frag<F8> At[4], B0[2], B1[2];
    const char* cA = (const char*)g.A + (size_t)cur.pm * tstep; const char* cB = (const char*)g.Bt + (size_t)cur.pn * tstep;
    S.a_ready(cur);
    E.begin(cur, 0, tid, lds);
    if constexpr (SP2) {
        PG8_STAGE(PG8_SB(0, 0), cB + rot, voffB); PG8_STAGE(PG8_SB(0, 1), cB + rot + hstep, voffB); PG8_STAGE(PG8_SA(0, 0), cA + rot, voffA); PG8_STAGE(PG8_SA(0, 1), cA + rot + hstep, voffA);
        if (wr == 1) PG8_BAR;
        PG8_WAIT_V(2); PG8_BAR;
        PG8_STAGE(PG8_SB(1, 0), cB + rot + kstep, voffB); PG8_STAGE(PG8_SA(1, 0), cA + rot + kstep, voffA); PG8_STAGE(PG8_SB(1, 1), cB + rot + hstep + kstep, voffB);
        PG8_WAIT_V(6); PG8_BAR;
    } else {
        PG8_STAGE(PG8_SB(0, 0), cB, voffB); PG8_STAGE(PG8_SA(0, 0), cA, voffA); PG8_STAGE(PG8_SB(0, 1), cB + hstep, voffB); PG8_STAGE(PG8_SA(0, 1), cA + hstep, voffA);
        if (wr == 1) PG8_BAR;
        PG8_WAIT_V(4); PG8_BAR;
        PG8_STAGE(PG8_SB(1, 0), cB + kstep, voffB); PG8_STAGE(PG8_SA(1, 0), cA + kstep, voffA); PG8_STAGE(PG8_SB(1, 1), cB + hstep + kstep, voffB);
        PG8_WAIT_V(6); PG8_BAR;
    }
    for (;;) {
        const bool has_next = S.next(ui + 1, nxt);
        const char* nA = has_next ? (const char*)g.A + (size_t)nxt.pm * tstep : cA; const char* nB = has_next ? (const char*)g.Bt + (size_t)nxt.pn * tstep : cB;
        for (int t = 0; t < nt; t += 2) {
            const bool last = (t == nt - 2);
            const char* a1 = cA + PG8_KO(t + 1);
            const char* a2 = last ? nA + rot : cA + PG8_KO(t + 2); const char* b2 = last ? nB + rot : cB + PG8_KO(t + 2);
            const char* a3 = a2 + kstep; const char* b3 = b2 + kstep;
            if (last && has_next) S.a_ready(nxt);
            if constexpr (SP2) {
            PG8_LDB(B0, 0, 0); PG8_LDB(B1, 0, 1); PG8_SCHED; PG8_LDA(At, 0, 0); PG8_STAGE(PG8_SA(1, 1), a1 + hstep, voffA);
            PG8_WAIT_V(8); PG8_WAIT_L(0); PG8_BAR; PG8_MMA(0, 0, At, B0); PG8_MMA(0, 1, At, B1); PG8_BAR; PG8_SCHED;
            PG8_LDA(At, 0, 1); PG8_STAGE(PG8_SB(0, 0), b2, voffB); PG8_STAGE(PG8_SB(0, 1), b2 + hstep, voffB); PG8_STAGE(PG8_SA(0, 0), a2, voffA);
            PG8_WAIT_V(8); PG8_WAIT_L(0); PG8_BAR; PG8_MMA(1, 0, At, B0); PG8_MMA(1, 1, At, B1); PG8_BAR; PG8_SCHED;
            PG8_LDB(B0, 1, 0); PG8_LDB(B1, 1, 1); PG8_SCHED; PG8_LDA(At, 1, 0); PG8_STAGE(PG8_SA(0, 1), a2 + hstep, voffA);
            PG8_WAIT_V(8); PG8_WAIT_L(0); PG8_BAR; PG8_MMA(0, 0, At, B0); PG8_MMA(0, 1, At, B1); PG8_BAR; PG8_SCHED;
            PG8_LDA(At, 1, 1); PG8_STAGE(PG8_SB(1, 0), b3, voffB); PG8_STAGE(PG8_SB(1, 1), b3 + hstep, voffB); PG8_STAGE(PG8_SA(1, 0), a3, voffA);
            PG8_WAIT_V(8); PG8_WAIT_L(0); PG8_BAR; PG8_MMA(1, 0, At, B0); PG8_MMA(1, 1, At, B1); PG8_BAR; PG8_SCHED;
            } else {
            PG8_LDB(B0, 0, 0); PG8_SCHED; PG8_LDA(At, 0, 0); PG8_STAGE(PG8_SA(1, 1), a1 + hstep, voffA);
            PG8_WAIT_L(8); PG8_BAR; PG8_WAIT_L(0); PG8_MMA(0, 0, At, B0); PG8_BAR; PG8_SCHED;
            PG8_LDB(B1, 0, 1); PG8_STAGE(PG8_SB(0, 0), b2, voffB);
            PG8_BAR; PG8_WAIT_L(0); PG8_MMA(0, 1, At, B1); PG8_BAR;
            PG8_LDA(At, 0, 1); PG8_STAGE(PG8_SA(0, 0), a2, voffA);
            PG8_BAR; PG8_WAIT_L(0); PG8_MMA(1, 0, At, B0); PG8_BAR; PG8_SCHED;
            PG8_STAGE(PG8_SB(0, 1), b2 + hstep, voffB);
            PG8_WAIT_V(6); PG8_BAR; PG8_MMA(1, 1, At, B1); PG8_BAR;
            PG8_LDB(B0, 1, 0); PG8_SCHED; PG8_LDA(At, 1, 0); PG8_STAGE(PG8_SA(0, 1), a2 + hstep, voffA);
            PG8_WAIT_L(8); PG8_BAR; PG8_WAIT_L(0); PG8_MMA(0, 0, At, B0); PG8_BAR; PG8_SCHED;
            PG8_LDB(B1, 1, 1); PG8_STAGE(PG8_SB(1, 0), b3, voffB);
            PG8_BAR; PG8_WAIT_L(0); PG8_MMA(0, 1, At, B1); PG8_BAR;
            PG8_LDA(At, 1, 1); PG8_STAGE(PG8_SA(1, 0), a3, voffA);
            PG8_BAR; PG8_WAIT_L(0); PG8_MMA(1, 0, At, B0); PG8_BAR; PG8_SCHED;
            PG8_STAGE(PG8_SB(1, 1), b3 + hstep, voffB);
            PG8_WAIT_V(6); PG8_BAR; PG8_MMA(1, 1, At, B1); PG8_BAR;
            }
            if constexpr (KROT) { if (t == nt / 2 - 2) E.mid(acc, wr, fr, lds, ui & 1); }
        }
        if constexpr (ALIGN_EPI) { if (wr == 0) PG8_BAR; }
        if constexpr (F8) asm volatile("s_nop 15\n\ts_nop 15" ::: "memory");
        if (has_next) E.begin(nxt, (ui + 1) & 1, tid, lds);
        if constexpr (!Epi::AFTER_DRAIN) { int le = lane; asm volatile("" : "+v"(le));
            E(acc, cur, wr, wc, le & 15, le >> 4, lds, ui & 1); S.done(cur); }
        if (!has_next) break;
#pragma unroll
        for (int a = 0; a < 2; ++a)
#pragma unroll
            for (int b = 0; b < 2; ++b)
#pragma unroll
                for (int m = 0; m < 4; ++m)
#pragma unroll
                    for (int n = 0; n < 2; ++n) acc[a][b][m][n] = (f32x4){0.f, 0.f, 0.f, 0.f};
        cur = nxt; cA = nA; cB = nB; ++ui;
        if constexpr (ALIGN_EPI) { if (wr == 1) PG8_BAR; }
    }
    PG8_WAIT_V(0);
    if constexpr (!ALIGN_EPI) { if (wr == 0) PG8_BAR; }
    PG8_BAR;
    if constexpr (Epi::AFTER_DRAIN) { E.fused(acc, cur, wr, wc, fr, fq, lds, wid, lane); S.done(cur); }
#undef PG8_KO
#undef PG8_SA
#undef PG8_SB
#undef PG8_STAGE
#undef PG8_LDA
#undef PG8_LDB
#undef PG8_MMA
#undef PG8_WAIT_V
#undef PG8_WAIT_L
#undef PG8_BAR
#undef PG8_SCHED
}
}

#ifndef PG8_SP2
#define PG8_SP2 true
#endif
#ifndef PG8_ALIGN
#define PG8_ALIGN true
#endif
constexpr int NWAVES = 8;
#ifndef MK_PER_PHASE
#define MK_PER_PHASE 0
#endif
constexpr int D_MODEL = 2048, BATCH = 8, SEQ = 2048, DEPTH = 2, M = BATCH * SEQ;
constexpr int NCMP = 127, NSEL = 32, TOPK = 16, WINDOW = 512;
constexpr int D_FF = 5632, N_IN = 6696, ZW = 6912;
constexpr float NORM_EPS = 1e-6f;
constexpr int ZC_MQ = 0, ZC_MK = 1024, ZC_MV = 2048, ZC_MO = 3072, ZC_NQ = 4096, ZC_KC = 5120, ZC_VC = 5376, ZC_KS = 5632, ZC_VS = 5888, ZC_KW = 6144, ZC_VW = 6400, ZC_MI = 6656, ZC_MF = 6664, ZC_NG = 6672;
__host__ __device__ __forceinline__ int colmap_in(int nd) {
    if (nd < 4096) return nd; if (nd < 6656) return nd + 16; if (nd < 6672) return nd - 2560; if (nd < N_IN) return nd; return -1; }
constexpr int PH_PER_LAYER = 11, N_PHASES = DEPTH * PH_PER_LAYER + 1;

constexpr size_t MiB = 1u << 20;
constexpr size_t WS_CTL = 0, CTL_ZERO_BYTES = 1 * MiB;
constexpr size_t WS_ROPE = 1 * MiB;
constexpr size_t WS_SSQ = WS_ROPE + 512 * 1024;
constexpr size_t WS_PBP = WS_ROPE + 640 * 1024, WS_PB = WS_ROPE + 768 * 1024;
constexpr size_t WS_WIN = 2 * MiB, WS_WOUT = 29 * MiB, WS_WUP = 37 * MiB, WS_WDN = 81 * MiB;
constexpr size_t WS_C1K = 103 * MiB, WS_C1V = 105 * MiB, WS_C2K = 107 * MiB, WS_C2V = 107 * MiB + 512 * 1024;
constexpr size_t WS_XN = 108 * MiB;
constexpr size_t WS_Z = 172 * MiB;
constexpr size_t WS_MIX = 388 * MiB;
constexpr size_t WS_KCMP = 452 * MiB, WS_VCMP = 453 * MiB;
constexpr size_t WS_OACC = 456 * MiB;
constexpr size_t WS_VTS = 520 * MiB, WS_VTW = 528 * MiB;
constexpr size_t WS_G = 172 * MiB;
constexpr size_t WS_EDGE = 348 * MiB;
constexpr size_t WS_L1 = 540 * MiB;
constexpr size_t WS_PBP1 = WS_L1 + 107 * MiB;
constexpr size_t WS_SSQP = 536 * MiB;
constexpr size_t WS_XR = 576 * MiB;
constexpr size_t WS_END = 700 * MiB;
constexpr int CW_BAR = 4096;
constexpr int CW_PB = 16384;

constexpr int RING_OFF = 0, RING_BYTES = 135168;
constexpr int LDSCTL_OFF = RING_BYTES, MISC_OFF = LDSCTL_OFF + 320;
constexpr int LDS_BYTES = 147456;

#define GAS __attribute__((address_space(1)))
#define LAS __attribute__((address_space(3)))
typedef unsigned short bf16;
typedef unsigned v4u __attribute__((ext_vector_type(4)));
typedef float f32x4 __attribute__((ext_vector_type(4)));
typedef short bf16x8 __attribute__((ext_vector_type(8)));
typedef GAS unsigned gu32;
#define RLX_AGENT __ATOMIC_RELAXED, __HIP_MEMORY_SCOPE_AGENT
#define LDS_WAIT() asm volatile("s_waitcnt lgkmcnt(0)" ::: "memory")
#define VM_WAIT() asm volatile("s_waitcnt vmcnt(0)" ::: "memory")
__device__ __forceinline__ unsigned f2bf(float f) { unsigned u = __builtin_bit_cast(unsigned, f); return (u + 0x7fffu + ((u >> 16) & 1u)) >> 16; }
__device__ __forceinline__ unsigned pk2(float lo, float hi) { return f2bf(lo) | (f2bf(hi) << 16); }
typedef float f32x2t_ __attribute__((ext_vector_type(2)));
typedef __bf16 bf16x2t_ __attribute__((ext_vector_type(2)));
__device__ __forceinline__ unsigned cvtpk(float lo, float hi) { const f32x2t_ v = {lo, hi}; return __builtin_bit_cast(unsigned, __builtin_convertvector(v, bf16x2t_)); }
__device__ __forceinline__ float bf2f(bf16 v) { return __builtin_bit_cast(float, (unsigned)v << 16); }
__device__ __forceinline__ float sigmoidf_(float x) { return __builtin_amdgcn_rcpf(1.f + __builtin_amdgcn_exp2f(-1.4426950408889634f * x)); }
__device__ __forceinline__ float siluf_(float x) { return x * __builtin_amdgcn_rcpf(1.f + __builtin_amdgcn_exp2f(-1.4426950408889634f * x)); }
__device__ __forceinline__ float gelu_tanh(float x) { const float u = 0.7978845608028654f * (x + 0.044715f * x * x * x); return 0.5f * x * (1.f + tanhf(u)); }
__device__ __forceinline__ float logsigmoidf_(float x) { return fminf(x, 0.f) - log1pf(__expf(-fabsf(x))); }
#define DPP_F(v, ctrl) __builtin_bit_cast(float, __builtin_amdgcn_update_dpp(0, __builtin_bit_cast(int, (v)), (ctrl), 0xf, 0xf, true))
#define DPP_F_ID(idv, v, ctrl, rmask) __builtin_bit_cast(float, __builtin_amdgcn_update_dpp(__builtin_bit_cast(int, (idv)), __builtin_bit_cast(int, (v)), (ctrl), (rmask), 0xf, false))
__device__ __forceinline__ float xor16_f(float v) { return __builtin_bit_cast(float, __builtin_amdgcn_ds_swizzle(__builtin_bit_cast(int, v), 0x401F)); }
__device__ __forceinline__ float swap32_other(float v) { auto rr = __builtin_amdgcn_permlane32_swap(__float_as_uint(v), __float_as_uint(v), false, false);
    return (__builtin_amdgcn_mbcnt_hi(~0u, __builtin_amdgcn_mbcnt_lo(~0u, 0u)) & 32u) ? __uint_as_float(rr[0]) : __uint_as_float(rr[1]); }
__device__ __forceinline__ float wave_sum(float v) {
    v += DPP_F(v, 0xB1); v += DPP_F(v, 0x4E); v += DPP_F(v, 0x124); v += DPP_F(v, 0x128);
    v += xor16_f(v);
    auto rr = __builtin_amdgcn_permlane32_swap(__float_as_uint(v), __float_as_uint(v), false, false); return __uint_as_float(rr[0]) + __uint_as_float(rr[1]);
}
__device__ __forceinline__ float wave_max(float v) {
    v = fmaxf(v, DPP_F(v, 0xB1)); v = fmaxf(v, DPP_F(v, 0x4E)); v = fmaxf(v, DPP_F(v, 0x124)); v = fmaxf(v, DPP_F(v, 0x128));
    v = fmaxf(v, xor16_f(v));
    auto rr = __builtin_amdgcn_permlane32_swap(__float_as_uint(v), __float_as_uint(v), false, false); return fmaxf(__uint_as_float(rr[0]), __uint_as_float(rr[1]));
}
__device__ __forceinline__ float q4_sum(float v) {
    v += xor16_f(v);
    auto rr = __builtin_amdgcn_permlane32_swap(__float_as_uint(v), __float_as_uint(v), false, false); return __uint_as_float(rr[0]) + __uint_as_float(rr[1]);
}
__device__ __forceinline__ float scan_sum(float v) {
    v += DPP_F_ID(0.f, v, 0x111, 0xf); v += DPP_F_ID(0.f, v, 0x112, 0xf); v += DPP_F_ID(0.f, v, 0x114, 0xf); v += DPP_F_ID(0.f, v, 0x118, 0xf);
    v += DPP_F_ID(0.f, v, 0x142, 0xa); v += DPP_F_ID(0.f, v, 0x143, 0xc); return v;
}
__device__ __forceinline__ float scan_max(float v) {
    const float ninf = -3.0e38f;
    v = fmaxf(v, DPP_F_ID(ninf, v, 0x111, 0xf)); v = fmaxf(v, DPP_F_ID(ninf, v, 0x112, 0xf)); v = fmaxf(v, DPP_F_ID(ninf, v, 0x114, 0xf)); v = fmaxf(v, DPP_F_ID(ninf, v, 0x118, 0xf));
    v = fmaxf(v, DPP_F_ID(ninf, v, 0x142, 0xa)); v = fmaxf(v, DPP_F_ID(ninf, v, 0x143, 0xc)); return v;
}
__device__ __forceinline__ float lane63(float v) { return __builtin_bit_cast(float, __builtin_amdgcn_readlane(__builtin_bit_cast(int, v), 63)); }

#define XB_TMO      128
#define XB_XCNT(j)  (256  + 64 * (j))
#define XB_XSUB(j)  (1280 + 64 * (j))
#define XB_XGEN(j)  (2304 + 64 * (j))
#define XB_TOP      3328
#define XB_TOPGEN   3392
#define XCD_BAR_WORDS 3456
#define XB_SPIN_CAP (1u << 22)

__device__ __forceinline__ unsigned xb_ld(unsigned* p)              { return __hip_atomic_load(p, __ATOMIC_RELAXED, __HIP_MEMORY_SCOPE_AGENT); }
__device__ __forceinline__ unsigned xb_add(unsigned* p, unsigned v) { return __hip_atomic_fetch_add(p, v, __ATOMIC_RELAXED, __HIP_MEMORY_SCOPE_AGENT); }
__device__ __forceinline__ unsigned xb_xcc_id() { return (unsigned)__builtin_amdgcn_s_getreg((3 << 11) | 20) & 0xFu; }
#define XB_SPIN(cond, bar) do { unsigned _sp = 0; while (cond) { __builtin_amdgcn_s_sleep(1); \
    if ((++_sp & 255u) == 0u) { if (xb_ld(&(bar)[XB_TMO])) break; if (_sp > XB_SPIN_CAP) { atomicAdd(&(bar)[XB_TMO], 1u); break; } } } } while (0)

struct XcdBarrier {
    unsigned* bar; unsigned x;
    volatile LAS unsigned* st;
};
__device__ __forceinline__ XcdBarrier xcd_barrier_post(unsigned* bar, volatile LAS unsigned* st) {
    XcdBarrier b; b.bar = bar; b.x = xb_xcc_id(); b.st = st;
    if (threadIdx.x == 0) (void)xb_add(&bar[XB_XCNT(b.x)], 1u);
    return b;
}
__device__ __forceinline__ void xcd_barrier_complete(unsigned* bar, unsigned x, unsigned& nloc, unsigned& nx) {
    const unsigned G = gridDim.x * gridDim.y * gridDim.z;
    unsigned sum, cnt, mine, sp = 0u;
    for (;;) {
        sum = 0u; cnt = 0u; mine = 0u;
#pragma unroll
        for (unsigned j = 0; j < 16; ++j) { const unsigned c = xb_ld(&bar[XB_XCNT(j)]); sum += c; cnt += (c > 0u) ? 1u : 0u; mine = (j == x) ? c : mine; }
        if (sum == G) break;
        __builtin_amdgcn_s_sleep(1);
        if ((++sp & 255u) == 0u) { if (xb_ld(&bar[XB_TMO])) break; if (sp > XB_SPIN_CAP) { atomicAdd(&bar[XB_TMO], 1u); break; } }
    }
    nloc = mine > 0u ? mine : 1u; nx = cnt > 0u ? cnt : 1u;
}
__device__ __attribute__((noinline)) void xcd_barrier_fn(unsigned* bar, unsigned lds_st, int tid0) {
    volatile LAS unsigned* st = (volatile LAS unsigned*)lds_st;
    asm volatile("s_waitcnt vmcnt(0)" ::: "memory");
    __syncthreads();
    if (tid0) {
        const unsigned bx = xb_xcc_id();
        __builtin_amdgcn_s_waitcnt(0);
        unsigned nloc = st[0], nx = st[1];
        if (nloc == 0u) { xcd_barrier_complete(bar, bx, nloc, nx); st[0] = nloc; st[1] = nx; }
        const unsigned old = xb_add(&bar[XB_XSUB(bx)], 1u);
        const unsigned gen = old / nloc;
        if (old + 1u == (gen + 1u) * nloc) {
            __builtin_amdgcn_fence(__ATOMIC_RELEASE, "agent");
            asm volatile("s_waitcnt vmcnt(0)" ::: "memory");
            const unsigned og = xb_add(&bar[XB_TOP], 1u);
            const unsigned tg = og / nx;
            if (og + 1u == (tg + 1u) * nx) xb_add(&bar[XB_TOPGEN], 1u);
            else XB_SPIN(xb_ld(&bar[XB_TOPGEN]) == tg, bar);
            __builtin_amdgcn_fence(__ATOMIC_ACQUIRE, "agent");
            xb_add(&bar[XB_XGEN(bx)], 1u);
            asm volatile("s_waitcnt vmcnt(0)" ::: "memory");
        } else {
            XB_SPIN(xb_ld(&bar[XB_XGEN(bx)]) == gen, bar);
            __builtin_amdgcn_fence(__ATOMIC_ACQUIRE, "agent");
            asm volatile("s_waitcnt vmcnt(0)" ::: "memory");
        }
    }
    __syncthreads();
}

struct Frame {
    LAS unsigned char* lds;
    volatile LAS unsigned* MISC;
    gu32* ctl;
    int tid, lane, wave;
    int bid, G;
    unsigned char* ws; float* out;
};
constexpr int PT_OFF = MISC_OFF + 256;
__device__ __forceinline__ const float* inptr(const Frame& F, int k) {
    const LAS unsigned* p = (const LAS unsigned*)(F.lds + PT_OFF) + 2 * k;
    const unsigned lo = p[0], hi = p[1];
    return (const float*)(((unsigned long long)hi << 32) | lo);
}

template <bool ACC>
__device__ __forceinline__ void lds_gemm(LAS float* C, int ldc, const LAS bf16* A, int lda, const LAS bf16* Bt, int ldb, int Mt, int Nt, int K, int wave, int lane) {
    const int tn = Nt >> 4, nt = (Mt >> 4) * tn;
    for (int t = wave; t < nt; t += NWAVES) {
        const int i = t / tn, j = t - i * tn;
        f32x4 acc = {0.f, 0.f, 0.f, 0.f};
        const LAS bf16* ap = A + (i * 16 + (lane & 15)) * lda + 8 * (lane >> 4);
        const LAS bf16* bp = Bt + (j * 16 + (lane & 15)) * ldb + 8 * (lane >> 4);
        for (int k0 = 0; k0 < K; k0 += 32) {
            const bf16x8 a = *(const LAS bf16x8*)(ap + k0), b = *(const LAS bf16x8*)(bp + k0);
            acc = __builtin_amdgcn_mfma_f32_16x16x32_bf16(a, b, acc, 0, 0, 0);
        }
        LAS float* cp = C + (i * 16 + 4 * (lane >> 4)) * ldc + j * 16 + (lane & 15);
#pragma unroll
        for (int r = 0; r < 4; ++r) cp[r * ldc] = (ACC ? cp[r * ldc] : 0.f) + acc[r];
    }
}

template <int MODE>
__device__ __forceinline__ void tr_load(const float* W, int Nsrc, int Ndst, int item, int lane, f32x4 (&v)[16]) {
    const int nblk = Ndst / 64, kb = item / nblk, nb = item - kb * nblk, k0 = 64 * kb + 16 * (lane >> 4), n0 = 64 * nb + 4 * (lane & 15);
    const int ns = MODE == 1 ? colmap_in(n0) : (MODE == 2 ? ((n0 >> 7) & 1) * D_FF + (n0 >> 8) * 128 + (n0 & 127) : n0);
    if (ns >= 0) { const float* p = W + (size_t)k0 * Nsrc + ns;
#pragma unroll
        for (int i = 0; i < 16; ++i) v[i] = *(const GAS f32x4*)(p + (size_t)i * Nsrc); }
    else {
#pragma unroll
        for (int i = 0; i < 16; ++i) v[i] = (f32x4){0.f, 0.f, 0.f, 0.f}; }
}
template <int MODE>
__device__ __forceinline__ void tr_store(int K, int Ndst, bf16* WT, int item, int lane, f32x4 (&v)[16], const float* kg) {
    const int nblk = Ndst / 64, kb = item / nblk, nb = item - kb * nblk, k0 = 64 * kb + 16 * (lane >> 4), n0 = 64 * nb + 4 * (lane & 15);
    if (kg != nullptr) {
#pragma unroll
        for (int i = 0; i < 4; ++i) { const f32x4 g4 = *(const GAS f32x4*)(kg + k0 + 4 * i);
#pragma unroll
            for (int j = 0; j < 4; ++j) v[4 * i + j] = v[4 * i + j] * g4[j]; } }
    if constexpr (MODE == 3) {
#pragma unroll
        for (int j = 0; j < 4; ++j) { unsigned char* o = (unsigned char*)WT + (size_t)(n0 + j) * K + k0; constexpr float s = pg8::F8_WS;
            *(GAS v4u*)o = (v4u){pg8::pk4_fp8(v[0][j] * s, v[1][j] * s, v[2][j] * s, v[3][j] * s), pg8::pk4_fp8(v[4][j] * s, v[5][j] * s, v[6][j] * s, v[7][j] * s),
                                 pg8::pk4_fp8(v[8][j] * s, v[9][j] * s, v[10][j] * s, v[11][j] * s), pg8::pk4_fp8(v[12][j] * s, v[13][j] * s, v[14][j] * s, v[15][j] * s)}; }
        return; }
#pragma unroll
    for (int j = 0; j < 4; ++j) { bf16* o = MODE == 4 ? WT + (size_t)(k0 >> 7) * (Ndst * 128) + (n0 + j) * 128 + (k0 & 127) : WT + (size_t)(n0 + j) * K + k0;
        *(GAS v4u*)o = (v4u){cvtpk(v[0][j], v[1][j]), cvtpk(v[2][j], v[3][j]), cvtpk(v[4][j], v[5][j]), cvtpk(v[6][j], v[7][j])};
        *(GAS v4u*)(o + 8) = (v4u){cvtpk(v[8][j], v[9][j]), cvtpk(v[10][j], v[11][j]), cvtpk(v[12][j], v[13][j]), cvtpk(v[14][j], v[15][j])}; }
}
template <int MODE>
__device__ __forceinline__ void transpose_item(const float* W, int K, int Nsrc, int Ndst, bf16* WT, int item, int lane, const float* kg = nullptr) {
    asm volatile("" : "+v"(lane));
    f32x4 v[16];
    tr_load<MODE>(W, Nsrc, Ndst, item, lane, v); tr_store<MODE>(K, Ndst, WT, item, lane, v, kg);
}
template <int MODE>
__device__ __forceinline__ void transpose_items4(const float* W, int K, int Nsrc, int Ndst, bf16* WT, int item0, int lane, const float* kg = nullptr) {
    asm volatile("" : "+v"(lane));
    f32x4 va[16], vb[16];
    tr_load<MODE>(W, Nsrc, Ndst, item0, lane, va);
    tr_load<MODE>(W, Nsrc, Ndst, item0 + 1, lane, vb); tr_store<MODE>(K, Ndst, WT, item0, lane, va, kg);
    tr_load<MODE>(W, Nsrc, Ndst, item0 + 2, lane, va); tr_store<MODE>(K, Ndst, WT, item0 + 1, lane, vb, kg);
    tr_load<MODE>(W, Nsrc, Ndst, item0 + 3, lane, vb); tr_store<MODE>(K, Ndst, WT, item0 + 2, lane, va, kg);
    tr_store<MODE>(K, Ndst, WT, item0 + 3, lane, vb, kg);
}
__device__ __forceinline__ void rms_row_to_bf16(const float* xrow, const float* gain, bf16* orow, int lane) {
    const GAS f32x4* xr = (const GAS f32x4*)xrow + lane; const GAS f32x4* gr = (const GAS f32x4*)gain + lane;
    f32x4 v[8]; float s = 0.f;
#pragma unroll
    for (int j = 0; j < 8; ++j) { v[j] = xr[64 * j]; s += (v[j].x * v[j].x + v[j].y * v[j].y) + (v[j].z * v[j].z + v[j].w * v[j].w); }
    const float rstd = 1.f / sqrtf(wave_sum(s) * (1.f / D_MODEL) + NORM_EPS);
    GAS unsigned long long* o8 = (GAS unsigned long long*)orow + lane;
#pragma unroll
    for (int j = 0; j < 8; ++j) { const f32x4 g = gr[64 * j];
        o8[64 * j] = (unsigned long long)pk2(v[j].x * rstd * g.x, v[j].y * rstd * g.y) | ((unsigned long long)pk2(v[j].z * rstd * g.z, v[j].w * rstd * g.w) << 32); }
}
__device__ __forceinline__ void rms_brow_to_bf16(const bf16* xrow, const float* gain, bf16* orow, int lane) {
    const GAS v4u* xr = (const GAS v4u*)xrow + lane; v4u v[4]; float s = 0.f;
#pragma unroll
    for (int j = 0; j < 4; ++j) { v[j] = xr[64 * j]; const unsigned w[4] = {v[j].x, v[j].y, v[j].z, v[j].w};
#pragma unroll
        for (int i = 0; i < 4; ++i) { const float a = __builtin_bit_cast(float, w[i] << 16), b = __builtin_bit_cast(float, w[i] & 0xffff0000u); s += a * a + b * b; } }
    const float rstd = 1.f / sqrtf(wave_sum(s) * (1.f / D_MODEL) + NORM_EPS);
    GAS v4u* o = (GAS v4u*)orow + lane;
#pragma unroll
    for (int j = 0; j < 4; ++j) { const unsigned w[4] = {v[j].x, v[j].y, v[j].z, v[j].w}; const float* g = gain + 8 * (lane + 64 * j);
        const f32x4 g0 = *(const GAS f32x4*)g, g1 = *(const GAS f32x4*)(g + 4); const float gg[8] = {g0[0], g0[1], g0[2], g0[3], g1[0], g1[1], g1[2], g1[3]};
        unsigned ow[4];
#pragma unroll
        for (int i = 0; i < 4; ++i) ow[i] = cvtpk(__builtin_bit_cast(float, w[i] << 16) * rstd * gg[2 * i], __builtin_bit_cast(float, w[i] & 0xffff0000u) * rstd * gg[2 * i + 1]);
        o[64 * j] = (v4u){ow[0], ow[1], ow[2], ow[3]}; }
}
__device__ __forceinline__ void rms_brow_to_f32(const bf16* xrow, const float* gain, float* orow, int lane) {
    const GAS v4u* xr = (const GAS v4u*)xrow + lane; v4u v[4]; float s = 0.f;
#pragma unroll
    for (int j = 0; j < 4; ++j) { v[j] = xr[64 * j]; const unsigned w[4] = {v[j].x, v[j].y, v[j].z, v[j].w};
#pragma unroll
        for (int i = 0; i < 4; ++i) { const float a = __builtin_bit_cast(float, w[i] << 16), b = __builtin_bit_cast(float, w[i] & 0xffff0000u); s += a * a + b * b; } }
    const float rstd = 1.f / sqrtf(wave_sum(s) * (1.f / D_MODEL) + NORM_EPS);
#pragma unroll
    for (int j = 0; j < 4; ++j) { const unsigned w[4] = {v[j].x, v[j].y, v[j].z, v[j].w}; const float* g = gain + 8 * (lane + 64 * j); float* o = orow + 8 * (lane + 64 * j);
        const f32x4 g0 = *(const GAS f32x4*)g, g1 = *(const GAS f32x4*)(g + 4);
        *(GAS f32x4*)o = (f32x4){__builtin_bit_cast(float, w[0] << 16) * rstd * g0[0], __builtin_bit_cast(float, w[0] & 0xffff0000u) * rstd * g0[1], __builtin_bit_cast(float, w[1] << 16) * rstd * g0[2], __builtin_bit_cast(float, w[1] & 0xffff0000u) * rstd * g0[3]};
        *(GAS f32x4*)(o + 4) = (f32x4){__builtin_bit_cast(float, w[2] << 16) * rstd * g1[0], __builtin_bit_cast(float, w[2] & 0xffff0000u) * rstd * g1[1], __builtin_bit_cast(float, w[3] << 16) * rstd * g1[2], __builtin_bit_cast(float, w[3] & 0xffff0000u) * rstd * g1[3]}; }
}
__device__ __forceinline__ void rms_row_to_f32(const float* xrow, const float* gain, float* orow, int lane) {
    const GAS f32x4* xr = (const GAS f32x4*)xrow + lane; const GAS f32x4* gr = (const GAS f32x4*)gain + lane;
    f32x4 v[8]; float s = 0.f;
#pragma unroll
    for (int j = 0; j < 8; ++j) { v[j] = xr[64 * j]; s += (v[j].x * v[j].x + v[j].y * v[j].y) + (v[j].z * v[j].z + v[j].w * v[j].w); }
    const float rstd = 1.f / sqrtf(wave_sum(s) * (1.f / D_MODEL) + NORM_EPS);
    GAS f32x4* o = (GAS f32x4*)orow + lane;
#pragma unroll
    for (int j = 0; j < 8; ++j) { const f32x4 g = gr[64 * j]; o[64 * j] = v[j] * rstd * g; }
}

struct LayerPtrs {
    const float *attn_norm, *w_in, *qk_conv_w, *qk_conv_b, *i_bias, *f_bias, *mlstm_norm, *pe_k, *pe_v, *w1_k, *w2_k, *w1_v, *w2_v, *nsa_norm, *w_out, *ffn_norm, *w_up, *ffn_conv_w, *ffn_conv_b, *w_down;
};
struct WsPtrs {
    float *ropec, *ropes, *ssq, *oacc, *pbp, *ssqp;
    bf16 *win, *wout, *wup, *wdn, *c1k, *c1v, *c2k, *c2v, *xn, *z, *mix, *kcmp, *vcmpt, *vts, *vtw, *u, *g, *xr;
};

__device__ __forceinline__ LayerPtrs make_L(const Frame& F, int layer) {
    LayerPtrs L;
    L.attn_norm = inptr(F, 1) + (size_t)layer * D_MODEL; L.w_in = inptr(F, 2) + (size_t)layer * D_MODEL * N_IN;
    L.qk_conv_w = inptr(F, 3) + (size_t)layer * 4 * 2048; L.qk_conv_b = inptr(F, 4) + (size_t)layer * 2048;
    L.i_bias = inptr(F, 5) + layer * 8; L.f_bias = inptr(F, 6) + layer * 8; L.mlstm_norm = inptr(F, 7) + layer * 1024;
    L.pe_k = inptr(F, 8) + layer * 32 * 128; L.pe_v = inptr(F, 9) + layer * 32 * 128;
    L.w1_k = inptr(F, 10) + (size_t)layer * 4096 * 256; L.w2_k = inptr(F, 11) + (size_t)layer * 256 * 128;
    L.w1_v = inptr(F, 12) + (size_t)layer * 4096 * 256; L.w2_v = inptr(F, 13) + (size_t)layer * 256 * 128;
    L.nsa_norm = inptr(F, 14) + layer * 1024; L.w_out = inptr(F, 15) + (size_t)layer * D_MODEL * D_MODEL;
    L.ffn_norm = inptr(F, 16) + (size_t)layer * D_MODEL; L.w_up = inptr(F, 17) + (size_t)layer * D_MODEL * 2 * D_FF;
    L.ffn_conv_w = inptr(F, 18) + (size_t)layer * 3 * 2 * D_FF; L.ffn_conv_b = inptr(F, 19) + (size_t)layer * 2 * D_FF;
    L.w_down = inptr(F, 20) + (size_t)layer * D_FF * D_MODEL;
    return L;
}
__device__ __forceinline__ WsPtrs make_W(const Frame& F, int layer = 0) {
    const unsigned long long wsu = (unsigned long long)F.ws;
    unsigned wlo = __builtin_amdgcn_readfirstlane((unsigned)wsu), whi = __builtin_amdgcn_readfirstlane((unsigned)(wsu >> 32));
    asm volatile("" : "+s"(wlo), "+s"(whi));
    unsigned char* ws = (unsigned char*)(((unsigned long long)whi << 32) | wlo);
    WsPtrs W;
    W.ropec = (float*)(ws + WS_ROPE); W.ropes = W.ropec + SEQ * 16; W.ssq = (float*)(ws + 454 * MiB);     W.oacc = (float*)(ws + WS_OACC); W.ssqp = (float*)(ws + WS_SSQP);
    const size_t lo_ = layer ? (WS_L1 - WS_WIN) : 0; W.pbp = (float*)(ws + (layer ? WS_PBP1 : WS_PBP));
    W.win = (bf16*)(ws + WS_WIN + lo_); W.wout = (bf16*)(ws + WS_WOUT + lo_); W.wup = (bf16*)(ws + WS_WUP); W.wdn = (bf16*)(ws + WS_WDN);
    W.c1k = (bf16*)(ws + WS_C1K + lo_); W.c1v = (bf16*)(ws + WS_C1V + lo_); W.c2k = (bf16*)(ws + WS_C2K + lo_); W.c2v = (bf16*)(ws + WS_C2V + lo_);
    W.xn = (bf16*)(ws + WS_XN); W.z = (bf16*)(ws + WS_Z); W.mix = (bf16*)(ws + WS_MIX); W.kcmp = (bf16*)(ws + WS_KCMP); W.vcmpt = (bf16*)(ws + WS_VCMP); W.vts = (bf16*)(ws + WS_VTS); W.vtw = (bf16*)(ws + WS_VTW);
    W.u = (bf16*)(ws + WS_EDGE); W.xr = (bf16*)(ws + WS_XR); W.g = (bf16*)(ws + WS_G);
    return W;
}
constexpr int I_IN = (D_MODEL / 64) * (ZW / 64), I_OUT = (D_MODEL / 64) * (D_MODEL / 64), I_C1 = (4096 / 64) * (256 / 64), I_C2 = (256 / 64) * (128 / 64);
constexpr int NSMALL = I_IN + I_OUT + 2 * I_C1 + 2 * I_C2 + 512;
static_assert(NSMALL % 8 == 0, "small conversion items");
__device__ __forceinline__ void small_item(Frame& F, const LayerPtrs& L, const WsPtrs& W, int r, bool fold) {
    if (r < I_IN) { transpose_item<1>(L.w_in, D_MODEL, N_IN, ZW, W.win, r, F.lane, fold ? L.attn_norm : nullptr); return; } r -= I_IN;
    if (r < I_OUT) { transpose_item<0>(L.w_out, D_MODEL, D_MODEL, D_MODEL, W.wout, r, F.lane, r / (D_MODEL / 64) >= 16 ? L.nsa_norm - 1024 : nullptr); return; } r -= I_OUT;
    if (r < I_C1) { transpose_item<4>(L.w1_k, 4096, 256, 256, W.c1k, r, F.lane); return; } r -= I_C1;
    if (r < I_C1) { transpose_item<4>(L.w1_v, 4096, 256, 256, W.c1v, r, F.lane); return; } r -= I_C1;
    if (r < I_C2) { transpose_item<0>(L.w2_k, 256, 128, 128, W.c2k, r, F.lane); return; } r -= I_C2;
    if (r < I_C2) { transpose_item<0>(L.w2_v, 256, 128, 128, W.c2v, r, F.lane); return; } r -= I_C2;
    {
        const int br = r >> 8, cg = (r >> 6) & 3, kp = r & 63, col = 64 * cg + F.lane;
        const float* w1 = (br ? L.w1_v : L.w1_k) + (size_t)(64 * kp) * 256 + col; const float* pe = (br ? L.pe_v : L.pe_k) + 64 * kp;
        float a = 0.f;
#pragma unroll 16
        for (int i = 0; i < 64; ++i) a += pe[i] * w1[(size_t)i * 256];
        W.pbp[(br * 64 + kp) * 256 + col] = a;
    }
}
__device__ __forceinline__ void ph_prologue(Frame& F, const LayerPtrs& L, const WsPtrs& W, const float* xin, int layer) {
    const int gw = F.bid * NWAVES + F.wave, NGW = F.G * NWAVES;
    if (layer == 0) for (int it = gw; it < NSMALL; it += NGW) small_item(F, L, W, it, false);
    if (layer == 0) for (int i = F.bid * 512 + F.tid; i < SEQ * 16; i += F.G * 512) {
        const int pos = i >> 4, k = i & 15;
        const float inv = powf(500000.0f, -(float)(2 * k) / 32.0f);
        const float ang = (float)pos * inv;
        const double rev = (double)ang * 0.15915494309189535;
        const float fr = (float)(rev - floor(rev));
        W.ropec[i] = __builtin_amdgcn_cosf(fr); W.ropes[i] = __builtin_amdgcn_sinf(fr);
    }
    if (layer == 0) { for (int m = gw; m < M; m += NGW) rms_row_to_bf16(xin + (size_t)m * D_MODEL, L.attn_norm, W.xn + (size_t)m * D_MODEL, F.lane); }
    else { for (int m = gw; m < M; m += NGW) rms_brow_to_bf16(W.xr + (size_t)m * D_MODEL, L.attn_norm, W.xn + (size_t)m * D_MODEL, F.lane); }
}

__device__ __forceinline__ void ph_rope(Frame& F, const WsPtrs& W) {
    const size_t total = (size_t)M * 224;
    for (size_t i = (size_t)F.bid * 512 + F.tid; i < total; i += (size_t)F.G * 512) {
        const int m = (int)(i / 224), r = (int)(i - (size_t)m * 224), slot = r >> 4, k = r & 15;
        const int col = slot < 8 ? ZC_NQ + slot * 128 : (slot < 10 ? ZC_KC + (slot - 8) * 128 : (slot < 12 ? ZC_KS + (slot - 10) * 128 : ZC_KW + (slot - 12) * 128));
        const int pos = m & (SEQ - 1);
        const float c = W.ropec[pos * 16 + k], s = W.ropes[pos * 16 + k];
        bf16* p = W.z + (size_t)m * ZW + col + k;
        const float x1 = bf2f(p[0]), x2 = bf2f(p[16]);
        p[0] = (bf16)f2bf(x1 * c - x2 * s); p[16] = (bf16)f2bf(x2 * c + x1 * s);
    }
}

constexpr int M2_QB = 0, M2_KB = 17408, M2_KT = 34816, M2_VT = 53248, M2_PL = 71680, M2_SC = 80896;
__device__ __forceinline__ void mlstm2_unit(Frame& F, const LayerPtrs& L, const WsPtrs& W, int b, int hd) {
    LAS bf16* QB = (LAS bf16*)(F.lds + M2_QB);
    LAS bf16* KB = (LAS bf16*)(F.lds + M2_KB);
    LAS bf16* KT = (LAS bf16*)(F.lds + M2_KT);
    LAS bf16* VT = (LAS bf16*)(F.lds + M2_VT);
    LAS bf16* PL = (LAS bf16*)(F.lds + M2_PL);
    LAS float* SC = (LAS float*)(F.lds + M2_SC);
    LAS float *colf = SC, *rowf = SC + 64, *wi = SC + 128, *emt = SC + 192, *wkv = SC + 256, *nvec = SC + 320, *ssp = SC + 448, *ms = SC + 960, *dinv = SC + 2304;
    int lane_ = F.lane; asm volatile("" : "+v"(lane_));
    const int lane = lane_, wave = F.wave, tid = wave * 64 + lane, r = lane & 15, q4 = lane >> 4;
    const int d2 = tid & 63, sg = wave, dA = 2 * d2;
    const int coff = hd * 128 + dA;
    LAS float* CWL = SC + 1024;
    for (int e = tid; e < 10 * 128; e += 512) { const int k = e >> 7, d = e & 127, cq = hd * 128 + d;
        CWL[e] = k < 4 ? L.qk_conv_w[k * 2048 + cq] : (k < 8 ? L.qk_conv_w[(k - 4) * 2048 + 1024 + cq] : (k == 8 ? L.qk_conv_b[cq] : L.qk_conv_b[1024 + cq])); }
    const f32x4 gain = *(const GAS f32x4*)(L.mlstm_norm + hd * 128 + 16 * wave + 4 * q4);
    const float ibias = L.i_bias[hd], fbias = L.f_bias[hd];
    f32x4 cacc[8];
#pragma unroll
    for (int i = 0; i < 8; ++i) cacc[i] = (f32x4){0.f, 0.f, 0.f, 0.f};
    float nreg = 0.f;
    if (tid < 128) nvec[tid] = 0.f;
    if (tid == 0) ms[0] = 0.f;
    const bf16* zb = W.z + (size_t)b * SEQ * ZW;
    unsigned qraw[11], kraw[11], vraw[8]; bf16 graw0 = 0, graw1 = 0;
#pragma unroll
    for (int k = 0; k < 11; ++k) { const int t = 8 * sg - 3 + k;
        const bf16* rp = zb + (ptrdiff_t)(t >= 0 ? t : 0) * ZW;
        qraw[k] = t >= 0 ? *(const GAS unsigned*)(rp + ZC_MQ + coff) : 0u; kraw[k] = t >= 0 ? *(const GAS unsigned*)(rp + ZC_MK + coff) : 0u; }
#pragma unroll
    for (int k = 0; k < 8; ++k) { const bf16* rp = zb + (size_t)(8 * sg + k) * ZW; vraw[k] = *(const GAS unsigned*)(rp + ZC_MV + coff); }
    if (wave == 0) { graw0 = zb[(size_t)lane * ZW + ZC_MI + hd]; graw1 = zb[(size_t)lane * ZW + ZC_MF + hd]; }
    __syncthreads();
    for (int c = 0; c < SEQ / 64; ++c) {
        const int t0 = c * 64; const size_t row0 = (size_t)b * SEQ + t0;
        {
            unsigned kt0[4], kt1[4], vt0[4], vt1[4];
            typedef float f32x2_ __attribute__((ext_vector_type(2)));
            f32x2_ cw[10];
#pragma unroll
            for (int k = 0; k < 10; ++k) cw[k] = *(const LAS f32x2_*)(CWL + k * 128 + dA);
#pragma unroll
            for (int i = 0; i < 8; ++i) {
                float yq0 = cw[8][0], yq1 = cw[8][1], yk0 = cw[9][0], yk1 = cw[9][1];
#pragma unroll
                for (int j = 0; j < 4; ++j) { const unsigned a = qraw[i + j], kk = kraw[i + j];
                    yq0 += cw[j][0] * bf2f((bf16)(a & 0xffffu)); yq1 += cw[j][1] * bf2f((bf16)(a >> 16));
                    yk0 += cw[4 + j][0] * bf2f((bf16)(kk & 0xffffu)); yk1 += cw[4 + j][1] * bf2f((bf16)(kk >> 16)); }
                const int s = 8 * sg + i;
                *(LAS unsigned*)(QB + s * 136 + dA) = cvtpk(siluf_(yq0), siluf_(yq1));
                const unsigned kpk = cvtpk(siluf_(yk0) * 0.08838834764831845f, siluf_(yk1) * 0.08838834764831845f); const unsigned k0 = kpk & 0xffffu, k1 = kpk >> 16;
                *(LAS unsigned*)(KB + s * 136 + dA) = kpk;
                if (i & 1) { kt0[i >> 1] |= k0 << 16; kt1[i >> 1] |= k1 << 16; vt0[i >> 1] |= (vraw[i] & 0xffffu) << 16; vt1[i >> 1] |= vraw[i] & 0xffff0000u; }
                else { kt0[i >> 1] = k0; kt1[i >> 1] = k1; vt0[i >> 1] = vraw[i] & 0xffffu; vt1[i >> 1] = vraw[i] >> 16; }
                __builtin_amdgcn_sched_barrier(0);
            }
            *(LAS v4u*)(KT + dA * 72 + 8 * sg) = (v4u){kt0[0], kt0[1], kt0[2], kt0[3]}; *(LAS v4u*)(KT + (dA + 1) * 72 + 8 * sg) = (v4u){kt1[0], kt1[1], kt1[2], kt1[3]};
            *(LAS v4u*)(VT + dA * 72 + 8 * sg) = (v4u){vt0[0], vt0[1], vt0[2], vt0[3]}; *(LAS v4u*)(VT + (dA + 1) * 72 + 8 * sg) = (v4u){vt1[0], vt1[1], vt1[2], vt1[3]};
        }
        if (wave == 0) {
            const float ig = bf2f(graw0) + ibias, fp = bf2f(graw1) + fbias;
            float bsum = logsigmoidf_(fp);
#pragma unroll
            for (int o = 1; o < 64; o <<= 1) { const float tt = __shfl_up(bsum, o); if (lane >= o) bsum += tt; }
            const float ibv = ig - bsum; float pm = ibv;
#pragma unroll
            for (int o = 1; o < 64; o <<= 1) { const float tt = __shfl_up(pm, o); if (lane >= o) pm = fmaxf(pm, tt); }
            const float mprev = ms[0];
            const float mtv = bsum + fmaxf(mprev, pm);
            const float bL = __shfl(bsum, 63), pmL = __shfl(pm, 63);
            const float mnew = bL + fmaxf(mprev, pmL);
            colf[lane] = __expf(ibv); rowf[lane] = __expf(bsum - mtv); wi[lane] = __expf(bsum + mprev - mtv); emt[lane] = __expf(-mtv); wkv[lane] = __expf(bL + ibv - mnew);
            if (lane == 0) { ms[1] = __expf(bL + mprev - mnew); ms[2] = mnew; }
        }
        if (c + 1 < SEQ / 64) { const bf16* zn = zb + (size_t)(t0 + 64) * ZW;
#pragma unroll
            for (int k = 0; k < 11; ++k) { const int t = 8 * sg - 3 + k;
                const bf16* rp = zn + (ptrdiff_t)t * ZW;
                qraw[k] = *(const GAS unsigned*)(rp + ZC_MQ + coff); kraw[k] = *(const GAS unsigned*)(rp + ZC_MK + coff); }
#pragma unroll
            for (int k = 0; k < 8; ++k) { const bf16* rp = zn + (size_t)(8 * sg + k) * ZW; vraw[k] = *(const GAS unsigned*)(rp + ZC_MV + coff); }
            if (wave == 0) { graw0 = zn[(size_t)lane * ZW + ZC_MI + hd]; graw1 = zn[(size_t)lane * ZW + ZC_MF + hd]; } }
        __syncthreads();
        { const int i = wave >> 1;
#pragma unroll
          for (int e = 0; e < 2; ++e) { const int jj = 2 * (wave & 1) + e; const int t = 16 * jj + r;
              f32x4 acc = {0.f, 0.f, 0.f, 0.f};
              if (i <= jj) {
#pragma unroll
                  for (int kk = 0; kk < 4; ++kk) { const bf16x8 a = *(const LAS bf16x8*)(KB + (16 * i + r) * 136 + 32 * kk + 8 * q4), bb = *(const LAS bf16x8*)(QB + t * 136 + 32 * kk + 8 * q4);
                      acc = __builtin_amdgcn_mfma_f32_16x16x32_bf16(a, bb, acc, 0, 0, 0); }
                  const f32x4 cf = *(const LAS f32x4*)(colf + 16 * i + 4 * q4); const float rf = rowf[t];
#pragma unroll
                  for (int g = 0; g < 4; ++g) acc[g] = (16 * i + 4 * q4 + g <= t) ? acc[g] * cf[g] * rf : 0.f;
              }
              *(LAS unsigned long long*)(PL + t * 72 + 16 * i + 4 * q4) = (unsigned long long)cvtpk(acc[0], acc[1]) | ((unsigned long long)cvtpk(acc[2], acc[3]) << 32); } }
        __syncthreads();
        f32x4 hout[4];
        {
            bf16x8 av[2];
#pragma unroll
            for (int ks = 0; ks < 2; ++ks) av[ks] = *(const LAS bf16x8*)(VT + (16 * wave + r) * 72 + 32 * ks + 8 * q4);
#pragma unroll
            for (int jj = 0; jj < 4; ++jj) { const int t = 16 * jj + r;
                f32x4 hi = {0.f, 0.f, 0.f, 0.f}, ha = {0.f, 0.f, 0.f, 0.f};
#pragma unroll
                for (int kk = 0; kk < 4; ++kk) {
                    const unsigned long long lo = *(const LAS unsigned long long*)(QB + t * 136 + 32 * kk + 4 * q4), hi8 = *(const LAS unsigned long long*)(QB + t * 136 + 32 * kk + 16 + 4 * q4);
                    v4u w; w.x = (unsigned)lo; w.y = (unsigned)(lo >> 32); w.z = (unsigned)hi8; w.w = (unsigned)(hi8 >> 32);
                    v4u cw4; cw4.x = cvtpk(cacc[2 * kk][0], cacc[2 * kk][1]); cw4.y = cvtpk(cacc[2 * kk][2], cacc[2 * kk][3]); cw4.z = cvtpk(cacc[2 * kk + 1][0], cacc[2 * kk + 1][1]); cw4.w = cvtpk(cacc[2 * kk + 1][2], cacc[2 * kk + 1][3]);
                    hi = __builtin_amdgcn_mfma_f32_16x16x32_bf16(__builtin_bit_cast(bf16x8, cw4), __builtin_bit_cast(bf16x8, w), hi, 0, 0, 0); }
#pragma unroll
                for (int ks = 0; ks < 2; ++ks) { const bf16x8 w = *(const LAS bf16x8*)(PL + t * 72 + 32 * ks + 8 * q4); ha = __builtin_amdgcn_mfma_f32_16x16x32_bf16(av[ks], w, ha, 0, 0, 0); }
                hout[jj] = hi * wi[t] + ha;
                float ss = (hout[jj][0] * hout[jj][0] + hout[jj][1] * hout[jj][1]) + (hout[jj][2] * hout[jj][2] + hout[jj][3] * hout[jj][3]);
                ss = q4_sum(ss);
                if (q4 == 0) ssp[wave * 64 + t] = ss; }
            { const int t = 8 * wave + (lane >> 3), p = lane & 7;
              float a = 0.f;
#pragma unroll
              for (int e = 0; e < 2; ++e) { const v4u w = *(const LAS v4u*)(QB + t * 136 + 16 * p + 8 * e); const f32x4 n0 = *(const LAS f32x4*)(nvec + 16 * p + 8 * e), n1 = *(const LAS f32x4*)(nvec + 16 * p + 8 * e + 4);
                  a += bf2f((bf16)(w.x & 0xffffu)) * n0[0] + bf2f((bf16)(w.x >> 16)) * n0[1] + bf2f((bf16)(w.y & 0xffffu)) * n0[2] + bf2f((bf16)(w.y >> 16)) * n0[3]
                     + bf2f((bf16)(w.z & 0xffffu)) * n1[0] + bf2f((bf16)(w.z >> 16)) * n1[1] + bf2f((bf16)(w.w & 0xffffu)) * n1[2] + bf2f((bf16)(w.w >> 16)) * n1[3]; }
              const v4u w = *(const LAS v4u*)(PL + t * 72 + 8 * p);
              float d = (bf2f((bf16)(w.x & 0xffffu)) + bf2f((bf16)(w.x >> 16))) + (bf2f((bf16)(w.y & 0xffffu)) + bf2f((bf16)(w.y >> 16))) + (bf2f((bf16)(w.z & 0xffffu)) + bf2f((bf16)(w.z >> 16))) + (bf2f((bf16)(w.w & 0xffffu)) + bf2f((bf16)(w.w >> 16)));
              float den = wi[t] * a + d;
              den += DPP_F(den, 0xB1); den += DPP_F(den, 0x4E); den += DPP_F(den, 0x141);
              if (p == 0) dinv[t] = 1.f / fmaxf(fabsf(den), emt[t]); }
        }
        __syncthreads();
#pragma unroll
        for (int jj = 0; jj < 4; ++jj) { const int t = 16 * jj + r;
            float tot = 0.f;
#pragma unroll
            for (int w8 = 0; w8 < 8; ++w8) tot += ssp[w8 * 64 + t];
            const float iv = dinv[t]; const float rstd = iv / sqrtf(tot * iv * iv * (1.f / 128.f) + NORM_EPS);
            const unsigned long long mo = *(const GAS unsigned long long*)(W.z + (row0 + t) * ZW + ZC_MO + hd * 128 + 16 * wave + 4 * q4);
            const float o0 = hout[jj][0] * rstd * gain[0] * sigmoidf_(bf2f((bf16)(mo & 0xffffu))), o1 = hout[jj][1] * rstd * gain[1] * sigmoidf_(bf2f((bf16)((mo >> 16) & 0xffffu)));
            const float o2 = hout[jj][2] * rstd * gain[2] * sigmoidf_(bf2f((bf16)((mo >> 32) & 0xffffu))), o3 = hout[jj][3] * rstd * gain[3] * sigmoidf_(bf2f((bf16)(mo >> 48)));
            *(GAS unsigned long long*)(W.mix + (row0 + t) * 2048 + hd * 128 + 16 * wave + 4 * q4) = (unsigned long long)cvtpk(o0, o1) | ((unsigned long long)cvtpk(o2, o3) << 32);
            __builtin_amdgcn_sched_barrier(0); }
        {
            const float decay = ms[1];
            bf16x8 bv[2];
#pragma unroll
            for (int ks = 0; ks < 2; ++ks) { const v4u w = *(const LAS v4u*)(VT + (16 * wave + r) * 72 + 32 * ks + 8 * q4);
                const f32x4 k0 = *(const LAS f32x4*)(wkv + 32 * ks + 8 * q4), k1 = *(const LAS f32x4*)(wkv + 32 * ks + 8 * q4 + 4);
                v4u o; o.x = cvtpk(bf2f((bf16)(w.x & 0xffffu)) * k0[0], bf2f((bf16)(w.x >> 16)) * k0[1]); o.y = cvtpk(bf2f((bf16)(w.y & 0xffffu)) * k0[2], bf2f((bf16)(w.y >> 16)) * k0[3]);
                o.z = cvtpk(bf2f((bf16)(w.z & 0xffffu)) * k1[0], bf2f((bf16)(w.z >> 16)) * k1[1]); o.w = cvtpk(bf2f((bf16)(w.w & 0xffffu)) * k1[2], bf2f((bf16)(w.w >> 16)) * k1[3]);
                bv[ks] = __builtin_bit_cast(bf16x8, o); }
#pragma unroll
            for (int dt = 0; dt < 8; ++dt) { f32x4 a4 = cacc[dt] * decay;
#pragma unroll
                for (int ks = 0; ks < 2; ++ks) { const bf16x8 a = *(const LAS bf16x8*)(KT + (16 * dt + r) * 72 + 32 * ks + 8 * q4); a4 = __builtin_amdgcn_mfma_f32_16x16x32_bf16(a, bv[ks], a4, 0, 0, 0); }
                cacc[dt] = a4; __builtin_amdgcn_sched_barrier(0); }
            if (tid < 128) { float a = nreg * decay;
#pragma unroll
                for (int s8 = 0; s8 < 8; ++s8) { const v4u w = *(const LAS v4u*)(KT + tid * 72 + 8 * s8); const f32x4 k0 = *(const LAS f32x4*)(wkv + 8 * s8), k1 = *(const LAS f32x4*)(wkv + 8 * s8 + 4);
                    a += bf2f((bf16)(w.x & 0xffffu)) * k0[0] + bf2f((bf16)(w.x >> 16)) * k0[1] + bf2f((bf16)(w.y & 0xffffu)) * k0[2] + bf2f((bf16)(w.y >> 16)) * k0[3]
                       + bf2f((bf16)(w.z & 0xffffu)) * k1[0] + bf2f((bf16)(w.z >> 16)) * k1[1] + bf2f((bf16)(w.w & 0xffffu)) * k1[2] + bf2f((bf16)(w.w >> 16)) * k1[3]; }
                nreg = a; nvec[tid] = a; }
            if (tid == 0) ms[0] = ms[2];
        }
        __syncthreads();
    }
}

__device__ __forceinline__ void cmp_unit(Frame& F, const LayerPtrs& L, const WsPtrs& W, int u, int layer) {
    const int branch = u >> 7, rem = u & 127, bk = rem >> 3, b = bk >> 1, kvh = bk & 1, n0 = (rem & 7) * 16;
    LAS bf16* Hb = (LAS bf16*)(F.lds);
    int lane_ = F.lane; asm volatile("" : "+v"(lane_));
    const int lane = lane_, wave = F.wave, r = lane & 15, q4 = lane >> 4;
    const bf16* w1t = branch ? W.c1v : W.c1k; const bf16* w2t = branch ? W.c2v : W.c2k;
    const int zc = (branch ? ZC_VC : ZC_KC) + kvh * 128;
    const bf16* bp0 = w1t + (size_t)(32 * wave + r) * 128 + 8 * q4; const bf16* bp1 = bp0 + (size_t)16 * 128;
    f32x4 acc0 = {0.f, 0.f, 0.f, 0.f}, acc1 = {0.f, 0.f, 0.f, 0.f};
    LAS unsigned char* As = F.lds + 8448;
    { const int tid = wave * 64 + lane; v4u t[9];
#pragma unroll
      for (int j = 0; j < 9; ++j) { const int c = tid + 512 * j, rho = c >> 4; int row = 16 * n0 + rho; row = row < SEQ ? row : SEQ - 1;
          if (c < 272 * 16) t[j] = *(const GAS v4u*)(W.z + ((size_t)b * SEQ + row) * ZW + zc + 8 * (c & 15)); }
#pragma unroll
      for (int j = 0; j < 9; ++j) { const int c = tid + 512 * j, rho = c >> 4;
          if (c < 272 * 16) *(LAS v4u*)(As + ((rho & 15) * 18 + (rho >> 4)) * 272 + 16 * (c & 15)) = t[j]; } }
    bf16x8 fb[4][2][4];
#define CMP_LDB(s, l) do { _Pragma("unroll") for (int i = 0; i < 4; ++i) { fb[s][0][i] = *(const GAS bf16x8*)(bp0 + 32768 * (l) + 32 * i); fb[s][1][i] = *(const GAS bf16x8*)(bp1 + 32768 * (l) + 32 * i); } } while (0)
    CMP_LDB(0, 0); CMP_LDB(1, 1); CMP_LDB(2, 2);
    __syncthreads();
    const LAS unsigned char* ar = As + r * 272 + q4 * 16;
#pragma unroll 1
    for (int l4 = 0; l4 < 32; l4 += 4) {
#pragma unroll
        for (int s = 0; s < 4; ++s) { const int l = l4 + s, lp = l + 3 < 32 ? l + 3 : 31;
            CMP_LDB((s + 3) & 3, lp);
            bf16x8 fa[4];
#pragma unroll
            for (int i = 0; i < 4; ++i) fa[i] = *(const LAS bf16x8*)(ar + ((l & 15) * 18 + (l >> 4)) * 272 + 64 * i);
#pragma unroll
            for (int i = 0; i < 4; ++i) { acc0 = __builtin_amdgcn_mfma_f32_16x16x32_bf16(fa[i], fb[s][0][i], acc0, 0, 0, 0); acc1 = __builtin_amdgcn_mfma_f32_16x16x32_bf16(fa[i], fb[s][1][i], acc1, 0, 0, 0); } }
    }
#undef CMP_LDB
    { const float* pb = W.pbp + branch * 64 * 256 + 32 * wave + r;
      float b0 = 0.f, b1 = 0.f;
#pragma unroll 16
      for (int kp = 0; kp < 64; ++kp) { b0 += pb[kp * 256]; b1 += pb[kp * 256 + 16]; }
#pragma unroll
      for (int g = 0; g < 4; ++g) { Hb[(4 * q4 + g) * 264 + 32 * wave + r] = (bf16)(cvtpk(gelu_tanh(acc0[g] + b0), 0.f) & 0xffffu); Hb[(4 * q4 + g) * 264 + 32 * wave + 16 + r] = (bf16)(cvtpk(gelu_tanh(acc1[g] + b1), 0.f) & 0xffffu); } }
    __syncthreads();
    f32x4 o = {0.f, 0.f, 0.f, 0.f};
#pragma unroll
    for (int kk = 0; kk < 8; ++kk) { const bf16x8 a = *(const LAS bf16x8*)(Hb + r * 264 + 32 * kk + 8 * q4), bb = *(const GAS bf16x8*)(w2t + (size_t)(16 * wave + r) * 256 + 32 * kk + 8 * q4);
        o = __builtin_amdgcn_mfma_f32_16x16x32_bf16(a, bb, o, 0, 0, 0); }
    bf16* dst = (branch ? W.vcmpt : W.kcmp) + (size_t)bk * 128 * 128;
    const int d = 16 * wave + r;
#pragma unroll
    for (int g = 0; g < 4; ++g) { const int n = n0 + 4 * q4 + g; const bf16 ov = n < NCMP ? (bf16)(cvtpk(o[g], 0.f) & 0xffffu) : (bf16)0;
        if (branch) dst[d * 128 + ((n & ~12) | ((n & 4) << 1) | ((n & 8) >> 1))] = ov; else dst[n * 128 + d] = ov; }
    __syncthreads();
}

typedef float f32x16 __attribute__((ext_vector_type(16)));
struct NsaOff { unsigned base, x; __device__ __forceinline__ unsigned at(int s) const { return base + 32u * ((unsigned)s ^ x); } };
constexpr int N2_IMPW = 65536;
constexpr int N2_IMP = N2_IMPW + 33792;
constexpr int N2_SEL = N2_IMP + 8448;
#define N2_KOFF(buf) ((buf) * 32768)
#define N2_VOFF(buf) ((buf) * 32768 + 16384)
__device__ __forceinline__ float xhalf_max(float v) { auto rr = __builtin_amdgcn_permlane32_swap(__float_as_uint(v), __float_as_uint(v), false, false); return fmaxf(__uint_as_float(rr[0]), __uint_as_float(rr[1])); }
__device__ __forceinline__ float xhalf_sum(float v) { auto rr = __builtin_amdgcn_permlane32_swap(__float_as_uint(v), __float_as_uint(v), false, false); return __uint_as_float(rr[0]) + __uint_as_float(rr[1]); }
__device__ __forceinline__ float xhalf_other(float v) { return swap32_other(v); }
__device__ __forceinline__ void nsa2_stage(LAS unsigned char* lds, int buf, const bf16* kbase, int krs, const bf16* vtbase, int vrs, int wave, int lane) {
    asm volatile("" : "+v"(lane));
#pragma unroll
    for (int i = 0; i < 2; ++i) {
        const int p = wave * 2 + i;
        const int row = 4 * p + (lane >> 4), ch = (lane & 15) ^ (((row & 3) << 2) | ((row >> 2) & 3));
        __builtin_amdgcn_global_load_lds((const unsigned*)(kbase + (size_t)row * krs + 8 * ch), (LAS unsigned*)(lds + N2_KOFF(buf) + p * 1024), 16, 0, 0);
        const int vrow = 8 * p + (lane >> 3), vc = (lane & 7) ^ ((vrow >> 1) & 7);
        __builtin_amdgcn_global_load_lds((const unsigned*)(vtbase + (size_t)vrow * vrs + 8 * vc), (LAS unsigned*)(lds + N2_VOFF(buf) + p * 1024), 16, 0, 0);
    }
}
__device__ __forceinline__ void nsa2_qk(LAS unsigned char* lds, int buf, const bf16x8 (&Qf)[8], const NsaOff koff, f32x16 (&st)[2]) {
#pragma unroll
    for (int kt = 0; kt < 2; ++kt) {
#pragma unroll
        for (int r = 0; r < 16; ++r) st[kt][r] = 0.f;
#pragma unroll
        for (int s = 0; s < 8; ++s) { const bf16x8 a = *(const LAS bf16x8*)(lds + N2_KOFF(buf) + kt * 8192 + koff.at(s)); st[kt] = __builtin_amdgcn_mfma_f32_32x32x16_bf16(a, Qf[s], st[kt], 0, 0, 0); }
    }
}
__device__ __forceinline__ void nsa2_pv(LAS unsigned char* lds, int buf, const f32x16 (&st)[2], const NsaOff voff, f32x16 (&O)[4]) {
    bf16x8 pf[4];
#pragma unroll
    for (int ks = 0; ks < 4; ++ks) { const int kt = ks >> 1, b0 = (ks & 1) * 8;
        v4u w; w.x = cvtpk(st[kt][b0 + 0], st[kt][b0 + 1]); w.y = cvtpk(st[kt][b0 + 2], st[kt][b0 + 3]); w.z = cvtpk(st[kt][b0 + 4], st[kt][b0 + 5]); w.w = cvtpk(st[kt][b0 + 6], st[kt][b0 + 7]);
        pf[ks] = __builtin_bit_cast(bf16x8, w); }
#pragma unroll
    for (int db = 0; db < 4; ++db)
#pragma unroll
        for (int ks = 0; ks < 4; ++ks) { const bf16x8 a = *(const LAS bf16x8*)(lds + N2_VOFF(buf) + db * 4096 + voff.at(ks)); O[db] = __builtin_amdgcn_mfma_f32_32x32x16_bf16(a, pf[ks], O[db], 0, 0, 0); }
}
__device__ __forceinline__ void nsa2_flash(LAS unsigned char* lds, int buf, const bf16x8 (&Qf)[8], const NsaOff koff, const NsaOff voff, f32x16 (&O)[4], float& m2, float& l, int lo_k, int hi_k, int h) {
    constexpr float C = 0.08838834764831845f * 1.4426950408889634f;
    f32x16 st[2];
    nsa2_qk(lds, buf, Qf, koff, st);
    float mx = -1e30f;
#pragma unroll
    for (int kt = 0; kt < 2; ++kt)
#pragma unroll
        for (int r = 0; r < 16; ++r) { const int kk = 32 * kt + (r & 3) + 8 * (r >> 2) + 4 * h; const bool valid = (kk > lo_k) && (kk <= hi_k);
            const float sv = valid ? st[kt][r] * C : -1e30f; st[kt][r] = sv; mx = fmaxf(mx, sv); }
    mx = xhalf_max(mx);
    const float mnew = fmaxf(m2, mx), alpha = __builtin_amdgcn_exp2f(m2 - mnew); m2 = mnew;
    float ps = 0.f;
#pragma unroll
    for (int kt = 0; kt < 2; ++kt)
#pragma unroll
        for (int r = 0; r < 16; ++r) { const float p = st[kt][r] > -5e29f ? __builtin_amdgcn_exp2f(st[kt][r] - mnew) : 0.f; st[kt][r] = p; ps += p; }
    l = l * alpha + ps;
#pragma unroll
    for (int db = 0; db < 4; ++db) O[db] = O[db] * alpha;
    nsa2_pv(lds, buf, st, voff, O);
}
__device__ __forceinline__ void nsa2_unit(Frame& F, const WsPtrs& W, int b, int kvh, int c, int pass) {
    LAS unsigned char* lds = F.lds;
    LAS float* IMPW = (LAS float*)(lds + N2_IMPW); LAS float* IMP = (LAS float*)(lds + N2_IMP); LAS unsigned* SEL = (LAS unsigned*)(lds + N2_SEL);
    int lane_ = F.lane; asm volatile("" : "+v"(lane_));
    const int lane = lane_, wave = F.wave, tid = wave * 64 + lane, g = wave >> 1, qh = wave & 1, q = lane & 31, h = lane >> 5, hq = kvh * 4 + g;
    const int rq = 32 * qh + q, t = c * 64 + rq; const size_t row = (size_t)b * SEQ + t;
    const int xr = ((q & 3) << 2) | ((q >> 2) & 3), xv = (q >> 1) & 7;
    const NsaOff koff = {(unsigned)(256 * q + 16 * ((h ^ xr) & 1)), (unsigned)(xr >> 1)}, voff = {(unsigned)(128 * q + 16 * ((h ^ xv) & 1)), (unsigned)(xv >> 1)};
    const bf16* kcb = W.kcmp + (size_t)(b * 2 + kvh) * 128 * 128; const bf16* vcb = W.vcmpt + (size_t)(b * 2 + kvh) * 128 * 128;
    nsa2_stage(lds, 0, kcb, 128, vcb, 128, wave, lane);
    nsa2_stage(lds, 1, kcb + 64 * 128, 128, vcb + 64, 128, wave, lane);
    bf16x8 Qf[8];
    { const bf16* qp = W.z + row * ZW + ZC_NQ + hq * 128 + 8 * h;
#pragma unroll
      for (int s = 0; s < 8; ++s) Qf[s] = *(const GAS bf16x8*)(qp + 16 * s); }
    const float g0 = sigmoidf_(bf2f(W.z[row * ZW + ZC_NG + hq * 3 + 0])), g1 = sigmoidf_(bf2f(W.z[row * ZW + ZC_NG + hq * 3 + 1])), g2 = sigmoidf_(bf2f(W.z[row * ZW + ZC_NG + hq * 3 + 2]));
    if (tid < 65) SEL[tid] = 0u;
    float* op = W.oacc + row * 1024 + hq * 128 + 4 * h;
    asm volatile("s_waitcnt vmcnt(0)" ::: "memory");
    __syncthreads();
    constexpr float C = 0.08838834764831845f * 1.4426950408889634f;
    f32x16 O[4];
    {
        const int lim = t >= 31 ? ((t - 31) >> 4) : -1;
        const int limc = lim < NCMP - 1 ? lim : NCMP - 1;
        float m2 = -1e30f, l = 0.f;
#pragma unroll
        for (int db = 0; db < 4; ++db)
#pragma unroll
            for (int r = 0; r < 16; ++r) O[db][r] = 0.f;
        nsa2_flash(lds, 0, Qf, koff, voff, O, m2, l, -1, limc, h);
        nsa2_flash(lds, 1, Qf, koff, voff, O, m2, l, -1, limc - 64, h);
        const float lt = xhalf_sum(l), inv = lt > 0.f ? 1.f / lt : 0.f, og = inv * g0;
#pragma unroll
        for (int db = 0; db < 4; ++db)
#pragma unroll
            for (int r4 = 0; r4 < 4; ++r4) *(GAS f32x4*)(op + 32 * db + 8 * r4) = (f32x4){O[db][4 * r4] * og, O[db][4 * r4 + 1] * og, O[db][4 * r4 + 2] * og, O[db][4 * r4 + 3] * og};
        LAS float* iw = IMPW + (wave * 32 + q) * 33 + h;
        float prev = 0.f;
#pragma unroll
        for (int blk = 0; blk < 2; ++blk) {
            f32x16 st[2];
            nsa2_qk(lds, blk, Qf, koff, st);
#pragma unroll
            for (int kt = 0; kt < 2; ++kt)
#pragma unroll
                for (int r4 = 0; r4 < 4; ++r4) {
                    float pv[4];
#pragma unroll
                    for (int i = 0; i < 4; ++i) { const int kk = 64 * blk + 32 * kt + 8 * r4 + 4 * h + i; pv[i] = kk <= limc ? __builtin_amdgcn_exp2f(st[kt][4 * r4 + i] * C - m2) * inv : 0.f; }
                    const float s4 = (pv[0] + pv[1]) + (pv[2] + pv[3]);
                    const float o = xhalf_other(pv[3]);
                    const float add = h ? o : prev; prev = o;
                    iw[2 * (8 * blk + 4 * kt + r4)] = s4 + add;
                }
        }
    }
    __syncthreads();
    const bf16* ksb = W.z + (size_t)b * SEQ * ZW + ZC_KS + kvh * 128; const bf16* vsb = W.vts + (size_t)(b * 2 + kvh) * 128 * SEQ;
    const bf16* kwb = W.z + (size_t)b * SEQ * ZW + ZC_KW + kvh * 128; const bf16* vwb = W.vtw + (size_t)(b * 2 + kvh) * 128 * SEQ;
    nsa2_stage(lds, 0, ksb, ZW, vsb, SEQ, wave, lane);
    for (int e = tid; e < 64 * 32; e += 512) { const int q64 = e >> 5, j = e & 31; const int wq = (q64 >> 5), ql = q64 & 31;
        IMP[q64 * 33 + j] = ((IMPW[((0 + wq) * 32 + ql) * 33 + j] + IMPW[((2 + wq) * 32 + ql) * 33 + j]) + IMPW[((4 + wq) * 32 + ql) * 33 + j]) + IMPW[((6 + wq) * 32 + ql) * 33 + j]; }
    __syncthreads();
    for (int e = tid; e < 64 * 32; e += 512) { const int q64 = e >> 5, j = e & 31;
        const float vj = (j == 0 || j == c || j == c - 1) ? 1e4f : (j > c ? -1.f : IMP[q64 * 33 + j]);
        int rank = 0;
        for (int i = 0; i < 32; ++i) { const float vi = (i == 0 || i == c || i == c - 1) ? 1e4f : (i > c ? -1.f : IMP[q64 * 33 + i]); rank += (vi > vj || (vi == vj && i < j)) ? 1 : 0; }
        if (j <= c && rank < TOPK) { __hip_atomic_fetch_or(&SEL[q64], 1u << j, __ATOMIC_RELAXED, __HIP_MEMORY_SCOPE_WORKGROUP); __hip_atomic_fetch_or(&SEL[64], 1u << j, __ATOMIC_RELAXED, __HIP_MEMORY_SCOPE_WORKGROUP); } }
    __syncthreads();
    const unsigned mysel = SEL[rq];
    const unsigned anysel = __builtin_amdgcn_readfirstlane(SEL[64]);
    const int j0w = c > 8 ? c - 8 : 0, nsl = __builtin_popcount(anysel), nit = nsl + (c - j0w + 1);
    unsigned rem = anysel & ~1u;
    float m2 = -1e30f, l = 0.f;
#pragma unroll
    for (int db = 0; db < 4; ++db)
#pragma unroll
        for (int r = 0; r < 16; ++r) O[db][r] = 0.f;
    int jcur = 0;
    for (int it = 0; it < nit; ++it) {
        const int buf = it & 1; const bool is_sel = it < nsl;
        int jn = 0; const int itn = it + 1;
        if (itn < nit) {
            if (itn < nsl) { jn = __builtin_ctz(rem); rem &= rem - 1u; nsa2_stage(lds, buf ^ 1, ksb + (size_t)jn * 64 * ZW, ZW, vsb + jn * 64, SEQ, wave, lane); }
            else { jn = j0w + (itn - nsl); nsa2_stage(lds, buf ^ 1, kwb + (size_t)jn * 64 * ZW, ZW, vwb + jn * 64, SEQ, wave, lane); }
        }
        const int j = jcur;
        int lo_k = -1, hi_k = 63; bool lane_on = true;
        if (j == c) hi_k = rq;
        if (is_sel) lane_on = (mysel >> j) & 1u; else if (j == c - 8) lo_k = rq;
        if (!lane_on) hi_k = -1;
        if (__builtin_amdgcn_ballot_w64(lane_on) != 0ull) nsa2_flash(lds, buf, Qf, koff, voff, O, m2, l, lo_k, hi_k, h);
        if (it == nsl - 1 || it == nit - 1) {
            const float lt = xhalf_sum(l); const float sc = (it == nsl - 1 ? g1 : g2) / lt;
            if (it == nsl - 1) {
#pragma unroll
                for (int db = 0; db < 4; ++db)
#pragma unroll
                    for (int r4 = 0; r4 < 4; ++r4) { GAS f32x4* p = (GAS f32x4*)(op + 32 * db + 8 * r4); f32x4 v = *p;
                        v.x += O[db][4 * r4] * sc; v.y += O[db][4 * r4 + 1] * sc; v.z += O[db][4 * r4 + 2] * sc; v.w += O[db][4 * r4 + 3] * sc; *p = v; }
                m2 = -1e30f; l = 0.f;
#pragma unroll
                for (int db = 0; db < 4; ++db)
#pragma unroll
                    for (int r = 0; r < 16; ++r) O[db][r] = 0.f;
            } else {
                float ss = 0.f; bf16* mp = W.mix + row * 2048 + 1024 + hq * 128 + 4 * h;
#pragma unroll
                for (int db = 0; db < 4; ++db)
#pragma unroll
                    for (int r4 = 0; r4 < 4; ++r4) { const f32x4 v = *(const GAS f32x4*)(op + 32 * db + 8 * r4);
                        const float a0 = v.x + O[db][4 * r4] * sc, a1 = v.y + O[db][4 * r4 + 1] * sc, a2 = v.z + O[db][4 * r4 + 2] * sc, a3 = v.w + O[db][4 * r4 + 3] * sc;
                        ss += (a0 * a0 + a1 * a1) + (a2 * a2 + a3 * a3);
                        *(GAS unsigned long long*)(mp + 32 * db + 8 * r4) = (unsigned long long)pk2(a0, a1) | ((unsigned long long)pk2(a2, a3) << 32); }
                ss = xhalf_sum(ss);
                if (h == 0) W.ssq[(size_t)hq * M + row] = ss;
            }
        }
        jcur = jn;
        asm volatile("s_waitcnt vmcnt(0)" ::: "memory");
        __syncthreads();
    }
}

__device__ __forceinline__ void ph_vt(Frame& F, const WsPtrs& W) {
    LAS bf16* T = (LAS bf16*)F.lds;
    for (int tile = F.bid; tile < 1024; tile += F.G) {
        const int which = tile & 1, kvh = (tile >> 1) & 1, tb = (tile >> 2) & 31, b = tile >> 7;
        const int zc = (which ? ZC_VW : ZC_VS) + kvh * 128; const size_t r0 = (size_t)b * SEQ + tb * 64;
        for (int e = F.tid; e < 64 * 16; e += 512) { const int r = e >> 4, qd = e & 15; *(LAS v4u*)(T + r * 136 + 8 * qd) = *(const GAS v4u*)(W.z + (r0 + r) * ZW + zc + 8 * qd); }
        __syncthreads();
        bf16* dst = (which ? W.vtw : W.vts) + (size_t)(b * 2 + kvh) * 128 * SEQ + tb * 64;
        for (int e = F.tid; e < 128 * 8; e += 512) { const int d = e >> 3, u = e & 7, kb = 16 * (u >> 1) + 4 * (u & 1);
            unsigned w[4];
#pragma unroll
            for (int i = 0; i < 4; ++i) { const int k0 = kb + (i >> 1) * 8 + (i & 1) * 2; w[i] = (unsigned)T[k0 * 136 + d] | ((unsigned)T[(k0 + 1) * 136 + d] << 16); }
            v4u o; o.x = w[0]; o.y = w[1]; o.z = w[2]; o.w = w[3];
            *(GAS v4u*)(dst + (size_t)d * SEQ + 8 * u) = o; }
        __syncthreads();
    }
}

__device__ __forceinline__ void ph_nsa_norm(Frame& F, const LayerPtrs& L, const WsPtrs& W) {
    const size_t total = (size_t)M * 128;
    for (size_t i = (size_t)F.bid * 512 + F.tid; i < total; i += (size_t)F.G * 512) {
        const int m = (int)(i >> 7), q = (int)(i & 127);
        float sq = 0.f;
#pragma unroll
        for (int hh = 0; hh < 8; ++hh) sq += W.ssq[(size_t)hh * M + m];
        const float rstd = 1.f / sqrtf(sq * (1.f / 1024.f) + NORM_EPS);
        GAS v4u* p = (GAS v4u*)(W.mix + (size_t)m * 2048 + 1024 + 8 * q); v4u v = *p; const float* gn = L.nsa_norm + 8 * q;
        unsigned w[4] = {v.x, v.y, v.z, v.w};
#pragma unroll
        for (int k = 0; k < 4; ++k) { const float lo = bf2f((bf16)(w[k] & 0xffffu)) * rstd * gn[2 * k], hi = bf2f((bf16)(w[k] >> 16)) * rstd * gn[2 * k + 1]; w[k] = pk2(lo, hi); }
        v.x = w[0]; v.y = w[1]; v.z = w[2]; v.w = w[3]; *p = v;
    }
}
__device__ __forceinline__ void ph_ffn_gate(Frame& F, const LayerPtrs& L, const WsPtrs& W) {
    constexpr int FG = D_FF / 8, NITEM = FG * (M / 64);
    for (int it = F.bid * 512 + F.tid; it < NITEM; it += F.G * 512) {
        const int blk = it / FG, q = it - blk * FG, f0 = 8 * q; const bool first = (blk & (SEQ / 64 - 1)) == 0;
        const bf16* e0 = W.u + (size_t)blk * 4 * (2 * D_FF) + f0; const bf16* ep = e0 - 4 * (2 * D_FF);
        v4u r[2][4];
#pragma unroll
        for (int s = 0; s < 2; ++s) { r[s][2] = *(const GAS v4u*)(e0 + s * D_FF); r[s][3] = *(const GAS v4u*)(e0 + (2 * D_FF) + s * D_FF);
            if (first) { r[s][0] = (v4u){0u, 0u, 0u, 0u}; r[s][1] = r[s][0]; } else { r[s][0] = *(const GAS v4u*)(ep + 2 * (2 * D_FF) + s * D_FF); r[s][1] = *(const GAS v4u*)(ep + 3 * (2 * D_FF) + s * D_FF); } }
        float wg[3][8], wu[3][8], bg[8], bu[8];
#pragma unroll
        for (int j = 0; j < 3; ++j) { const float* p = L.ffn_conv_w + (size_t)j * (2 * D_FF) + f0;
#pragma unroll
            for (int i = 0; i < 8; ++i) { wg[j][i] = p[i]; wu[j][i] = p[D_FF + i]; } }
#pragma unroll
        for (int i = 0; i < 8; ++i) { bg[i] = L.ffn_conv_b[f0 + i]; bu[i] = L.ffn_conv_b[D_FF + f0 + i]; }
#pragma unroll
        for (int e = 0; e < 2; ++e) {
            float yy[8];
#pragma unroll
            for (int k2 = 0; k2 < 4; ++k2) { float y[2];
#pragma unroll
                for (int hh = 0; hh < 2; ++hh) { const int i = 2 * k2 + hh;
                    const unsigned g2 = ((const unsigned*)&r[0][e])[k2], g1 = ((const unsigned*)&r[0][e + 1])[k2], gc = ((const unsigned*)&r[0][e + 2])[k2];
                    const unsigned u2 = ((const unsigned*)&r[1][e])[k2], u1 = ((const unsigned*)&r[1][e + 1])[k2], uc = ((const unsigned*)&r[1][e + 2])[k2];
                    const float ga = bg[i] + wg[0][i] * bf2f((bf16)(hh ? g2 >> 16 : g2 & 0xffffu)) + wg[1][i] * bf2f((bf16)(hh ? g1 >> 16 : g1 & 0xffffu)) + wg[2][i] * bf2f((bf16)(hh ? gc >> 16 : gc & 0xffffu));
                    const float ua = bu[i] + wu[0][i] * bf2f((bf16)(hh ? u2 >> 16 : u2 & 0xffffu)) + wu[1][i] * bf2f((bf16)(hh ? u1 >> 16 : u1 & 0xffffu)) + wu[2][i] * bf2f((bf16)(hh ? uc >> 16 : uc & 0xffffu));
                    y[hh] = siluf_(ga) * ua; }
                yy[2 * k2] = y[0] * pg8::F8_GS; yy[2 * k2 + 1] = y[1] * pg8::F8_GS; }
            *(GAS unsigned long long*)((unsigned char*)W.g + ((size_t)blk * 64 + e) * D_FF + f0) = (unsigned long long)pg8::pk4_fp8(yy[0], yy[1], yy[2], yy[3]) | ((unsigned long long)pg8::pk4_fp8(yy[4], yy[5], yy[6], yy[7]) << 32);
        }
    }
}


__device__ __forceinline__ void call_prologue(Frame& F, int layer) {
    const LayerPtrs L = make_L(F, layer); const WsPtrs W = make_W(F, layer); ph_prologue(F, L, W, layer == 0 ? inptr(F, 0) : (const float*)F.out, layer);
}
__device__ __forceinline__ void call_mix1(Frame& F, int layer) {
    const LayerPtrs L = make_L(F, layer); const WsPtrs W = make_W(F, layer);
    for (int u = F.bid; u < 256; u += F.G) cmp_unit(F, L, W, u, layer);
}
constexpr int CW_QUEUE = 8192;
constexpr int I_UP = (D_MODEL / 64) * (2 * D_FF / 64), I_DN = (D_FF / 64) * (D_MODEL / 64), NCONV = (I_UP + I_DN) / 32;
static_assert(I_UP % 32 == 0 && I_DN % 32 == 0, "conversion items");
__device__ __forceinline__ int q_pop(Frame& F, unsigned* head) {
    LAS int* slot = (LAS int*)(F.lds + MISC_OFF + 64);
    __syncthreads();
    if (F.tid == 0) *slot = (int)__hip_atomic_fetch_add(head, 1u, __ATOMIC_RELAXED, __HIP_MEMORY_SCOPE_AGENT);
    __syncthreads();
    return *slot;
}
__device__ __forceinline__ void conv_pop(Frame& F, const WsPtrs& W, int layer, int c) {
    const int wt = c * 32 + F.wave * 4;
    if (wt < I_UP) transpose_items4<2>(inptr(F, 17) + (size_t)layer * D_MODEL * 2 * D_FF, D_MODEL, 2 * D_FF, 2 * D_FF, W.wup, wt, F.lane, inptr(F, 16) + (size_t)layer * D_MODEL);
    else transpose_items4<3>(inptr(F, 20) + (size_t)layer * D_FF * D_MODEL, D_FF, D_MODEL, D_MODEL, W.wdn, wt - I_UP, F.lane);
}
__device__ __forceinline__ unsigned* conv_head(Frame& F, int layer) { return (unsigned*)(F.ws + WS_CTL) + CW_QUEUE + 512 + 64 * layer; }
__device__ __forceinline__ void call_nsa(Frame& F, int layer, int pass) {
    const WsPtrs W = make_W(F, layer);
    if (F.bid < 64) { const LayerPtrs L = make_L(F, layer); for (int rep = 0; rep < (PROBE_DUP == 41 ? 2 : 1); ++rep) for (int u = F.bid; u < 64; u += (F.G < 64 ? F.G : 64)) mlstm2_unit(F, L, W, u >> 3, u & 7); }
    unsigned* head = (unsigned*)(F.ws + WS_CTL) + CW_QUEUE + 64 * layer + 256 * (1 - pass);
    for (;;) { const int u = q_pop(F, head); if (u >= 512) break;
        for (int p_ = (PROBE_DUP == 42 ? 0 : 1); p_ < 2; ++p_) nsa2_unit(F, W, (u & 15) >> 1, u & 1, 31 - (u >> 4), p_); }
    if (pass == 0) return;
    { unsigned* ch = conv_head(F, layer); for (;;) { const int c = q_pop(F, ch); if (c >= NCONV) break; conv_pop(F, W, layer, c); } }
    if (layer + 1 < DEPTH) { unsigned* sh = conv_head(F, layer) + 16; const LayerPtrs L1 = make_L(F, layer + 1); const WsPtrs W1 = make_W(F, layer + 1);
        for (;;) { const int s = q_pop(F, sh); if (s >= NSMALL / 8) break; small_item(F, L1, W1, s * 8 + F.wave, true); } }
}

struct Args { const float* in[22]; float* out; unsigned char* ws; int ph_lo, ph_hi, pad0, pad1; };
__global__ void __launch_bounds__(NWAVES * 64, 2) hymba_fwd(Args args) {
    extern __shared__ __attribute__((aligned(16))) unsigned char lds[];
    Frame F;
    F.lds = (LAS unsigned char*)lds;
    F.MISC = (volatile LAS unsigned*)(F.lds + MISC_OFF);
    F.tid = threadIdx.x; F.lane = F.tid & 63; F.wave = __builtin_amdgcn_readfirstlane(F.tid >> 6);
    F.G = gridDim.x; F.bid = blockIdx.x;
    unsigned char* ws = args.ws;
    F.ws = args.ws; F.out = args.out;
    F.ctl = (gu32*)(ws + WS_CTL);
    for (int u = F.tid; u < (LDS_BYTES - LDSCTL_OFF) / 4; u += NWAVES * 64) ((LAS unsigned*)(F.lds + LDSCTL_OFF))[u] = 0u;
    __syncthreads();
    if (F.tid < 22) ((LAS unsigned long long*)(F.lds + PT_OFF))[F.tid] = (unsigned long long)args.in[F.tid];
    __syncthreads();
    if (!MK_PER_PHASE) (void)xcd_barrier_post((unsigned*)(F.ctl + CW_BAR), F.MISC + 8);
#define GRID_BAR() do { if (MK_PER_PHASE) { if (F.tid == 0) __hip_atomic_store(F.ctl + 0, 0xBADBA0u, RLX_AGENT); } else { const WsPtrs Wb_ = make_W(F); unsigned st_ = (unsigned)(__UINTPTR_TYPE__)(F.lds + MISC_OFF + 32); asm volatile("" : "+s"(st_)); xcd_barrier_fn((unsigned*)Wb_.ropec - (WS_ROPE - WS_CTL) / 4 + CW_BAR, st_, (int)(F.tid == 0)); } } while (0)
    const int lo = args.ph_lo, hi = args.ph_hi;
#ifndef PH_MASK
#define PH_MASK 0xFFFFFF
#endif
#define PH_EN(k) ((PH_MASK >> (k)) & 1)
#define IN(k) (lo <= (k) && (k) < hi)
#define xcd_barrier_dummy() do { } while (0)
#define SEAM(k) do { if (IN((k) + 1)) GRID_BAR(); } while (0)
#define PHASE_FRAME(Fp) Frame Fp = F; { int l_ = (int)__builtin_amdgcn_mbcnt_hi(~0u, __builtin_amdgcn_mbcnt_lo(~0u, 0u)); asm volatile("" : "+v"(l_)); Fp.lane = l_; Fp.tid = F.wave * 64 + l_; int b_ = F.bid, g_ = F.G; asm volatile("" : "+s"(b_), "+s"(g_)); Fp.bid = b_; Fp.G = g_; }
#define LAYER_BODY(layer) { \
        const int pb = layer * PH_PER_LAYER; \
        if (layer == 0 && PH_EN(0) && IN(pb + 0)) { PHASE_FRAME(Fp); call_prologue(Fp, layer); if (PROBE_DUP == 0) { PHASE_FRAME(Fq); call_prologue(Fq, layer); } SEAM(pb + 0); } \
        if (PH_EN(1) && IN(pb + 1)) { \
            const WsPtrs W = make_W(F, layer); \
            pg8::Gemm g{layer == 0 ? W.xn : W.xr, W.win, M, ZW, D_MODEL}; pg8::StaticOrder S; S.init(M, ZW, F.G, F.bid); \
            pg8::EpiBf16<0> E{W.z, ZW, nullptr, 0, 0, 1.f, pg8::RowScale{layer == 0 ? (const float*)nullptr : (const float*)W.ssqp, 1.f / D_MODEL, NORM_EPS}, W.ropec, W.ropes, 0x15F0000u, SEQ - 1}; \
            pg8::gemm_phase<pg8::EpiBf16<0>, pg8::StaticOrder, PG8_ALIGN, PG8_SP2>(F.lds + RING_OFF, g, S, E, F.wave); \
            if (PROBE_DUP == 1) pg8::gemm_phase<pg8::EpiBf16<0>, pg8::StaticOrder, PG8_ALIGN, PG8_SP2>(F.lds + RING_OFF, g, S, E, F.wave); \
            { PHASE_FRAME(Fp); const int nwg_ = (M / 256) * (ZW / 256); \
              if ((nwg_ - Fp.bid + Fp.G - 1) / Fp.G < (nwg_ + Fp.G - 1) / Fp.G) {     \
                  const WsPtrs Wc = make_W(Fp, layer); unsigned* ch = conv_head(Fp, layer); \
                  for (int n_ = 0; n_ < CONV_TAIL; ++n_) { const int c = q_pop(Fp, ch); if (c >= NCONV) break; conv_pop(Fp, Wc, layer, c); } } } \
            SEAM(pb + 1); \
        } \
        if (PH_EN(2) && IN(pb + 2)) { PHASE_FRAME(Fp); { const WsPtrs W = make_W(Fp, layer); ph_vt(Fp, W); } call_mix1(Fp, layer); SEAM(pb + 2); } \
        if (PH_EN(4) && IN(pb + 4)) { for (int pass_ = (PROBE_DUP == 4 ? 0 : 1); pass_ < 2; ++pass_) { PHASE_FRAME(Fp); call_nsa(Fp, layer, pass_); } SEAM(pb + 4); } \
        if (PH_EN(6) && IN(pb + 6)) { \
            const WsPtrs W = make_W(F, layer); \
            pg8::Gemm g{W.mix, W.wout, M, D_MODEL, D_MODEL}; pg8::StaticOrder S; S.init(M, D_MODEL, F.G, F.bid); \
            if (layer == 0) { pg8::EpiRes<true> E{W.xr, (const void*)inptr(F, 0), D_MODEL, W.ssqp, 1.f, W.ssq, M}; pg8::gemm_phase<pg8::EpiRes<true>, pg8::StaticOrder, PG8_ALIGN, PG8_SP2, false, true>(F.lds + RING_OFF, g, S, E, F.wave); } \
            else { pg8::EpiRes<false> E{W.xr, (const void*)W.xr, D_MODEL, W.ssqp, 1.f, W.ssq, M}; pg8::gemm_phase<pg8::EpiRes<false>, pg8::StaticOrder, PG8_ALIGN, PG8_SP2, false, true>(F.lds + RING_OFF, g, S, E, F.wave); } \
            SEAM(pb + 6); \
        } \
        if (PH_EN(8) && IN(pb + 8)) { \
            const WsPtrs W = make_W(F, layer); \
            pg8::Gemm g{W.xr, W.wup, M, 2 * D_FF, D_MODEL}; pg8::StaticOrder S; S.init(M, 2 * D_FF, F.G, F.bid); \
            pg8::EpiGate E{pg8::RowScale{W.ssqp, 1.f / D_MODEL, NORM_EPS}, W.g, D_FF, inptr(F, 18) + (size_t)layer * 3 * 2 * D_FF, inptr(F, 19) + (size_t)layer * 2 * D_FF, D_FF, W.u}; \
            pg8::gemm_phase<pg8::EpiGate, pg8::StaticOrder, PG8_ALIGN, PG8_SP2>(F.lds + RING_OFF, g, S, E, F.wave); \
            SEAM(pb + 8); \
        } \
        if (PH_EN(9) && IN(pb + 9)) { PHASE_FRAME(Fp); const LayerPtrs L = make_L(Fp, layer); const WsPtrs W = make_W(Fp, layer); ph_ffn_gate(Fp, L, W); SEAM(pb + 9); } \
        if (PH_EN(10) && IN(pb + 10)) { \
            const WsPtrs W = make_W(F, layer); \
            pg8::Gemm g{W.g, W.wdn, M, D_MODEL, D_FF / 2}; pg8::StaticOrder S; S.init(M, D_MODEL, F.G, F.bid);     \
            pg8::EpiRes<false, true> E{W.xr, (const void*)W.xr, D_MODEL, W.ssqp, 1.f / (pg8::F8_GS * pg8::F8_WS)}; \
            pg8::gemm_phase<pg8::EpiRes<false, true>, pg8::StaticOrder, PG8_ALIGN, PG8_SP2, true>(F.lds + RING_OFF, g, S, E, F.wave); \
            SEAM(pb + 10); \
        } \
     \
    }
    LAYER_BODY(0)
    LAYER_BODY(1)
#undef LAYER_BODY
    if (IN(DEPTH * PH_PER_LAYER)) {
        PHASE_FRAME(Fp); const float* gain = inptr(Fp, 21);
        const int gw = Fp.bid * NWAVES + Fp.wave, NGW = Fp.G * NWAVES;
        const WsPtrs Wf = make_W(Fp, 0);
        for (int m = gw; m < M; m += NGW) rms_brow_to_f32(Wf.xr + (size_t)m * D_MODEL, gain, Fp.out + (size_t)m * D_MODEL, Fp.lane);
    }
#undef IN
#undef SEAM
}

extern "C" void kernel_launch(void* const* d_in, const int* in_sizes, int n_in, void* d_out, int out_size, void* d_ws, size_t ws_size, hipStream_t stream) {
    static int grid = 0;
    if (grid == 0) {
        if (n_in != 22 || in_sizes[0] != M * D_MODEL || out_size != M * D_MODEL || ws_size < WS_END) { fprintf(stderr, "kernel_launch: unexpected shapes (n_in %d, in0 %d, out %d, ws %zu < %zu); nothing launched\n", n_in, n_in > 0 ? in_sizes[0] : -1, out_size, ws_size, (size_t)WS_END); grid = -1; return; }
        int dev = 0, cus = 0, per_cu = 0;
        if (hipGetDevice(&dev) != hipSuccess || hipDeviceGetAttribute(&cus, hipDeviceAttributeMultiprocessorCount, dev) != hipSuccess) { fprintf(stderr, "kernel_launch: device query failed\n"); grid = -1; return; }
        if (hipFuncSetAttribute((const void*)hymba_fwd, hipFuncAttributeMaxDynamicSharedMemorySize, LDS_BYTES) != hipSuccess) { fprintf(stderr, "kernel_launch: hipFuncSetAttribute failed\n"); grid = -1; return; }
        if (hipOccupancyMaxActiveBlocksPerMultiprocessor(&per_cu, (const void*)hymba_fwd, NWAVES * 64, LDS_BYTES) != hipSuccess || per_cu < 1)
            fprintf(stderr, "kernel_launch: note: occupancy query reports %d workgroups per CU\n", per_cu);
        (void)hipGetLastError();
        grid = cus;
    }
    if (grid < 0) return;
    if (hipMemsetAsync((char*)d_ws + WS_CTL, 0, CTL_ZERO_BYTES, stream) != hipSuccess) { fprintf(stderr, "kernel_launch: memset failed\n"); return; }
    Args a{};
    for (int i = 0; i < 22; ++i) a.in[i] = (const float*)d_in[i];
    a.out = (float*)d_out; a.ws = (unsigned char*)d_ws; a.pad0 = 0; a.pad1 = 0;
#if MK_PER_PHASE
    for (int p = 0; p < N_PHASES; ++p) { a.ph_lo = p; a.ph_hi = p + 1; hipLaunchKernelGGL(hymba_fwd, dim3(grid), dim3(NWAVES * 64), LDS_BYTES, stream, a); }
#else
    a.ph_lo = 0; a.ph_hi = N_PHASES; hipLaunchKernelGGL(hymba_fwd, dim3(grid), dim3(NWAVES * 64), LDS_BYTES, stream, a);
#endif
    const hipError_t le = hipPeekAtLastError();
    if (le != hipSuccess) fprintf(stderr, "kernel_launch: launch failed: %s\n", hipGetErrorName(le));
}
```

```cpp
#include <hip/hip_runtime.h>
#include <cstdio>
#include <cstdint>
#ifndef PROBE_DUP
#define PROBE_DUP -1
#endif
namespace pg8 {
#define PG8_LAS __attribute__((address_space(3)))
typedef unsigned short bf16_t;
typedef short bf16x8 __attribute__((ext_vector_type(8)));
typedef float f32x4 __attribute__((ext_vector_type(4)));
typedef unsigned u32x4 __attribute__((ext_vector_type(4)));
constexpr int BM = 256, BK = 64, HALF = 128, HTB = HALF * BK * 2  , STAGE_BYTES = 8 * HTB, NXCD = 8, WGM = 8;

__host__ __device__ __forceinline__ int lds_byte(int r, int c) { const int st = (r >> 4) * 2 + (c >> 5), rr = r & 15, cc = c & 31, ob = rr * 64 + cc * 2; return st * 1024 + (ob ^ (((ob >> 9) & 1) << 5)); }
__host__ __device__ __forceinline__ void stage_rc(int b, int& R, int& C) { const int st = b / 1024, sb = b % 1024, swz = sb ^ (((sb >> 9) & 1) << 5); R = (st >> 1) * 16 + swz / 64; C = (st & 1) * 32 + (swz % 64) / 2; }
__host__ __device__ __forceinline__ int perm32(int rho) { const int n = rho >> 4, i = rho & 15; return 8 * (i >> 2) + 4 * n + (i & 3); }

struct Unit { int pm, pn; };
struct Gemm { const bf16_t* A; const bf16_t* Bt; int M, N, K; };

struct StaticOrder {
    int nM, nN, nwg, G, c;
    __host__ __device__ void init(int M, int N, int G_, int c_) { nM = M / BM; nN = N / BM; nwg = nM * nN; G = G_; c = c_; }
    __host__ __device__ bool next(int i, Unit& u) const {
        const long L = (long)i * G + c; if (L >= nwg) return false;
        int wgid = (int)L; { const int q = nwg / NXCD, r = nwg % NXCD, xcd = wgid % NXCD, off = wgid / NXCD; wgid = (xcd < r ? xcd * (q + 1) : r * (q + 1) + (xcd - r) * q) + off; }
        const int nig = WGM * nN, gid = wgid / nig, fm = gid * WGM, gsz = (nM - fm) < WGM ? (nM - fm) : WGM;
        u.pm = fm + ((wgid % nig) % gsz); u.pn = (wgid % nig) / gsz; return true;
    }
    __device__ __forceinline__ void a_ready(const Unit&) const {}
    __device__ __forceinline__ void done(const Unit&) const {}
};

__device__ __forceinline__ unsigned cvt_pk_bf16(float lo, float hi) { unsigned r; asm volatile("v_cvt_pk_bf16_f32 %0, %1, %2" : "=v"(r) : "v"(lo), "v"(hi)); return r; }
typedef float f32x2 __attribute__((ext_vector_type(2)));
typedef int i32x4 __attribute__((ext_vector_type(4)));
typedef int i32x8 __attribute__((ext_vector_type(8)));
constexpr float F8_GS = 8.f, F8_WS = 64.f;
__device__ __forceinline__ unsigned pk4_fp8(float a, float b, float c, float d) {
    a = __builtin_amdgcn_fmed3f(a, -448.f, 448.f); b = __builtin_amdgcn_fmed3f(b, -448.f, 448.f); c = __builtin_amdgcn_fmed3f(c, -448.f, 448.f); d = __builtin_amdgcn_fmed3f(d, -448.f, 448.f);
    unsigned w; asm volatile("v_cvt_pk_fp8_f32 %0, %1, %2\n\tv_cvt_pk_fp8_f32 %0, %3, %4 op_sel:[0,0,1]" : "=&v"(w) : "v"(a), "v"(b), "v"(c), "v"(d)); return w; }
__device__ __forceinline__ f32x2 gelu_pk(f32x2 v) {
    const f32x2 av = __builtin_elementwise_abs(v), d = av * 0.2316418882f + 1.0f;
    f32x2 t; t.x = __builtin_amdgcn_rcpf(d.x); t.y = __builtin_amdgcn_rcpf(d.y);
    f32x2 q = t * 0.5307027145f + (-0.7265760135f); q = q * t + 0.7107068705f; q = q * t + (-0.142248368f); q = q * t + 0.127414796f; q = q * t;
    const f32x2 s = (v * v) * (-0.72134752044f);
    f32x2 e; e.x = __builtin_amdgcn_exp2f(s.x); e.y = __builtin_amdgcn_exp2f(s.y);
    const f32x2 m = v * (q * e), r = v - m;
    f32x2 o; o.x = v.x < 0.f ? m.x : r.x; o.y = v.y < 0.f ? m.y : r.y; return o;
}

constexpr int RS_OFF = STAGE_BYTES;
struct RowScale {
    const float* part; float inv_n, eps;
    __device__ __forceinline__ void begin(const Unit& u, int slot, int tid, PG8_LAS unsigned char* lds) const {
        if (part != nullptr && tid < BM) { const f32x4* p = (const f32x4*)(part + (size_t)(u.pm * BM + tid) * 64); float s = 0.f;
#pragma unroll
            for (int j = 0; j < 16; ++j) { const f32x4 v = p[j]; s += (v[0] + v[1]) + (v[2] + v[3]); }
            ((PG8_LAS float*)(lds + RS_OFF))[slot * BM + tid] = 1.0f / sqrtf(s * inv_n + eps); }
    }
    __device__ __forceinline__ float get(PG8_LAS unsigned char* lds, int slot, int r) const { return part != nullptr ? ((const PG8_LAS float*)(lds + RS_OFF))[slot * BM + r] : 1.f; }
};
template <int ACT  > struct EpiBf16 {
    static constexpr bool PERM = true, AFTER_DRAIN = false; static_assert(ACT == 0 || ACT == 1, "EpiBf16: ACT is 0 (none) or 1 (gelu_pk)");
    bf16_t* O; int ldc; const float* bias; int split_cols; size_t split_stride; float scale0;
    RowScale rsc;
    __device__ __forceinline__ void begin(const Unit& u, int slot, int tid, PG8_LAS unsigned char* lds) const { rsc.begin(u, slot, tid, lds); }
    const float* rc; const float* rs; unsigned rmask; int posmask;
    static __device__ __forceinline__ float other32(float v, bool hi) { auto rr = __builtin_amdgcn_permlane32_swap(__builtin_bit_cast(unsigned, v), __builtin_bit_cast(unsigned, v), false, false); return __builtin_bit_cast(float, hi ? rr[0] : rr[1]); }
    __device__ __forceinline__ void operator()(const f32x4 (&acc)[2][2][4][2], const Unit& u, int wr, int wc, int fr, int fq, PG8_LAS unsigned char* lds, int slot) const {
        const int row0 = u.pm * BM + wr * 64 + fr; int colt = u.pn * BM; bf16_t* base = O;
        float sc = 1.f; if (split_cols) { const int t = colt / split_cols; base += (size_t)t * split_stride; colt -= t * split_cols; if (t == 0) sc = scale0; }
        const int col0 = colt + wc * 32 + 8 * fq, bcol0 = u.pn * BM + wc * 32 + 8 * fq;
        const bool do_rope = rc != nullptr && wc == 0 && ((rmask >> u.pn) & 1u);
        f32x4 bv[2][2];
#pragma unroll
        for (int bj = 0; bj < 2; ++bj)
#pragma unroll
            for (int n = 0; n < 2; ++n) bv[bj][n] = bias ? *(const f32x4*)(bias + bcol0 + bj * HALF + 4 * n) : (f32x4){0.f, 0.f, 0.f, 0.f};
#pragma unroll
        for (int ai = 0; ai < 2; ++ai)
#pragma unroll
            for (int m = 0; m < 4; ++m) { bf16_t* rowp = base + (size_t)(row0 + ai * HALF + m * 16) * ldc + col0;
                f32x4 c0 = {1.f, 1.f, 1.f, 1.f}, c1 = c0, s0 = {0.f, 0.f, 0.f, 0.f}, s1 = s0;
                if (do_rope) { const int pos = (row0 + ai * HALF + m * 16) & posmask; const float* tc = rc + pos * 16 + 8 * (fq & 1); const float* ts = rs + pos * 16 + 8 * (fq & 1);
                    c0 = *(const f32x4*)tc; c1 = *(const f32x4*)(tc + 4); s0 = *(const f32x4*)ts; s1 = *(const f32x4*)(ts + 4); if (fq < 2) { s0 = -s0; s1 = -s1; } }
                const float rsv = rsc.get(lds, slot, ai * HALF + wr * 64 + m * 16 + fr);
#pragma unroll
                for (int bj = 0; bj < 2; ++bj) { f32x4 v0 = (acc[ai][bj][m][0] + bv[bj][0]) * rsv, v1 = (acc[ai][bj][m][1] + bv[bj][1]) * rsv;
                    if (do_rope) {
#pragma unroll
                        for (int i = 0; i < 4; ++i) { const float p0 = other32(v0[i], fq >= 2), p1 = other32(v1[i], fq >= 2); v0[i] = v0[i] * c0[i] + p0 * s0[i]; v1[i] = v1[i] * c1[i] + p1 * s1[i]; } }
                    if (ACT == 1) { f32x2 a = gelu_pk((f32x2){v0[0], v0[1]}), b = gelu_pk((f32x2){v0[2], v0[3]}), c = gelu_pk((f32x2){v1[0], v1[1]}), d = gelu_pk((f32x2){v1[2], v1[3]});
                        v0 = (f32x4){a.x, a.y, b.x, b.y}; v1 = (f32x4){c.x, c.y, d.x, d.y}; }
                    v0 = v0 * sc; v1 = v1 * sc; u32x4 w; w.x = cvt_pk_bf16(v0[0], v0[1]); w.y = cvt_pk_bf16(v0[2], v0[3]); w.z = cvt_pk_bf16(v1[0], v1[1]); w.w = cvt_pk_bf16(v1[2], v1[3]);
                    *(u32x4*)(rowp + bj * HALF) = w; } }
    }
};
template <bool RF32, bool SC = false> struct EpiRes {
    static constexpr bool PERM = true, AFTER_DRAIN = false;
    bf16_t* X; const void* R; int ldc; float* SSQP; float osc = 1.f;
    const float* hssq = nullptr; int hM = 0;
    __device__ __forceinline__ void begin(const Unit& u, int slot, int tid, PG8_LAS unsigned char* lds) const {
        if (hssq != nullptr && tid < BM) { const float* p = hssq + u.pm * BM + tid; float s = 0.f;
#pragma unroll
            for (int h = 0; h < 8; ++h) s += p[(size_t)h * hM];
            ((PG8_LAS float*)(lds + RS_OFF))[slot * BM + tid] = 1.0f / sqrtf(s * (1.f / 1024.f) + 1e-6f); } }
    __device__ __forceinline__ void mid(f32x4 (&acc)[2][2][4][2], int wr, int fr, PG8_LAS unsigned char* lds, int slot) const {
#pragma unroll
        for (int ai = 0; ai < 2; ++ai)
#pragma unroll
            for (int m = 0; m < 4; ++m) { const float rs = ((const PG8_LAS float*)(lds + RS_OFF))[slot * BM + ai * HALF + wr * 64 + m * 16 + fr];
#pragma unroll
                for (int bj = 0; bj < 2; ++bj)
#pragma unroll
                    for (int n = 0; n < 2; ++n) acc[ai][bj][m][n] = acc[ai][bj][m][n] * rs; } }
    static __device__ __forceinline__ float sq8(const u32x4 w) { float s = 0.f; const unsigned a[4] = {w.x, w.y, w.z, w.w};
#pragma unroll
        for (int i = 0; i < 4; ++i) { const float lo = __builtin_bit_cast(float, a[i] << 16), hi = __builtin_bit_cast(float, a[i] & 0xffff0000u); s += lo * lo + hi * hi; } return s; }
    __device__ __forceinline__ void put_ssq(float ss, int row, const Unit& u, int wc, int fq) const {
        ss += __builtin_bit_cast(float, __builtin_amdgcn_ds_swizzle(__builtin_bit_cast(int, ss), 0x401F));
        if ((fq & 1) == 0) SSQP[(size_t)row * 64 + u.pn * 8 + wc * 2 + (fq >> 1)] = ss; }
    __device__ __forceinline__ void operator()(const f32x4 (&acc)[2][2][4][2], const Unit& u, int wr, int wc, int fr, int fq, PG8_LAS unsigned char* lds, int slot) const {
        const int row0 = u.pm * BM + wr * 64 + fr, col0 = u.pn * BM + wc * 32 + 8 * fq;
#pragma unroll
        for (int ai = 0; ai < 2; ++ai) {
            if constexpr (RF32) {
                f32x4 rv[4][2][2];
#pragma unroll
                for (int m = 0; m < 4; ++m) { const size_t off = (size_t)(row0 + ai * HALF + m * 16) * ldc + col0;
#pragma unroll
                    for (int bj = 0; bj < 2; ++bj)
#pragma unroll
                        for (int n = 0; n < 2; ++n) rv[m][bj][n] = *(const f32x4*)((const float*)R + off + bj * HALF + n * 4); }
#pragma unroll
                for (int m = 0; m < 4; ++m) { const size_t off = (size_t)(row0 + ai * HALF + m * 16) * ldc + col0; float ss = 0.f;
#pragma unroll
                    for (int bj = 0; bj < 2; ++bj) { const f32x4 v0 = acc[ai][bj][m][0] + rv[m][bj][0], v1 = acc[ai][bj][m][1] + rv[m][bj][1];
                        u32x4 w; w.x = cvt_pk_bf16(v0[0], v0[1]); w.y = cvt_pk_bf16(v0[2], v0[3]); w.z = cvt_pk_bf16(v1[0], v1[1]); w.w = cvt_pk_bf16(v1[2], v1[3]);
                        ss += sq8(w); *(u32x4*)(X + off + bj * HALF) = w; }
                    put_ssq(ss, row0 + ai * HALF + m * 16, u, wc, fq); }
            } else {
                u32x4 rv[4][2];
#pragma unroll
                for (int m = 0; m < 4; ++m) { const size_t off = (size_t)(row0 + ai * HALF + m * 16) * ldc + col0;
#pragma unroll
                    for (int bj = 0; bj < 2; ++bj) rv[m][bj] = *(const u32x4*)((const bf16_t*)R + off + bj * HALF); }
#pragma unroll
                for (int m = 0; m < 4; ++m) { const size_t off = (size_t)(row0 + ai * HALF + m * 16) * ldc + col0; float ss = 0.f;
#pragma unroll
                    for (int bj = 0; bj < 2; ++bj) { const u32x4 r = rv[m][bj];
                        const f32x4 r0 = (f32x4){__builtin_bit_cast(float, r.x << 16), __builtin_bit_cast(float, r.x & 0xffff0000u), __builtin_bit_cast(float, r.y << 16), __builtin_bit_cast(float, r.y & 0xffff0000u)};
                        const f32x4 r1 = (f32x4){__builtin_bit_cast(float, r.z << 16), __builtin_bit_cast(float, r.z & 0xffff0000u), __builtin_bit_cast(float, r.w << 16), __builtin_bit_cast(float, r.w & 0xffff0000u)};
                        const f32x4 v0 = SC ? acc[ai][bj][m][0] * osc + r0 : acc[ai][bj][m][0] + r0, v1 = SC ? acc[ai][bj][m][1] * osc + r1 : acc[ai][bj][m][1] + r1;
                        u32x4 w; w.x = cvt_pk_bf16(v0[0], v0[1]); w.y = cvt_pk_bf16(v0[2], v0[3]); w.z = cvt_pk_bf16(v1[0], v1[1]); w.w = cvt_pk_bf16(v1[2], v1[3]);
                        ss += sq8(w); *(u32x4*)(X + off + bj * HALF) = w; }
                    put_ssq(ss, row0 + ai * HALF + m * 16, u, wc, fq); }
            }
            asm volatile("" ::: "memory");
        }
    }
};

struct EpiGate {
    static constexpr bool PERM = true, AFTER_DRAIN = false;
    RowScale rsc;
    __device__ __forceinline__ void begin(const Unit& u, int slot, int tid, PG8_LAS unsigned char* lds) const { rsc.begin(u, slot, tid, lds); }
    bf16_t* G; int ldg; const float* cw; const float* cb; int dff; bf16_t* edge;
    __device__ __forceinline__ void operator()(const f32x4 (&acc)[2][2][4][2], const Unit& u, int wr, int wc, int fr, int fq, PG8_LAS unsigned char* lds, int slot) const {
        const int f0 = u.pn * 128 + wc * 32 + 8 * fq;
        const float m0 = fr == 0 ? 1.f : 0.f, m01 = fr < 2 ? 1.f : 0.f;
#define PG8_DPP(v, ctrl) __builtin_bit_cast(float, __builtin_amdgcn_update_dpp(0, __builtin_bit_cast(int, (v)), (ctrl), 0xf, 0xf, true))
#pragma unroll
        for (int ai = 0; ai < 2; ++ai) {
            const int rowb = u.pm * BM + ai * HALF + wr * 64;
            unsigned og[4][2];
            float rsv[4];
#pragma unroll
            for (int m = 0; m < 4; ++m) rsv[m] = rsc.get(lds, slot, ai * HALF + wr * 64 + 16 * m + fr);
#pragma unroll
            for (int n = 0; n < 2; ++n) {
                const float* pw = cw + f0 + 4 * n; const float* pb = cb + f0 + 4 * n;
                const f32x4 g0 = *(const f32x4*)pw, g1 = *(const f32x4*)(pw + 2 * dff), g2 = *(const f32x4*)(pw + 4 * dff), gb = *(const f32x4*)pb;
                const f32x4 u0 = *(const f32x4*)(pw + dff), u1 = *(const f32x4*)(pw + 3 * dff), u2 = *(const f32x4*)(pw + 5 * dff), ub = *(const f32x4*)(pb + dff);
#pragma unroll
                for (int m = 0; m < 4; ++m) {
                    float yo[4];
#pragma unroll
                    for (int i = 0; i < 4; ++i) {
                        const float xg = acc[ai][0][m][n][i] * rsv[m], xu = acc[ai][1][m][n][i] * rsv[m];
                        float yg = gb[i] + g2[i] * xg + g1[i] * PG8_DPP(xg, 0x111) + g0[i] * PG8_DPP(xg, 0x112);
                        float yu = ub[i] + u2[i] * xu + u1[i] * PG8_DPP(xu, 0x111) + u0[i] * PG8_DPP(xu, 0x112);
                        if (m > 0) { const float pg = acc[ai][0][m - 1][n][i] * rsv[m - 1], pu = acc[ai][1][m - 1][n][i] * rsv[m - 1];
                            yg += (g1[i] * m0) * PG8_DPP(pg, 0x121) + (g0[i] * m01) * PG8_DPP(pg, 0x122);
                            yu += (u1[i] * m0) * PG8_DPP(pu, 0x121) + (u0[i] * m01) * PG8_DPP(pu, 0x122); }
                        const float sg = yg * __builtin_amdgcn_rcpf(1.f + __builtin_amdgcn_exp2f(-1.4426950408889634f * yg));
                        yo[i] = sg * yu;
                    }
                    og[m][n] = pk4_fp8(yo[0] * F8_GS, yo[1] * F8_GS, yo[2] * F8_GS, yo[3] * F8_GS);
                }
            }
#pragma unroll
            for (int m = 0; m < 4; ++m) {
                if (m > 0 || fr >= 2) { unsigned long long w = (unsigned long long)og[m][0] | ((unsigned long long)og[m][1] << 32); *(unsigned long long*)((unsigned char*)G + (size_t)(rowb + 16 * m + fr) * ldg + f0) = w; }
            }
            if (fr < 2 || fr >= 14) { const int m = fr < 2 ? 0 : 3, e = fr < 2 ? fr : fr - 12;
                bf16_t* ep = edge + ((size_t)(rowb >> 6) * 4 + e) * (2 * dff) + f0;
                u32x4 wg, wu;
                if (fr < 2) { wg.x = cvt_pk_bf16((acc[ai][0][0][0][0] * rsv[0]), (acc[ai][0][0][0][1] * rsv[0])); wg.y = cvt_pk_bf16((acc[ai][0][0][0][2] * rsv[0]), (acc[ai][0][0][0][3] * rsv[0])); wg.z = cvt_pk_bf16((acc[ai][0][0][1][0] * rsv[0]), (acc[ai][0][0][1][1] * rsv[0])); wg.w = cvt_pk_bf16((acc[ai][0][0][1][2] * rsv[0]), (acc[ai][0][0][1][3] * rsv[0]));
                              wu.x = cvt_pk_bf16((acc[ai][1][0][0][0] * rsv[0]), (acc[ai][1][0][0][1] * rsv[0])); wu.y = cvt_pk_bf16((acc[ai][1][0][0][2] * rsv[0]), (acc[ai][1][0][0][3] * rsv[0])); wu.z = cvt_pk_bf16((acc[ai][1][0][1][0] * rsv[0]), (acc[ai][1][0][1][1] * rsv[0])); wu.w = cvt_pk_bf16((acc[ai][1][0][1][2] * rsv[0]), (acc[ai][1][0][1][3] * rsv[0])); }
                else {        wg.x = cvt_pk_bf16((acc[ai][0][3][0][0] * rsv[3]), (acc[ai][0][3][0][1] * rsv[3])); wg.y = cvt_pk_bf16((acc[ai][0][3][0][2] * rsv[3]), (acc[ai][0][3][0][3] * rsv[3])); wg.z = cvt_pk_bf16((acc[ai][0][3][1][0] * rsv[3]), (acc[ai][0][3][1][1] * rsv[3])); wg.w = cvt_pk_bf16((acc[ai][0][3][1][2] * rsv[3]), (acc[ai][0][3][1][3] * rsv[3]));
                              wu.x = cvt_pk_bf16((acc[ai][1][3][0][0] * rsv[3]), (acc[ai][1][3][0][1] * rsv[3])); wu.y = cvt_pk_bf16((acc[ai][1][3][0][2] * rsv[3]), (acc[ai][1][3][0][3] * rsv[3])); wu.z = cvt_pk_bf16((acc[ai][1][3][1][0] * rsv[3]), (acc[ai][1][3][1][1] * rsv[3])); wu.w = cvt_pk_bf16((acc[ai][1][3][1][2] * rsv[3]), (acc[ai][1][3][1][3] * rsv[3])); }
                (void)m; *(u32x4*)ep = wg; *(u32x4*)(ep + dff) = wu; }
        }
#undef PG8_DPP
    }
};

template <bool F8> struct Frag;
template <> struct Frag<false> { bf16x8 k[2]; __device__ __forceinline__ void ld(int i, const PG8_LAS unsigned char* p) { k[i] = *(const PG8_LAS bf16x8*)p; } };
template <> struct Frag<true> { i32x8 v; __device__ __forceinline__ void ld(int i, const PG8_LAS unsigned char* p) { if (i == 0) v.lo = *(const PG8_LAS i32x4*)p; else v.hi = *(const PG8_LAS i32x4*)p; } };
template <class Epi, class Sched, bool ALIGN_EPI = false, bool SP2 = false, bool F8 = false, bool KROT = false>
__device__ __forceinline__ void gemm_phase(PG8_LAS unsigned char* lds, const Gemm g, const Sched& S, const Epi& E, const int wave_id) {
    int lane_ = (int)__builtin_amdgcn_mbcnt_hi(~0u, __builtin_amdgcn_mbcnt_lo(~0u, 0u)); asm volatile("" : "+v"(lane_));
    const int tid = wave_id * 64 + lane_, wid = __builtin_amdgcn_readfirstlane(tid >> 6), lane = tid & 63, wr = wid >> 2, wc = wid & 3, fr = lane & 15, fq = lane >> 4;
    const int K = g.K, nt = K / BK;
    unsigned voffA[2], voffB[2];
#pragma unroll
    for (int i = 0; i < 2; ++i) { int R, C; stage_rc(tid * 16 + i * 8192, R, C); const int Rb = Epi::PERM ? ((R & ~31) + perm32(R & 31)) : R;
        voffA[i] = (unsigned)(R * K + C) * 2u; voffB[i] = (unsigned)(Rb * K + C) * 2u; }
    const size_t kstep = (size_t)(BK * 2);
    const size_t rot = KROT ? (size_t)(nt / 2) * kstep : 0;
#define PG8_KO(t) (KROT ? (size_t)(((t) + nt / 2) & (nt - 1)) * kstep : (size_t)(t) * kstep)
    const size_t hstep = (size_t)HALF * K * 2;
    const size_t tstep = 2 * hstep;
    const unsigned ldsw = (unsigned)wid * 1024u;
    const int aoff = lds_byte(wr * 64 + fr, fq * 8), boff = lds_byte(wc * 32 + fr, fq * 8);
#define PG8_SA(b, h) (((b) * 2 + (h)) * HTB)
#define PG8_SB(b, h) ((4 + (b) * 2 + (h)) * HTB)
#define PG8_STAGE(bufoff, gbase, voff) do { _Pragma("unroll") for (int _i = 0; _i < 2; ++_i) \
        __builtin_amdgcn_global_load_lds((const unsigned*)((const char*)(gbase) + (voff)[_i]), (PG8_LAS unsigned*)(lds + (bufoff) + ldsw + _i * 8192), 16, 0, 0); } while (0)
#define PG8_LDA(dst, b, h) do { _Pragma("unroll") for (int m = 0; m < 4; ++m) _Pragma("unroll") for (int k = 0; k < 2; ++k) dst[m].ld(k, lds + PG8_SA(b, h) + aoff + m * 2048 + k * 1024); } while (0)
#define PG8_LDB(dst, b, h) do { _Pragma("unroll") for (int n = 0; n < 2; ++n) _Pragma("unroll") for (int k = 0; k < 2; ++k) dst[n].ld(k, lds + PG8_SB(b, h) + boff + n * 2048 + k * 1024); } while (0)
#define PG8_MMA(ai, bj, At, Bt) do { __builtin_amdgcn_s_setprio(1); _Pragma("unroll") for (int m = 0; m < 4; ++m) _Pragma("unroll") for (int n = 0; n < 2; ++n) { \
        if constexpr (F8) asm volatile("v_mfma_f32_16x16x128_f8f6f4 %0, %1, %2, %0" : "+v"(acc[ai][bj][m][n]) : "v"(Bt[n].v), "v"(At[m].v));         \
        else { _Pragma("unroll") for (int k = 0; k < 2; ++k) acc[ai][bj][m][n] = __builtin_amdgcn_mfma_f32_16x16x32_bf16(Bt[n].k[k], At[m].k[k], acc[ai][bj][m][n], 0, 0, 0); } } __builtin_amdgcn_s_setprio(0); } while (0)
#define PG8_WAIT_V(n) asm volatile("s_waitcnt vmcnt(" #n ")" ::: "memory")
#define PG8_WAIT_L(n) asm volatile("s_waitcnt lgkmcnt(" #n ")" ::: "memory")
#define PG8_BAR __builtin_amdgcn_s_barrier()
#define PG8_SCHED __builtin_amdgcn_sched_barrier(0)
    Unit cur, nxt; int ui = 0;
    if (!S.next(0, cur)) return;
    f32x4 acc[2][2][4][2];
#pragma unroll
    for (int a = 0; a < 2; ++a)
#pragma unroll
        for (int b = 0; b < 2; ++b)
#pragma unroll
            for (int m = 0; m < 4; ++m)
#pragma unroll
                for (int n = 0; n < 2; ++n) acc[a][b][m][n] = (f32x4){0.f, 0.f, 0.f, 0.f};
    Frag<F8> At[4], B0[2], B1[2];
    const char* cA = (const char*)g.A + (size_t)cur.pm * tstep; const char* cB = (const char*)g.Bt + (size_t)cur.pn * tstep;
    S.a_ready(cur);
    E.begin(cur, 0, tid, lds);
    if constexpr (SP2) {
        PG8_STAGE(PG8_SB(0, 0), cB + rot, voffB); PG8_STAGE(PG8_SB(0, 1), cB + rot + hstep, voffB); PG8_STAGE(PG8_SA(0, 0), cA + rot, voffA); PG8_STAGE(PG8_SA(0, 1), cA + rot + hstep, voffA);
        if (wr == 1) PG8_BAR;
        PG8_WAIT_V(2); PG8_BAR;
        PG8_STAGE(PG8_SB(1, 0), cB + rot + kstep, voffB); PG8_STAGE(PG8_SA(1, 0), cA + rot + kstep, voffA); PG8_STAGE(PG8_SB(1, 1), cB + rot + hstep + kstep, voffB);
        PG8_WAIT_V(6); PG8_BAR;
    } else {
        PG8_STAGE(PG8_SB(0, 0), cB, voffB); PG8_STAGE(PG8_SA(0, 0), cA, voffA); PG8_STAGE(PG8_SB(0, 1), cB + hstep, voffB); PG8_STAGE(PG8_SA(0, 1), cA + hstep, voffA);
        if (wr == 1) PG8_BAR;
        PG8_WAIT_V(4); PG8_BAR;
        PG8_STAGE(PG8_SB(1, 0), cB + kstep, voffB); PG8_STAGE(PG8_SA(1, 0), cA + kstep, voffA); PG8_STAGE(PG8_SB(1, 1), cB + hstep + kstep, voffB);
        PG8_WAIT_V(6); PG8_BAR;
    }
    for (;;) {
        const bool has_next = S.next(ui + 1, nxt);
        const char* nA = has_next ? (const char*)g.A + (size_t)nxt.pm * tstep : cA; const char* nB = has_next ? (const char*)g.Bt + (size_t)nxt.pn * tstep : cB;
        for (int t = 0; t < nt; t += 2) {
            const bool last = (t == nt - 2);
            const char* a1 = cA + PG8_KO(t + 1);
            const char* a2 = last ? nA + rot : cA + PG8_KO(t + 2); const char* b2 = last ? nB + rot : cB + PG8_KO(t + 2);
            const char* a3 = a2 + kstep; const char* b3 = b2 + kstep;
            if (last && has_next) S.a_ready(nxt);
            if constexpr (SP2) {
            PG8_LDB(B0, 0, 0); PG8_LDB(B1, 0, 1); PG8_SCHED; PG8_LDA(At, 0, 0); PG8_STAGE(PG8_SA(1, 1), a1 + hstep, voffA);
            PG8_WAIT_V(8); PG8_WAIT_L(0); PG8_BAR; PG8_MMA(0, 0, At, B0); PG8_MMA(0, 1, At, B1); PG8_BAR; PG8_SCHED;
            PG8_LDA(At, 0, 1); PG8_STAGE(PG8_SB(0, 0), b2, voffB); PG8_STAGE(PG8_SB(0, 1), b2 + hstep, voffB); PG8_STAGE(PG8_SA(0, 0), a2, voffA);
            PG8_WAIT_V(8); PG8_WAIT_L(0); PG8_BAR; PG8_MMA(1, 0, At, B0); PG8_MMA(1, 1, At, B1); PG8_BAR; PG8_SCHED;
            PG8_LDB(B0, 1, 0); PG8_LDB(B1, 1, 1); PG8_SCHED; PG8_LDA(At, 1, 0); PG8_STAGE(PG8_SA(0, 1), a2 + hstep, voffA);
            PG8_WAIT_V(8); PG8_WAIT_L(0); PG8_BAR; PG8_MMA(0, 0, At, B0); PG8_MMA(0, 1, At, B1); PG8_BAR; PG8_SCHED;
            PG8_LDA(At, 1, 1); PG8_STAGE(PG8_SB(1, 0), b3, voffB); PG8_STAGE(PG8_SB(1, 1), b3 + hstep, voffB); PG8_STAGE(PG8_SA(1, 0), a3, voffA);
            PG8_WAIT_V(8); PG8_WAIT_L(0); PG8_BAR; PG8_MMA(1, 0, At, B0); PG8_MMA(1, 1, At, B1); PG8_BAR; PG8_SCHED;
            } else {
            PG8_LDB(B0, 0, 0); PG8_SCHED; PG8_LDA(At, 0, 0); PG8_STAGE(PG8_SA(1, 1), a1 + hstep, voffA);
            PG8_WAIT_L(8); PG8_BAR; PG8_WAIT_L(0); PG8_MMA(0, 0, At, B0); PG8_BAR; PG8_SCHED;
            PG8_LDB(B1, 0, 1); PG8_STAGE(PG8_SB(0, 0), b2, voffB);
            PG8_BAR; PG8_WAIT_L(0); PG8_MMA(0, 1, At, B1); PG8_BAR;
            PG8_LDA(At, 0, 1); PG8_STAGE(PG8_SA(0, 0), a2, voffA);
            PG8_BAR; PG8_WAIT_L(0); PG8_MMA(1, 0, At, B0); PG8_BAR; PG8_SCHED;
            PG8_STAGE(PG8_SB(0, 1), b2 + hstep, voffB);
            PG8_WAIT_V(6); PG8_BAR; PG8_MMA(1, 1, At, B1); PG8_BAR;
            PG8_LDB(B0, 1, 0); PG8_SCHED; PG8_LDA(At, 1, 0); PG8_STAGE(PG8_SA(0, 1), a2 + hstep, voffA);
            PG8_WAIT_L(8); PG8_BAR; PG8_WAIT_L(0); PG8_MMA(0, 0, At, B0); PG8_BAR; PG8_SCHED;
            PG8_LDB(B1, 1, 1); PG8_STAGE(PG8_SB(1, 0), b3, voffB);
            PG8_BAR; PG8_WAIT_L(0); PG8_MMA(0, 1, At, B1); PG8_BAR;
            PG8_LDA(At, 1, 1); PG8_STAGE(PG8_SA(1, 0), a3, voffA);
            PG8_BAR; PG8_WAIT_L(0); PG8_MMA(1, 0, At, B0); PG8_BAR; PG8_SCHED;
            PG8_STAGE(PG8_SB(1, 1), b3 + hstep, voffB);
            PG8_WAIT_V(6); PG8_BAR; PG8_MMA(1, 1, At, B1); PG8_BAR;
            }
            if constexpr (KROT) { if (t == nt / 2 - 2) E.mid(acc, wr, fr, lds, ui & 1); }
        }
        if constexpr (ALIGN_EPI) { if (wr == 0) PG8_BAR; }
        if constexpr (F8) asm volatile("s_nop 15\n\ts_nop 15" ::: "memory");
        if (has_next) E.begin(nxt, (ui + 1) & 1, tid, lds);
        if constexpr (!Epi::AFTER_DRAIN) { int le = lane; asm volatile("" : "+v"(le));
            E(acc, cur, wr, wc, le & 15, le >> 4, lds, ui & 1); S.done(cur); }
        if (!has_next) break;
#pragma unroll
        for (int a = 0; a < 2; ++a)
#pragma unroll
            for (int b = 0; b < 2; ++b)
#pragma unroll
                for (int m = 0; m < 4; ++m)
#pragma unroll
                    for (int n = 0; n < 2; ++n) acc[a][b][m][n] = (f32x4){0.f, 0.f, 0.f, 0.f};
        cur = nxt; cA = nA; cB = nB; ++ui;
        if constexpr (ALIGN_EPI) { if (wr == 1) PG8_BAR; }
    }
    PG8_WAIT_V(0);
    if constexpr (!ALIGN_EPI) { if (wr == 0) PG8_BAR; }
    PG8_BAR;
    if constexpr (Epi::AFTER_DRAIN) { E.fused(acc, cur, wr, wc, fr, fq, lds, wid, lane); S.done(cur); }
#undef PG8_KO
#undef PG8_SA
#undef PG8_SB
#undef PG8_STAGE
#undef PG8_LDA
#undef PG8_LDB
#undef PG8_MMA
#undef PG8_WAIT_V
#undef PG8_WAIT_L
#undef PG8_BAR
#undef PG8_SCHED
}
}

#ifndef PG8_SP2
#define PG8_SP2 true
#endif
#ifndef PG8_ALIGN
#define PG8_ALIGN true
#endif
constexpr int NWAVES = 8;
#ifndef MK_PER_PHASE
#define MK_PER_PHASE 0
#endif
constexpr int D_MODEL = 2048, BATCH = 8, SEQ = 2048, DEPTH = 2, M = BATCH * SEQ;
constexpr int NCMP = 127, NSEL = 32, TOPK = 16, WINDOW = 512;
constexpr int D_FF = 5632, N_IN = 6696, ZW = 6912;
constexpr float NORM_EPS = 1e-6f;
constexpr int ZC_MQ = 0, ZC_MK = 1024, ZC_MV = 2048, ZC_MO = 3072, ZC_NQ = 4096, ZC_KC = 5120, ZC_VC = 5376, ZC_KS = 5632, ZC_VS = 5888, ZC_KW = 6144, ZC_VW = 6400, ZC_MI = 6656, ZC_MF = 6664, ZC_NG = 6672;
__host__ __device__ __forceinline__ int colmap_in(int nd) {
    if (nd < 4096) return nd; if (nd < 6656) return nd + 16; if (nd < 6672) return nd - 2560; if (nd < N_IN) return nd; return -1; }
constexpr int PH_PER_LAYER = 11, N_PHASES = DEPTH * PH_PER_LAYER + 1;

constexpr size_t MiB = 1u << 20;
constexpr size_t WS_CTL = 0, CTL_ZERO_BYTES = 1 * MiB;
constexpr size_t WS_ROPE = 1 * MiB;
constexpr size_t WS_SSQ = WS_ROPE + 512 * 1024;
constexpr size_t WS_PBP = WS_ROPE + 640 * 1024, WS_PB = WS_ROPE + 768 * 1024;
constexpr size_t WS_WIN = 2 * MiB, WS_WOUT = 29 * MiB, WS_WUP = 37 * MiB, WS_WDN = 81 * MiB;
constexpr size_t WS_C1K = 103 * MiB, WS_C1V = 105 * MiB, WS_C2K = 107 * MiB, WS_C2V = 107 * MiB + 512 * 1024;
constexpr size_t WS_XN = 108 * MiB;
constexpr size_t WS_Z = 172 * MiB;
constexpr size_t WS_MIX = 388 * MiB;
constexpr size_t WS_KCMP = 452 * MiB, WS_VCMP = 453 * MiB;
constexpr size_t WS_OACC = 456 * MiB;
constexpr size_t WS_VTS = 520 * MiB, WS_VTW = 528 * MiB;
constexpr size_t WS_G = 172 * MiB;
constexpr size_t WS_EDGE = 348 * MiB;
constexpr size_t WS_L1 = 540 * MiB;
constexpr size_t WS_PBP1 = WS_L1 + 107 * MiB;
constexpr size_t WS_SSQP = 536 * MiB;
constexpr size_t WS_XR = 576 * MiB;
constexpr size_t WS_END = 700 * MiB;
constexpr int CW_BAR = 4096;
constexpr int CW_PB = 16384;

constexpr int RING_OFF = 0, RING_BYTES = 135168;
constexpr int LDSCTL_OFF = RING_BYTES, MISC_OFF = LDSCTL_OFF + 320;
constexpr int LDS_BYTES = 147456;

#define GAS __attribute__((address_space(1)))
#define LAS __attribute__((address_space(3)))
typedef unsigned short bf16;
typedef unsigned v4u __attribute__((ext_vector_type(4)));
typedef float f32x4 __attribute__((ext_vector_type(4)));
typedef short bf16x8 __attribute__((ext_vector_type(8)));
typedef GAS unsigned gu32;
#define RLX_AGENT __ATOMIC_RELAXED, __HIP_MEMORY_SCOPE_AGENT
#define LDS_WAIT() asm volatile("s_waitcnt lgkmcnt(0)" ::: "memory")
#define VM_WAIT() asm volatile("s_waitcnt vmcnt(0)" ::: "memory")
__device__ __forceinline__ unsigned f2bf(float f) { unsigned u = __builtin_bit_cast(unsigned, f); return (u + 0x7fffu + ((u >> 16) & 1u)) >> 16; }
__device__ __forceinline__ unsigned pk2(float lo, float hi) { return f2bf(lo) | (f2bf(hi) << 16); }
typedef float f32x2t_ __attribute__((ext_vector_type(2)));
typedef __bf16 bf16x2t_ __attribute__((ext_vector_type(2)));
__device__ __forceinline__ unsigned cvtpk(float lo, float hi) { const f32x2t_ v = {lo, hi}; return __builtin_bit_cast(unsigned, __builtin_convertvector(v, bf16x2t_)); }
__device__ __forceinline__ float bf2f(bf16 v) { return __builtin_bit_cast(float, (unsigned)v << 16); }
__device__ __forceinline__ float sigmoidf_(float x) { return __builtin_amdgcn_rcpf(1.f + __builtin_amdgcn_exp2f(-1.4426950408889634f * x)); }
__device__ __forceinline__ float siluf_(float x) { return x * __builtin_amdgcn_rcpf(1.f + __builtin_amdgcn_exp2f(-1.4426950408889634f * x)); }
__device__ __forceinline__ float gelu_tanh(float x) { const float u = 0.7978845608028654f * (x + 0.044715f * x * x * x); return 0.5f * x * (1.f + tanhf(u)); }
__device__ __forceinline__ float logsigmoidf_(float x) { return fminf(x, 0.f) - log1pf(__expf(-fabsf(x))); }
#define DPP_F(v, ctrl) __builtin_bit_cast(float, __builtin_amdgcn_update_dpp(0, __builtin_bit_cast(int, (v)), (ctrl), 0xf, 0xf, true))
#define DPP_F_ID(idv, v, ctrl, rmask) __builtin_bit_cast(float, __builtin_amdgcn_update_dpp(__builtin_bit_cast(int, (idv)), __builtin_bit_cast(int, (v)), (ctrl), (rmask), 0xf, false))
__device__ __forceinline__ float xor16_f(float v) { return __builtin_bit_cast(float, __builtin_amdgcn_ds_swizzle(__builtin_bit_cast(int, v), 0x401F)); }
__device__ __forceinline__ float swap32_other(float v) { auto rr = __builtin_amdgcn_permlane32_swap(__float_as_uint(v), __float_as_uint(v), false, false);
    return (__builtin_amdgcn_mbcnt_hi(~0u, __builtin_amdgcn_mbcnt_lo(~0u, 0u)) & 32u) ? __uint_as_float(rr[0]) : __uint_as_float(rr[1]); }
__device__ __forceinline__ float wave_sum(float v) {
    v += DPP_F(v, 0xB1); v += DPP_F(v, 0x4E); v += DPP_F(v, 0x124); v += DPP_F(v, 0x128);
    v += xor16_f(v);
    auto rr = __builtin_amdgcn_permlane32_swap(__float_as_uint(v), __float_as_uint(v), false, false); return __uint_as_float(rr[0]) + __uint_as_float(rr[1]);
}
__device__ __forceinline__ float wave_max(float v) {
    v = fmaxf(v, DPP_F(v, 0xB1)); v = fmaxf(v, DPP_F(v, 0x4E)); v = fmaxf(v, DPP_F(v, 0x124)); v = fmaxf(v, DPP_F(v, 0x128));
    v = fmaxf(v, xor16_f(v));
    auto rr = __builtin_amdgcn_permlane32_swap(__float_as_uint(v), __float_as_uint(v), false, false); return fmaxf(__uint_as_float(rr[0]), __uint_as_float(rr[1]));
}
__device__ __forceinline__ float q4_sum(float v) {
    v += xor16_f(v);
    auto rr = __builtin_amdgcn_permlane32_swap(__float_as_uint(v), __float_as_uint(v), false, false); return __uint_as_float(rr[0]) + __uint_as_float(rr[1]);
}
__device__ __forceinline__ float scan_sum(float v) {
    v += DPP_F_ID(0.f, v, 0x111, 0xf); v += DPP_F_ID(0.f, v, 0x112, 0xf); v += DPP_F_ID(0.f, v, 0x114, 0xf); v += DPP_F_ID(0.f, v, 0x118, 0xf);
    v += DPP_F_ID(0.f, v, 0x142, 0xa); v += DPP_F_ID(0.f, v, 0x143, 0xc); return v;
}
__device__ __forceinline__ float scan_max(float v) {
    const float ninf = -3.0e38f;
    v = fmaxf(v, DPP_F_ID(ninf, v, 0x111, 0xf)); v = fmaxf(v, DPP_F_ID(ninf, v, 0x112, 0xf)); v = fmaxf(v, DPP_F_ID(ninf, v, 0x114, 0xf)); v = fmaxf(v, DPP_F_ID(ninf, v, 0x118, 0xf));
    v = fmaxf(v, DPP_F_ID(ninf, v, 0x142, 0xa)); v = fmaxf(v, DPP_F_ID(ninf, v, 0x143, 0xc)); return v;
}
__device__ __forceinline__ float lane63(float v) { return __builtin_bit_cast(float, __builtin_amdgcn_readlane(__builtin_bit_cast(int, v), 63)); }

#define XB_TMO      128
#define XB_XCNT(j)  (256  + 64 * (j))
#define XB_XSUB(j)  (1280 + 64 * (j))
#define XB_XGEN(j)  (2304 + 64 * (j))
#define XB_TOP      3328
#define XB_TOPGEN   3392
#define XCD_BAR_WORDS 3456
#define XB_SPIN_CAP (1u << 22)

__device__ __forceinline__ unsigned xb_ld(unsigned* p)              { return __hip_atomic_load(p, __ATOMIC_RELAXED, __HIP_MEMORY_SCOPE_AGENT); }
__device__ __forceinline__ unsigned xb_add(unsigned* p, unsigned v) { return __hip_atomic_fetch_add(p, v, __ATOMIC_RELAXED, __HIP_MEMORY_SCOPE_AGENT); }
__device__ __forceinline__ unsigned xb_xcc_id() { return (unsigned)__builtin_amdgcn_s_getreg((3 << 11) | 20) & 0xFu; }
#define XB_SPIN(cond, bar) do { unsigned _sp = 0; while (cond) { __builtin_amdgcn_s_sleep(1); \
    if ((++_sp & 255u) == 0u) { if (xb_ld(&(bar)[XB_TMO])) break; if (_sp > XB_SPIN_CAP) { atomicAdd(&(bar)[XB_TMO], 1u); break; } } } } while (0)

struct XcdBarrier {
    unsigned* bar; unsigned x;
    volatile LAS unsigned* st;
};
__device__ __forceinline__ XcdBarrier xcd_barrier_post(unsigned* bar, volatile LAS unsigned* st) {
    XcdBarrier b; b.bar = bar; b.x = xb_xcc_id(); b.st = st;
    if (threadIdx.x == 0) (void)xb_add(&bar[XB_XCNT(b.x)], 1u);
    return b;
}
__device__ __forceinline__ void xcd_barrier_complete(unsigned* bar, unsigned x, unsigned& nloc, unsigned& nx) {
    const unsigned G = gridDim.x * gridDim.y * gridDim.z;
    unsigned sum, cnt, mine, sp = 0u;
    for (;;) {
        sum = 0u; cnt = 0u; mine = 0u;
#pragma unroll
        for (unsigned j = 0; j < 16; ++j) { const unsigned c = xb_ld(&bar[XB_XCNT(j)]); sum += c; cnt += (c > 0u) ? 1u : 0u; mine = (j == x) ? c : mine; }
        if (sum == G) break;
        __builtin_amdgcn_s_sleep(1);
        if ((++sp & 255u) == 0u) { if (xb_ld(&bar[XB_TMO])) break; if (sp > XB_SPIN_CAP) { atomicAdd(&bar[XB_TMO], 1u); break; } }
    }
    nloc = mine > 0u ? mine : 1u; nx = cnt > 0u ? cnt : 1u;
}
__device__ __attribute__((noinline)) void xcd_barrier_fn(unsigned* bar, unsigned lds_st, int tid0) {
    volatile LAS unsigned* st = (volatile LAS unsigned*)lds_st;
    asm volatile("s_waitcnt vmcnt(0)" ::: "memory");
    __syncthreads();
    if (tid0) {
        const unsigned bx = xb_xcc_id();
        __builtin_amdgcn_s_waitcnt(0);
        unsigned nloc = st[0], nx = st[1];
        if (nloc == 0u) { xcd_barrier_complete(bar, bx, nloc, nx); st[0] = nloc; st[1] = nx; }
        const unsigned old = xb_add(&bar[XB_XSUB(bx)], 1u);
        const unsigned gen = old / nloc;
        if (old + 1u == (gen + 1u) * nloc) {
            __builtin_amdgcn_fence(__ATOMIC_RELEASE, "agent");
            asm volatile("s_waitcnt vmcnt(0)" ::: "memory");
            const unsigned og = xb_add(&bar[XB_TOP], 1u);
            const unsigned tg = og / nx;
            if (og + 1u == (tg + 1u) * nx) xb_add(&bar[XB_TOPGEN], 1u);
            else XB_SPIN(xb_ld(&bar[XB_TOPGEN]) == tg, bar);
            __builtin_amdgcn_fence(__ATOMIC_ACQUIRE, "agent");
            xb_add(&bar[XB_XGEN(bx)], 1u);
            asm volatile("s_waitcnt vmcnt(0)" ::: "memory");
        } else {
            XB_SPIN(xb_ld(&bar[XB_XGEN(bx)]) == gen, bar);
            __builtin_amdgcn_fence(__ATOMIC_ACQUIRE, "agent");
            asm volatile("s_waitcnt vmcnt(0)" ::: "memory");
        }
    }
    __syncthreads();
}

struct Frame {
    LAS unsigned char* lds;
    volatile LAS unsigned* MISC;
    gu32* ctl;
    int tid, lane, wave;
    int bid, G;
    unsigned char* ws; float* out;
};
constexpr int PT_OFF = MISC_OFF + 256;
__device__ __forceinline__ const float* inptr(const Frame& F, int k) {
    const LAS unsigned* p = (const LAS unsigned*)(F.lds + PT_OFF) + 2 * k;
    const unsigned lo = p[0], hi = p[1];
    return (const float*)(((unsigned long long)hi << 32) | lo);
}

template <bool ACC>
__device__ __forceinline__ void lds_gemm(LAS float* C, int ldc, const LAS bf16* A, int lda, const LAS bf16* Bt, int ldb, int Mt, int Nt, int K, int wave, int lane) {
    const int tn = Nt >> 4, nt = (Mt >> 4) * tn;
    for (int t = wave; t < nt; t += NWAVES) {
        const int i = t / tn, j = t - i * tn;
        f32x4 acc = {0.f, 0.f, 0.f, 0.f};
        const LAS bf16* ap = A + (i * 16 + (lane & 15)) * lda + 8 * (lane >> 4);
        const LAS bf16* bp = Bt + (j * 16 + (lane & 15)) * ldb + 8 * (lane >> 4);
        for (int k0 = 0; k0 < K; k0 += 32) {
            const bf16x8 a = *(const LAS bf16x8*)(ap + k0), b = *(const LAS bf16x8*)(bp + k0);
            acc = __builtin_amdgcn_mfma_f32_16x16x32_bf16(a, b, acc, 0, 0, 0);
        }
        LAS float* cp = C + (i * 16 + 4 * (lane >> 4)) * ldc + j * 16 + (lane & 15);
#pragma unroll
        for (int r = 0; r < 4; ++r) cp[r * ldc] = (ACC ? cp[r * ldc] : 0.f) + acc[r];
    }
}

template <int MODE>
__device__ __forceinline__ void transpose_item(const float* W, int K, int Nsrc, int Ndst, bf16* WT, int item, int lane, const float* kg = nullptr) {
    asm volatile("" : "+v"(lane));
    const int nblk = Ndst / 64, kb = item / nblk, nb = item - kb * nblk, k0 = 64 * kb + 16 * (lane >> 4), n0 = 64 * nb + 4 * (lane & 15);
    const int ns = MODE == 1 ? colmap_in(n0) : (MODE == 2 ? ((n0 >> 7) & 1) * D_FF + (n0 >> 8) * 128 + (n0 & 127) : n0);
    f32x4 v[16];
    if (ns >= 0) { const float* p = W + (size_t)k0 * Nsrc + ns;
#pragma unroll
        for (int i = 0; i < 16; ++i) v[i] = *(const GAS f32x4*)(p + (size_t)i * Nsrc); }
    else {
#pragma unroll
        for (int i = 0; i < 16; ++i) v[i] = (f32x4){0.f, 0.f, 0.f, 0.f}; }
    if (kg != nullptr) {
#pragma unroll
        for (int i = 0; i < 4; ++i) { const f32x4 g4 = *(const GAS f32x4*)(kg + k0 + 4 * i);
#pragma unroll
            for (int j = 0; j < 4; ++j) v[4 * i + j] = v[4 * i + j] * g4[j]; } }
    if constexpr (MODE == 3) {
#pragma unroll
        for (int j = 0; j < 4; ++j) { unsigned char* o = (unsigned char*)WT + (size_t)(n0 + j) * K + k0; constexpr float s = pg8::F8_WS;
            *(GAS v4u*)o = (v4u){pg8::pk4_fp8(v[0][j] * s, v[1][j] * s, v[2][j] * s, v[3][j] * s), pg8::pk4_fp8(v[4][j] * s, v[5][j] * s, v[6][j] * s, v[7][j] * s),
                                 pg8::pk4_fp8(v[8][j] * s, v[9][j] * s, v[10][j] * s, v[11][j] * s), pg8::pk4_fp8(v[12][j] * s, v[13][j] * s, v[14][j] * s, v[15][j] * s)}; }
        return; }
#pragma unroll
    for (int j = 0; j < 4; ++j) { bf16* o = MODE == 4 ? WT + (size_t)(k0 >> 7) * (Ndst * 128) + (n0 + j) * 128 + (k0 & 127) : WT + (size_t)(n0 + j) * K + k0;
        *(GAS v4u*)o = (v4u){cvtpk(v[0][j], v[1][j]), cvtpk(v[2][j], v[3][j]), cvtpk(v[4][j], v[5][j]), cvtpk(v[6][j], v[7][j])};
        *(GAS v4u*)(o + 8) = (v4u){cvtpk(v[8][j], v[9][j]), cvtpk(v[10][j], v[11][j]), cvtpk(v[12][j], v[13][j]), cvtpk(v[14][j], v[15][j])}; }
}
__device__ __forceinline__ void rms_row_to_bf16(const float* xrow, const float* gain, bf16* orow, int lane) {
    const GAS f32x4* xr = (const GAS f32x4*)xrow + lane; const GAS f32x4* gr = (const GAS f32x4*)gain + lane;
    f32x4 v[8]; float s = 0.f;
#pragma unroll
    for (int j = 0; j < 8; ++j) { v[j] = xr[64 * j]; s += (v[j].x * v[j].x + v[j].y * v[j].y) + (v[j].z * v[j].z + v[j].w * v[j].w); }
    const float rstd = 1.f / sqrtf(wave_sum(s) * (1.f / D_MODEL) + NORM_EPS);
    GAS unsigned long long* o8 = (GAS unsigned long long*)orow + lane;
#pragma unroll
    for (int j = 0; j < 8; ++j) { const f32x4 g = gr[64 * j];
        o8[64 * j] = (unsigned long long)pk2(v[j].x * rstd * g.x, v[j].y * rstd * g.y) | ((unsigned long long)pk2(v[j].z * rstd * g.z, v[j].w * rstd * g.w) << 32); }
}
__device__ __forceinline__ void rms_brow_to_bf16(const bf16* xrow, const float* gain, bf16* orow, int lane) {
    const GAS v4u* xr = (const GAS v4u*)xrow + lane; v4u v[4]; float s = 0.f;
#pragma unroll
    for (int j = 0; j < 4; ++j) { v[j] = xr[64 * j]; const unsigned w[4] = {v[j].x, v[j].y, v[j].z, v[j].w};
#pragma unroll
        for (int i = 0; i < 4; ++i) { const float a = __builtin_bit_cast(float, w[i] << 16), b = __builtin_bit_cast(float, w[i] & 0xffff0000u); s += a * a + b * b; } }
    const float rstd = 1.f / sqrtf(wave_sum(s) * (1.f / D_MODEL) + NORM_EPS);
    GAS v4u* o = (GAS v4u*)orow + lane;
#pragma unroll
    for (int j = 0; j < 4; ++j) { const unsigned w[4] = {v[j].x, v[j].y, v[j].z, v[j].w}; const float* g = gain + 8 * (lane + 64 * j);
        const f32x4 g0 = *(const GAS f32x4*)g, g1 = *(const GAS f32x4*)(g + 4); const float gg[8] = {g0[0], g0[1], g0[2], g0[3], g1[0], g1[1], g1[2], g1[3]};
        unsigned ow[4];
#pragma unroll
        for (int i = 0; i < 4; ++i) ow[i] = cvtpk(__builtin_bit_cast(float, w[i] << 16) * rstd * gg[2 * i], __builtin_bit_cast(float, w[i] & 0xffff0000u) * rstd * gg[2 * i + 1]);
        o[64 * j] = (v4u){ow[0], ow[1], ow[2], ow[3]}; }
}
__device__ __forceinline__ void rms_brow_to_f32(const bf16* xrow, const float* gain, float* orow, int lane) {
    const GAS v4u* xr = (const GAS v4u*)xrow + lane; v4u v[4]; float s = 0.f;
#pragma unroll
    for (int j = 0; j < 4; ++j) { v[j] = xr[64 * j]; const unsigned w[4] = {v[j].x, v[j].y, v[j].z, v[j].w};
#pragma unroll
        for (int i = 0; i < 4; ++i) { const float a = __builtin_bit_cast(float, w[i] << 16), b = __builtin_bit_cast(float, w[i] & 0xffff0000u); s += a * a + b * b; } }
    const float rstd = 1.f / sqrtf(wave_sum(s) * (1.f / D_MODEL) + NORM_EPS);
#pragma unroll
    for (int j = 0; j < 4; ++j) { const unsigned w[4] = {v[j].x, v[j].y, v[j].z, v[j].w}; const float* g = gain + 8 * (lane + 64 * j); float* o = orow + 8 * (lane + 64 * j);
        const f32x4 g0 = *(const GAS f32x4*)g, g1 = *(const GAS f32x4*)(g + 4);
        *(GAS f32x4*)o = (f32x4){__builtin_bit_cast(float, w[0] << 16) * rstd * g0[0], __builtin_bit_cast(float, w[0] & 0xffff0000u) * rstd * g0[1], __builtin_bit_cast(float, w[1] << 16) * rstd * g0[2], __builtin_bit_cast(float, w[1] & 0xffff0000u) * rstd * g0[3]};
        *(GAS f32x4*)(o + 4) = (f32x4){__builtin_bit_cast(float, w[2] << 16) * rstd * g1[0], __builtin_bit_cast(float, w[2] & 0xffff0000u) * rstd * g1[1], __builtin_bit_cast(float, w[3] << 16) * rstd * g1[2], __builtin_bit_cast(float, w[3] & 0xffff0000u) * rstd * g1[3]}; }
}
__device__ __forceinline__ void rms_row_to_f32(const float* xrow, const float* gain, float* orow, int lane) {
    const GAS f32x4* xr = (const GAS f32x4*)xrow + lane; const GAS f32x4* gr = (const GAS f32x4*)gain + lane;
    f32x4 v[8]; float s = 0.f;
#pragma unroll
    for (int j = 0; j < 8; ++j) { v[j] = xr[64 * j]; s += (v[j].x * v[j].x + v[j].y * v[j].y) + (v[j].z * v[j].z + v[j].w * v[j].w); }
    const float rstd = 1.f / sqrtf(wave_sum(s) * (1.f / D_MODEL) + NORM_EPS);
    GAS f32x4* o = (GAS f32x4*)orow + lane;
#pragma unroll
    for (int j = 0; j < 8; ++j) { const f32x4 g = gr[64 * j]; o[64 * j] = v[j] * rstd * g; }
}

struct LayerPtrs {
    const float *attn_norm, *w_in, *qk_conv_w, *qk_conv_b, *i_bias, *f_bias, *mlstm_norm, *pe_k, *pe_v, *w1_k, *w2_k, *w1_v, *w2_v, *nsa_norm, *w_out, *ffn_norm, *w_up, *ffn_conv_w, *ffn_conv_b, *w_down;
};
struct WsPtrs {
    float *ropec, *ropes, *ssq, *oacc, *pbp, *ssqp;
    bf16 *win, *wout, *wup, *wdn, *c1k, *c1v, *c2k, *c2v, *xn, *z, *mix, *kcmp, *vcmpt, *vts, *vtw, *u, *g, *xr;
};

__device__ __forceinline__ LayerPtrs make_L(const Frame& F, int layer) {
    LayerPtrs L;
    L.attn_norm = inptr(F, 1) + (size_t)layer * D_MODEL; L.w_in = inptr(F, 2) + (size_t)layer * D_MODEL * N_IN;
    L.qk_conv_w = inptr(F, 3) + (size_t)layer * 4 * 2048; L.qk_conv_b = inptr(F, 4) + (size_t)layer * 2048;
    L.i_bias = inptr(F, 5) + layer * 8; L.f_bias = inptr(F, 6) + layer * 8; L.mlstm_norm = inptr(F, 7) + layer * 1024;
    L.pe_k = inptr(F, 8) + layer * 32 * 128; L.pe_v = inptr(F, 9) + layer * 32 * 128;
    L.w1_k = inptr(F, 10) + (size_t)layer * 4096 * 256; L.w2_k = inptr(F, 11) + (size_t)layer * 256 * 128;
    L.w1_v = inptr(F, 12) + (size_t)layer * 4096 * 256; L.w2_v = inptr(F, 13) + (size_t)layer * 256 * 128;
    L.nsa_norm = inptr(F, 14) + layer * 1024; L.w_out = inptr(F, 15) + (size_t)layer * D_MODEL * D_MODEL;
    L.ffn_norm = inptr(F, 16) + (size_t)layer * D_MODEL; L.w_up = inptr(F, 17) + (size_t)layer * D_MODEL * 2 * D_FF;
    L.ffn_conv_w = inptr(F, 18) + (size_t)layer * 3 * 2 * D_FF; L.ffn_conv_b = inptr(F, 19) + (size_t)layer * 2 * D_FF;
    L.w_down = inptr(F, 20) + (size_t)layer * D_FF * D_MODEL;
    return L;
}
__device__ __forceinline__ WsPtrs make_W(const Frame& F, int layer = 0) {
    const unsigned long long wsu = (unsigned long long)F.ws;
    unsigned wlo = __builtin_amdgcn_readfirstlane((unsigned)wsu), whi = __builtin_amdgcn_readfirstlane((unsigned)(wsu >> 32));
    asm volatile("" : "+s"(wlo), "+s"(whi));
    unsigned char* ws = (unsigned char*)(((unsigned long long)whi << 32) | wlo);
    WsPtrs W;
    W.ropec = (float*)(ws + WS_ROPE); W.ropes = W.ropec + SEQ * 16; W.ssq = (float*)(ws + 454 * MiB);     W.oacc = (float*)(ws + WS_OACC); W.ssqp = (float*)(ws + WS_SSQP);
    const size_t lo_ = layer ? (WS_L1 - WS_WIN) : 0; W.pbp = (float*)(ws + (layer ? WS_PBP1 : WS_PBP));
    W.win = (bf16*)(ws + WS_WIN + lo_); W.wout = (bf16*)(ws + WS_WOUT + lo_); W.wup = (bf16*)(ws + WS_WUP); W.wdn = (bf16*)(ws + WS_WDN);
    W.c1k = (bf16*)(ws + WS_C1K + lo_); W.c1v = (bf16*)(ws + WS_C1V + lo_); W.c2k = (bf16*)(ws + WS_C2K + lo_); W.c2v = (bf16*)(ws + WS_C2V + lo_);
    W.xn = (bf16*)(ws + WS_XN); W.z = (bf16*)(ws + WS_Z); W.mix = (bf16*)(ws + WS_MIX); W.kcmp = (bf16*)(ws + WS_KCMP); W.vcmpt = (bf16*)(ws + WS_VCMP); W.vts = (bf16*)(ws + WS_VTS); W.vtw = (bf16*)(ws + WS_VTW);
    W.u = (bf16*)(ws + WS_EDGE); W.xr = (bf16*)(ws + WS_XR); W.g = (bf16*)(ws + WS_G);
    return W;
}
constexpr int I_IN = (D_MODEL / 64) * (ZW / 64), I_OUT = (D_MODEL / 64) * (D_MODEL / 64), I_C1 = (4096 / 64) * (256 / 64), I_C2 = (256 / 64) * (128 / 64);
constexpr int NSMALL = I_IN + I_OUT + 2 * I_C1 + 2 * I_C2 + 512;
static_assert(NSMALL % 8 == 0, "small conversion items");
__device__ __forceinline__ void small_item(Frame& F, const LayerPtrs& L, const WsPtrs& W, int r, bool fold) {
    if (r < I_IN) { transpose_item<1>(L.w_in, D_MODEL, N_IN, ZW, W.win, r, F.lane, fold ? L.attn_norm : nullptr); return; } r -= I_IN;
    if (r < I_OUT) { transpose_item<0>(L.w_out, D_MODEL, D_MODEL, D_MODEL, W.wout, r, F.lane, r / (D_MODEL / 64) >= 16 ? L.nsa_norm - 1024 : nullptr); return; } r -= I_OUT;
    if (r < I_C1) { transpose_item<4>(L.w1_k, 4096, 256, 256, W.c1k, r, F.lane); return; } r -= I_C1;
    if (r < I_C1) { transpose_item<4>(L.w1_v, 4096, 256, 256, W.c1v, r, F.lane); return; } r -= I_C1;
    if (r < I_C2) { transpose_item<0>(L.w2_k, 256, 128, 128, W.c2k, r, F.lane); return; } r -= I_C2;
    if (r < I_C2) { transpose_item<0>(L.w2_v, 256, 128, 128, W.c2v, r, F.lane); return; } r -= I_C2;
    {
        const int br = r >> 8, cg = (r >> 6) & 3, kp = r & 63, col = 64 * cg + F.lane;
        const float* w1 = (br ? L.w1_v : L.w1_k) + (size_t)(64 * kp) * 256 + col; const float* pe = (br ? L.pe_v : L.pe_k) + 64 * kp;
        float a = 0.f;
#pragma unroll 16
        for (int i = 0; i < 64; ++i) a += pe[i] * w1[(size_t)i * 256];
        W.pbp[(br * 64 + kp) * 256 + col] = a;
    }
}
__device__ __forceinline__ void ph_prologue(Frame& F, const LayerPtrs& L, const WsPtrs& W, const float* xin, int layer) {
    const int gw = F.bid * NWAVES + F.wave, NGW = F.G * NWAVES;
    if (layer == 0) for (int it = gw; it < NSMALL; it += NGW) small_item(F, L, W, it, false);
    if (layer == 0) for (int i = F.bid * 512 + F.tid; i < SEQ * 16; i += F.G * 512) {
        const int pos = i >> 4, k = i & 15;
        const float inv = powf(500000.0f, -(float)(2 * k) / 32.0f);
        const float ang = (float)pos * inv;
        const double rev = (double)ang * 0.15915494309189535;
        const float fr = (float)(rev - floor(rev));
        W.ropec[i] = __builtin_amdgcn_cosf(fr); W.ropes[i] = __builtin_amdgcn_sinf(fr);
    }
    if (layer == 0) { for (int m = gw; m < M; m += NGW) rms_row_to_bf16(xin + (size_t)m * D_MODEL, L.attn_norm, W.xn + (size_t)m * D_MODEL, F.lane); }
    else { for (int m = gw; m < M; m += NGW) rms_brow_to_bf16(W.xr + (size_t)m * D_MODEL, L.attn_norm, W.xn + (size_t)m * D_MODEL, F.lane); }
}

__device__ __forceinline__ void ph_rope(Frame& F, const WsPtrs& W) {
    const size_t total = (size_t)M * 224;
    for (size_t i = (size_t)F.bid * 512 + F.tid; i < total; i += (size_t)F.G * 512) {
        const int m = (int)(i / 224), r = (int)(i - (size_t)m * 224), slot = r >> 4, k = r & 15;
        const int col = slot < 8 ? ZC_NQ + slot * 128 : (slot < 10 ? ZC_KC + (slot - 8) * 128 : (slot < 12 ? ZC_KS + (slot - 10) * 128 : ZC_KW + (slot - 12) * 128));
        const int pos = m & (SEQ - 1);
        const float c = W.ropec[pos * 16 + k], s = W.ropes[pos * 16 + k];
        bf16* p = W.z + (size_t)m * ZW + col + k;
        const float x1 = bf2f(p[0]), x2 = bf2f(p[16]);
        p[0] = (bf16)f2bf(x1 * c - x2 * s); p[16] = (bf16)f2bf(x2 * c + x1 * s);
    }
}

constexpr int M2_QB = 0, M2_KB = 17408, M2_KT = 34816, M2_VT = 53248, M2_PL = 71680, M2_SC = 80896;
__device__ __forceinline__ void mlstm2_unit(Frame& F, const LayerPtrs& L, const WsPtrs& W, int b, int hd) {
    LAS bf16* QB = (LAS bf16*)(F.lds + M2_QB);
    LAS bf16* KB = (LAS bf16*)(F.lds + M2_KB);
    LAS bf16* KT = (LAS bf16*)(F.lds + M2_KT);
    LAS bf16* VT = (LAS bf16*)(F.lds + M2_VT);
    LAS bf16* PL = (LAS bf16*)(F.lds + M2_PL);
    LAS float* SC = (LAS float*)(F.lds + M2_SC);
    LAS float *colf = SC, *rowf = SC + 64, *wi = SC + 128, *emt = SC + 192, *wkv = SC + 256, *nvec = SC + 320, *ssp = SC + 448, *ms = SC + 960, *dinv = SC + 2304;
    int lane_ = F.lane; asm volatile("" : "+v"(lane_));
    const int lane = lane_, wave = F.wave, tid = wave * 64 + lane, r = lane & 15, q4 = lane >> 4;
    const int d2 = tid & 63, sg = wave, dA = 2 * d2;
    const int coff = hd * 128 + dA;
    LAS float* CWL = SC + 1024;
    for (int e = tid; e < 10 * 128; e += 512) { const int k = e >> 7, d = e & 127, cq = hd * 128 + d;
        CWL[e] = k < 4 ? L.qk_conv_w[k * 2048 + cq] : (k < 8 ? L.qk_conv_w[(k - 4) * 2048 + 1024 + cq] : (k == 8 ? L.qk_conv_b[cq] : L.qk_conv_b[1024 + cq])); }
    const f32x4 gain = *(const GAS f32x4*)(L.mlstm_norm + hd * 128 + 16 * wave + 4 * q4);
    const float ibias = L.i_bias[hd], fbias = L.f_bias[hd];
    f32x4 cacc[8];
#pragma unroll
    for (int i = 0; i < 8; ++i) cacc[i] = (f32x4){0.f, 0.f, 0.f, 0.f};
    float nreg = 0.f;
    if (tid < 128) nvec[tid] = 0.f;
    if (tid == 0) ms[0] = 0.f;
    const bf16* zb = W.z + (size_t)b * SEQ * ZW;
    unsigned qraw[11], kraw[11], vraw[8]; bf16 graw0 = 0, graw1 = 0;
#pragma unroll
    for (int k = 0; k < 11; ++k) { const int t = 8 * sg - 3 + k;
        const bf16* rp = zb + (ptrdiff_t)(t >= 0 ? t : 0) * ZW;
        qraw[k] = t >= 0 ? *(const GAS unsigned*)(rp + ZC_MQ + coff) : 0u; kraw[k] = t >= 0 ? *(const GAS unsigned*)(rp + ZC_MK + coff) : 0u; }
#pragma unroll
    for (int k = 0; k < 8; ++k) { const bf16* rp = zb + (size_t)(8 * sg + k) * ZW; vraw[k] = *(const GAS unsigned*)(rp + ZC_MV + coff); }
    if (wave == 0) { graw0 = zb[(size_t)lane * ZW + ZC_MI + hd]; graw1 = zb[(size_t)lane * ZW + ZC_MF + hd]; }
    __syncthreads();
    for (int c = 0; c < SEQ / 64; ++c) {
        const int t0 = c * 64; const size_t row0 = (size_t)b * SEQ + t0;
        {
            unsigned kt0[4], kt1[4], vt0[4], vt1[4];
            typedef float f32x2_ __attribute__((ext_vector_type(2)));
            f32x2_ cw[10];
#pragma unroll
            for (int k = 0; k < 10; ++k) cw[k] = *(const LAS f32x2_*)(CWL + k * 128 + dA);
#pragma unroll
            for (int i = 0; i < 8; ++i) {
                float yq0 = cw[8][0], yq1 = cw[8][1], yk0 = cw[9][0], yk1 = cw[9][1];
#pragma unroll
                for (int j = 0; j < 4; ++j) { const unsigned a = qraw[i + j], kk = kraw[i + j];
                    yq0 += cw[j][0] * bf2f((bf16)(a & 0xffffu)); yq1 += cw[j][1] * bf2f((bf16)(a >> 16));
                    yk0 += cw[4 + j][0] * bf2f((bf16)(kk & 0xffffu)); yk1 += cw[4 + j][1] * bf2f((bf16)(kk >> 16)); }
                const int s = 8 * sg + i;
                *(LAS unsigned*)(QB + s * 136 + dA) = cvtpk(siluf_(yq0), siluf_(yq1));
                const unsigned kpk = cvtpk(siluf_(yk0) * 0.08838834764831845f, siluf_(yk1) * 0.08838834764831845f); const unsigned k0 = kpk & 0xffffu, k1 = kpk >> 16;
                *(LAS unsigned*)(KB + s * 136 + dA) = kpk;
                if (i & 1) { kt0[i >> 1] |= k0 << 16; kt1[i >> 1] |= k1 << 16; vt0[i >> 1] |= (vraw[i] & 0xffffu) << 16; vt1[i >> 1] |= vraw[i] & 0xffff0000u; }
                else { kt0[i >> 1] = k0; kt1[i >> 1] = k1; vt0[i >> 1] = vraw[i] & 0xffffu; vt1[i >> 1] = vraw[i] >> 16; }
                __builtin_amdgcn_sched_barrier(0);
            }
            *(LAS v4u*)(KT + dA * 72 + 8 * sg) = (v4u){kt0[0], kt0[1], kt0[2], kt0[3]}; *(LAS v4u*)(KT + (dA + 1) * 72 + 8 * sg) = (v4u){kt1[0], kt1[1], kt1[2], kt1[3]};
            *(LAS v4u*)(VT + dA * 72 + 8 * sg) = (v4u){vt0[0], vt0[1], vt0[2], vt0[3]}; *(LAS v4u*)(VT + (dA + 1) * 72 + 8 * sg) = (v4u){vt1[0], vt1[1], vt1[2], vt1[3]};
        }
        if (wave == 0) {
            const float ig = bf2f(graw0) + ibias, fp = bf2f(graw1) + fbias;
            float bsum = logsigmoidf_(fp);
#pragma unroll
            for (int o = 1; o < 64; o <<= 1) { const float tt = __shfl_up(bsum, o); if (lane >= o) bsum += tt; }
            const float ibv = ig - bsum; float pm = ibv;
#pragma unroll
            for (int o = 1; o < 64; o <<= 1) { const float tt = __shfl_up(pm, o); if (lane >= o) pm = fmaxf(pm, tt); }
            const float mprev = ms[0];
            const float mtv = bsum + fmaxf(mprev, pm);
            const float bL = __shfl(bsum, 63), pmL = __shfl(pm, 63);
            const float mnew = bL + fmaxf(mprev, pmL);
            colf[lane] = __expf(ibv); rowf[lane] = __expf(bsum - mtv); wi[lane] = __expf(bsum + mprev - mtv); emt[lane] = __expf(-mtv); wkv[lane] = __expf(bL + ibv - mnew);
            if (lane == 0) { ms[1] = __expf(bL + mprev - mnew); ms[2] = mnew; }
        }
        if (c + 1 < SEQ / 64) { const bf16* zn = zb + (size_t)(t0 + 64) * ZW;
#pragma unroll
            for (int k = 0; k < 11; ++k) { const int t = 8 * sg - 3 + k;
                const bf16* rp = zn + (ptrdiff_t)t * ZW;
                qraw[k] = *(const GAS unsigned*)(rp + ZC_MQ + coff); kraw[k] = *(const GAS unsigned*)(rp + ZC_MK + coff); }
#pragma unroll
            for (int k = 0; k < 8; ++k) { const bf16* rp = zn + (size_t)(8 * sg + k) * ZW; vraw[k] = *(const GAS unsigned*)(rp + ZC_MV + coff); }
            if (wave == 0) { graw0 = zn[(size_t)lane * ZW + ZC_MI + hd]; graw1 = zn[(size_t)lane * ZW + ZC_MF + hd]; } }
        __syncthreads();
        { const int i = wave >> 1;
#pragma unroll
          for (int e = 0; e < 2; ++e) { const int jj = 2 * (wave & 1) + e; const int t = 16 * jj + r;
              f32x4 acc = {0.f, 0.f, 0.f, 0.f};
              if (i <= jj) {
#pragma unroll
                  for (int kk = 0; kk < 4; ++kk) { const bf16x8 a = *(const LAS bf16x8*)(KB + (16 * i + r) * 136 + 32 * kk + 8 * q4), bb = *(const LAS bf16x8*)(QB + t * 136 + 32 * kk + 8 * q4);
                      acc = __builtin_amdgcn_mfma_f32_16x16x32_bf16(a, bb, acc, 0, 0, 0); }
                  const f32x4 cf = *(const LAS f32x4*)(colf + 16 * i + 4 * q4); const float rf = rowf[t];
#pragma unroll
                  for (int g = 0; g < 4; ++g) acc[g] = (16 * i + 4 * q4 + g <= t) ? acc[g] * cf[g] * rf : 0.f;
              }
              *(LAS unsigned long long*)(PL + t * 72 + 16 * i + 4 * q4) = (unsigned long long)cvtpk(acc[0], acc[1]) | ((unsigned long long)cvtpk(acc[2], acc[3]) << 32); } }
        __syncthreads();
        f32x4 hout[4];
        {
            bf16x8 av[2];
#pragma unroll
            for (int ks = 0; ks < 2; ++ks) av[ks] = *(const LAS bf16x8*)(VT + (16 * wave + r) * 72 + 32 * ks + 8 * q4);
#pragma unroll
            for (int jj = 0; jj < 4; ++jj) { const int t = 16 * jj + r;
                f32x4 hi = {0.f, 0.f, 0.f, 0.f}, ha = {0.f, 0.f, 0.f, 0.f};
#pragma unroll
                for (int kk = 0; kk < 4; ++kk) {
                    const unsigned long long lo = *(const LAS unsigned long long*)(QB + t * 136 + 32 * kk + 4 * q4), hi8 = *(const LAS unsigned long long*)(QB + t * 136 + 32 * kk + 16 + 4 * q4);
                    v4u w; w.x = (unsigned)lo; w.y = (unsigned)(lo >> 32); w.z = (unsigned)hi8; w.w = (unsigned)(hi8 >> 32);
                    v4u cw4; cw4.x = cvtpk(cacc[2 * kk][0], cacc[2 * kk][1]); cw4.y = cvtpk(cacc[2 * kk][2], cacc[2 * kk][3]); cw4.z = cvtpk(cacc[2 * kk + 1][0], cacc[2 * kk + 1][1]); cw4.w = cvtpk(cacc[2 * kk + 1][2], cacc[2 * kk + 1][3]);
                    hi = __builtin_amdgcn_mfma_f32_16x16x32_bf16(__builtin_bit_cast(bf16x8, cw4), __builtin_bit_cast(bf16x8, w), hi, 0, 0, 0); }
#pragma unroll
                for (int ks = 0; ks < 2; ++ks) { const bf16x8 w = *(const LAS bf16x8*)(PL + t * 72 + 32 * ks + 8 * q4); ha = __builtin_amdgcn_mfma_f32_16x16x32_bf16(av[ks], w, ha, 0, 0, 0); }
                hout[jj] = hi * wi[t] + ha;
                float ss = (hout[jj][0] * hout[jj][0] + hout[jj][1] * hout[jj][1]) + (hout[jj][2] * hout[jj][2] + hout[jj][3] * hout[jj][3]);
                ss = q4_sum(ss);
                if (q4 == 0) ssp[wave * 64 + t] = ss; }
            { const int t = 8 * wave + (lane >> 3), p = lane & 7;
              float a = 0.f;
#pragma unroll
              for (int e = 0; e < 2; ++e) { const v4u w = *(const LAS v4u*)(QB + t * 136 + 16 * p + 8 * e); const f32x4 n0 = *(const LAS f32x4*)(nvec + 16 * p + 8 * e), n1 = *(const LAS f32x4*)(nvec + 16 * p + 8 * e + 4);
                  a += bf2f((bf16)(w.x & 0xffffu)) * n0[0] + bf2f((bf16)(w.x >> 16)) * n0[1] + bf2f((bf16)(w.y & 0xffffu)) * n0[2] + bf2f((bf16)(w.y >> 16)) * n0[3]
                     + bf2f((bf16)(w.z & 0xffffu)) * n1[0] + bf2f((bf16)(w.z >> 16)) * n1[1] + bf2f((bf16)(w.w & 0xffffu)) * n1[2] + bf2f((bf16)(w.w >> 16)) * n1[3]; }
              const v4u w = *(const LAS v4u*)(PL + t * 72 + 8 * p);
              float d = (bf2f((bf16)(w.x & 0xffffu)) + bf2f((bf16)(w.x >> 16))) + (bf2f((bf16)(w.y & 0xffffu)) + bf2f((bf16)(w.y >> 16))) + (bf2f((bf16)(w.z & 0xffffu)) + bf2f((bf16)(w.z >> 16))) + (bf2f((bf16)(w.w & 0xffffu)) + bf2f((bf16)(w.w >> 16)));
              float den = wi[t] * a + d;
              den += DPP_F(den, 0xB1); den += DPP_F(den, 0x4E); den += DPP_F(den, 0x141);
              if (p == 0) dinv[t] = 1.f / fmaxf(fabsf(den), emt[t]); }
        }
        __syncthreads();
#pragma unroll
        for (int jj = 0; jj < 4; ++jj) { const int t = 16 * jj + r;
            float tot = 0.f;
#pragma unroll
            for (int w8 = 0; w8 < 8; ++w8) tot += ssp[w8 * 64 + t];
            const float iv = dinv[t]; const float rstd = iv / sqrtf(tot * iv * iv * (1.f / 128.f) + NORM_EPS);
            const unsigned long long mo = *(const GAS unsigned long long*)(W.z + (row0 + t) * ZW + ZC_MO + hd * 128 + 16 * wave + 4 * q4);
            const float o0 = hout[jj][0] * rstd * gain[0] * sigmoidf_(bf2f((bf16)(mo & 0xffffu))), o1 = hout[jj][1] * rstd * gain[1] * sigmoidf_(bf2f((bf16)((mo >> 16) & 0xffffu)));
            const float o2 = hout[jj][2] * rstd * gain[2] * sigmoidf_(bf2f((bf16)((mo >> 32) & 0xffffu))), o3 = hout[jj][3] * rstd * gain[3] * sigmoidf_(bf2f((bf16)(mo >> 48)));
            *(GAS unsigned long long*)(W.mix + (row0 + t) * 2048 + hd * 128 + 16 * wave + 4 * q4) = (unsigned long long)cvtpk(o0, o1) | ((unsigned long long)cvtpk(o2, o3) << 32);
            __builtin_amdgcn_sched_barrier(0); }
        {
            const float decay = ms[1];
            bf16x8 bv[2];
#pragma unroll
            for (int ks = 0; ks < 2; ++ks) { const v4u w = *(const LAS v4u*)(VT + (16 * wave + r) * 72 + 32 * ks + 8 * q4);
                const f32x4 k0 = *(const LAS f32x4*)(wkv + 32 * ks + 8 * q4), k1 = *(const LAS f32x4*)(wkv + 32 * ks + 8 * q4 + 4);
                v4u o; o.x = cvtpk(bf2f((bf16)(w.x & 0xffffu)) * k0[0], bf2f((bf16)(w.x >> 16)) * k0[1]); o.y = cvtpk(bf2f((bf16)(w.y & 0xffffu)) * k0[2], bf2f((bf16)(w.y >> 16)) * k0[3]);
                o.z = cvtpk(bf2f((bf16)(w.z & 0xffffu)) * k1[0], bf2f((bf16)(w.z >> 16)) * k1[1]); o.w = cvtpk(bf2f((bf16)(w.w & 0xffffu)) * k1[2], bf2f((bf16)(w.w >> 16)) * k1[3]);
                bv[ks] = __builtin_bit_cast(bf16x8, o); }
#pragma unroll
            for (int dt = 0; dt < 8; ++dt) { f32x4 a4 = cacc[dt] * decay;
#pragma unroll
                for (int ks = 0; ks < 2; ++ks) { const bf16x8 a = *(const LAS bf16x8*)(KT + (16 * dt + r) * 72 + 32 * ks + 8 * q4); a4 = __builtin_amdgcn_mfma_f32_16x16x32_bf16(a, bv[ks], a4, 0, 0, 0); }
                cacc[dt] = a4; __builtin_amdgcn_sched_barrier(0); }
            if (tid < 128) { float a = nreg * decay;
#pragma unroll
                for (int s8 = 0; s8 < 8; ++s8) { const v4u w = *(const LAS v4u*)(KT + tid * 72 + 8 * s8); const f32x4 k0 = *(const LAS f32x4*)(wkv + 8 * s8), k1 = *(const LAS f32x4*)(wkv + 8 * s8 + 4);
                    a += bf2f((bf16)(w.x & 0xffffu)) * k0[0] + bf2f((bf16)(w.x >> 16)) * k0[1] + bf2f((bf16)(w.y & 0xffffu)) * k0[2] + bf2f((bf16)(w.y >> 16)) * k0[3]
                       + bf2f((bf16)(w.z & 0xffffu)) * k1[0] + bf2f((bf16)(w.z >> 16)) * k1[1] + bf2f((bf16)(w.w & 0xffffu)) * k1[2] + bf2f((bf16)(w.w >> 16)) * k1[3]; }
                nreg = a; nvec[tid] = a; }
            if (tid == 0) ms[0] = ms[2];
        }
        __syncthreads();
    }
}

__device__ __forceinline__ void cmp_unit(Frame& F, const LayerPtrs& L, const WsPtrs& W, int u, int layer) {
    const int branch = u >> 7, rem = u & 127, bk = rem >> 3, b = bk >> 1, kvh = bk & 1, n0 = (rem & 7) * 16;
    LAS bf16* Hb = (LAS bf16*)(F.lds);
    int lane_ = F.lane; asm volatile("" : "+v"(lane_));
    const int lane = lane_, wave = F.wave, r = lane & 15, q4 = lane >> 4;
    const bf16* w1t = branch ? W.c1v : W.c1k; const bf16* w2t = branch ? W.c2v : W.c2k;
    const int zc = (branch ? ZC_VC : ZC_KC) + kvh * 128;
    const bf16* bp0 = w1t + (size_t)(32 * wave + r) * 128 + 8 * q4; const bf16* bp1 = bp0 + (size_t)16 * 128;
    f32x4 acc0 = {0.f, 0.f, 0.f, 0.f}, acc1 = {0.f, 0.f, 0.f, 0.f};
    LAS unsigned char* As = F.lds + 8448;
    { const int tid = wave * 64 + lane; v4u t[9];
#pragma unroll
      for (int j = 0; j < 9; ++j) { const int c = tid + 512 * j, rho = c >> 4; int row = 16 * n0 + rho; row = row < SEQ ? row : SEQ - 1;
          if (c < 272 * 16) t[j] = *(const GAS v4u*)(W.z + ((size_t)b * SEQ + row) * ZW + zc + 8 * (c & 15)); }
#pragma unroll
      for (int j = 0; j < 9; ++j) { const int c = tid + 512 * j, rho = c >> 4;
          if (c < 272 * 16) *(LAS v4u*)(As + ((rho & 15) * 18 + (rho >> 4)) * 272 + 16 * (c & 15)) = t[j]; } }
    bf16x8 fb[4][2][4];
#define CMP_LDB(s, l) do { _Pragma("unroll") for (int i = 0; i < 4; ++i) { fb[s][0][i] = *(const GAS bf16x8*)(bp0 + 32768 * (l) + 32 * i); fb[s][1][i] = *(const GAS bf16x8*)(bp1 + 32768 * (l) + 32 * i); } } while (0)
    CMP_LDB(0, 0); CMP_LDB(1, 1); CMP_LDB(2, 2);
    __syncthreads();
    const LAS unsigned char* ar = As + r * 272 + q4 * 16;
#pragma unroll 1
    for (int l4 = 0; l4 < 32; l4 += 4) {
#pragma unroll
        for (int s = 0; s < 4; ++s) { const int l = l4 + s, lp = l + 3 < 32 ? l + 3 : 31;
            CMP_LDB((s + 3) & 3, lp);
            bf16x8 fa[4];
#pragma unroll
            for (int i = 0; i < 4; ++i) fa[i] = *(const LAS bf16x8*)(ar + ((l & 15) * 18 + (l >> 4)) * 272 + 64 * i);
#pragma unroll
            for (int i = 0; i < 4; ++i) { acc0 = __builtin_amdgcn_mfma_f32_16x16x32_bf16(fa[i], fb[s][0][i], acc0, 0, 0, 0); acc1 = __builtin_amdgcn_mfma_f32_16x16x32_bf16(fa[i], fb[s][1][i], acc1, 0, 0, 0); } }
    }
#undef CMP_LDB
    { const float* pb = W.pbp + branch * 64 * 256 + 32 * wave + r;
      float b0 = 0.f, b1 = 0.f;
#pragma unroll 16
      for (int kp = 0; kp < 64; ++kp) { b0 += pb[kp * 256]; b1 += pb[kp * 256 + 16]; }
#pragma unroll
      for (int g = 0; g < 4; ++g) { Hb[(4 * q4 + g) * 264 + 32 * wave + r] = (bf16)(cvtpk(gelu_tanh(acc0[g] + b0), 0.f) & 0xffffu); Hb[(4 * q4 + g) * 264 + 32 * wave + 16 + r] = (bf16)(cvtpk(gelu_tanh(acc1[g] + b1), 0.f) & 0xffffu); } }
    __syncthreads();
    f32x4 o = {0.f, 0.f, 0.f, 0.f};
#pragma unroll
    for (int kk = 0; kk < 8; ++kk) { const bf16x8 a = *(const LAS bf16x8*)(Hb + r * 264 + 32 * kk + 8 * q4), bb = *(const GAS bf16x8*)(w2t + (size_t)(16 * wave + r) * 256 + 32 * kk + 8 * q4);
        o = __builtin_amdgcn_mfma_f32_16x16x32_bf16(a, bb, o, 0, 0, 0); }
    bf16* dst = (branch ? W.vcmpt : W.kcmp) + (size_t)bk * 128 * 128;
    const int d = 16 * wave + r;
#pragma unroll
    for (int g = 0; g < 4; ++g) { const int n = n0 + 4 * q4 + g; const bf16 ov = n < NCMP ? (bf16)(cvtpk(o[g], 0.f) & 0xffffu) : (bf16)0;
        if (branch) dst[d * 128 + ((n & ~12) | ((n & 4) << 1) | ((n & 8) >> 1))] = ov; else dst[n * 128 + d] = ov; }
    __syncthreads();
}

typedef float f32x16 __attribute__((ext_vector_type(16)));
struct NsaOff { unsigned base, x; __device__ __forceinline__ unsigned at(int s) const { return base + 32u * ((unsigned)s ^ x); } };
constexpr int N2_IMPW = 65536;
constexpr int N2_IMP = N2_IMPW + 33792;
constexpr int N2_SEL = N2_IMP + 8448;
#define N2_KOFF(buf) ((buf) * 32768)
#define N2_VOFF(buf) ((buf) * 32768 + 16384)
__device__ __forceinline__ float xhalf_max(float v) { auto rr = __builtin_amdgcn_permlane32_swap(__float_as_uint(v), __float_as_uint(v), false, false); return fmaxf(__uint_as_float(rr[0]), __uint_as_float(rr[1])); }
__device__ __forceinline__ float xhalf_sum(float v) { auto rr = __builtin_amdgcn_permlane32_swap(__float_as_uint(v), __float_as_uint(v), false, false); return __uint_as_float(rr[0]) + __uint_as_float(rr[1]); }
__device__ __forceinline__ float xhalf_other(float v) { return swap32_other(v); }
__device__ __forceinline__ void nsa2_stage(LAS unsigned char* lds, int buf, const bf16* kbase, int krs, const bf16* vtbase, int vrs, int wave, int lane) {
    asm volatile("" : "+v"(lane));
#pragma unroll
    for (int i = 0; i < 2; ++i) {
        const int p = wave * 2 + i;
        const int row = 4 * p + (lane >> 4), ch = (lane & 15) ^ (((row & 3) << 2) | ((row >> 2) & 3));
        __builtin_amdgcn_global_load_lds((const unsigned*)(kbase + (size_t)row * krs + 8 * ch), (LAS unsigned*)(lds + N2_KOFF(buf) + p * 1024), 16, 0, 0);
        const int vrow = 8 * p + (lane >> 3), vc = (lane & 7) ^ ((vrow >> 1) & 7);
        __builtin_amdgcn_global_load_lds((const unsigned*)(vtbase + (size_t)vrow * vrs + 8 * vc), (LAS unsigned*)(lds + N2_VOFF(buf) + p * 1024), 16, 0, 0);
    }
}
__device__ __forceinline__ void nsa2_qk(LAS unsigned char* lds, int buf, const bf16x8 (&Qf)[8], const NsaOff koff, f32x16 (&st)[2]) {
#pragma unroll
    for (int kt = 0; kt < 2; ++kt) {
#pragma unroll
        for (int r = 0; r < 16; ++r) st[kt][r] = 0.f;
#pragma unroll
        for (int s = 0; s < 8; ++s) { const bf16x8 a = *(const LAS bf16x8*)(lds + N2_KOFF(buf) + kt * 8192 + koff.at(s)); st[kt] = __builtin_amdgcn_mfma_f32_32x32x16_bf16(a, Qf[s], st[kt], 0, 0, 0); }
    }
}
__device__ __forceinline__ void nsa2_pv(LAS unsigned char* lds, int buf, const f32x16 (&st)[2], const NsaOff voff, f32x16 (&O)[4]) {
    bf16x8 pf[4];
#pragma unroll
    for (int ks = 0; ks < 4; ++ks) { const int kt = ks >> 1, b0 = (ks & 1) * 8;
        v4u w; w.x = cvtpk(st[kt][b0 + 0], st[kt][b0 + 1]); w.y = cvtpk(st[kt][b0 + 2], st[kt][b0 + 3]); w.z = cvtpk(st[kt][b0 + 4], st[kt][b0 + 5]); w.w = cvtpk(st[kt][b0 + 6], st[kt][b0 + 7]);
        pf[ks] = __builtin_bit_cast(bf16x8, w); }
#pragma unroll
    for (int db = 0; db < 4; ++db)
#pragma unroll
        for (int ks = 0; ks < 4; ++ks) { const bf16x8 a = *(const LAS bf16x8*)(lds + N2_VOFF(buf) + db * 4096 + voff.at(ks)); O[db] = __builtin_amdgcn_mfma_f32_32x32x16_bf16(a, pf[ks], O[db], 0, 0, 0); }
}
__device__ __forceinline__ void nsa2_flash(LAS unsigned char* lds, int buf, const bf16x8 (&Qf)[8], const NsaOff koff, const NsaOff voff, f32x16 (&O)[4], float& m2, float& l, int lo_k, int hi_k, int h) {
    constexpr float C = 0.08838834764831845f * 1.4426950408889634f;
    f32x16 st[2];
    nsa2_qk(lds, buf, Qf, koff, st);
    float mx = -1e30f;
#pragma unroll
    for (int kt = 0; kt < 2; ++kt)
#pragma unroll
        for (int r = 0; r < 16; ++r) { const int kk = 32 * kt + (r & 3) + 8 * (r >> 2) + 4 * h; const bool valid = (kk > lo_k) && (kk <= hi_k);
            const float sv = valid ? st[kt][r] * C : -1e30f; st[kt][r] = sv; mx = fmaxf(mx, sv); }
    mx = xhalf_max(mx);
    const float mnew = fmaxf(m2, mx), alpha = __builtin_amdgcn_exp2f(m2 - mnew); m2 = mnew;
    float ps = 0.f;
#pragma unroll
    for (int kt = 0; kt < 2; ++kt)
#pragma unroll
        for (int r = 0; r < 16; ++r) { const float p = st[kt][r] > -5e29f ? __builtin_amdgcn_exp2f(st[kt][r] - mnew) : 0.f; st[kt][r] = p; ps += p; }
    l = l * alpha + ps;
#pragma unroll
    for (int db = 0; db < 4; ++db) O[db] = O[db] * alpha;
    nsa2_pv(lds, buf, st, voff, O);
}
__device__ __forceinline__ void nsa2_unit(Frame& F, const WsPtrs& W, int b, int kvh, int c, int pass) {
    LAS unsigned char* lds = F.lds;
    LAS float* IMPW = (LAS float*)(lds + N2_IMPW); LAS float* IMP = (LAS float*)(lds + N2_IMP); LAS unsigned* SEL = (LAS unsigned*)(lds + N2_SEL);
    int lane_ = F.lane; asm volatile("" : "+v"(lane_));
    const int lane = lane_, wave = F.wave, tid = wave * 64 + lane, g = wave >> 1, qh = wave & 1, q = lane & 31, h = lane >> 5, hq = kvh * 4 + g;
    const int rq = 32 * qh + q, t = c * 64 + rq; const size_t row = (size_t)b * SEQ + t;
    const int xr = ((q & 3) << 2) | ((q >> 2) & 3), xv = (q >> 1) & 7;
    const NsaOff koff = {(unsigned)(256 * q + 16 * ((h ^ xr) & 1)), (unsigned)(xr >> 1)}, voff = {(unsigned)(128 * q + 16 * ((h ^ xv) & 1)), (unsigned)(xv >> 1)};
    const bf16* kcb = W.kcmp + (size_t)(b * 2 + kvh) * 128 * 128; const bf16* vcb = W.vcmpt + (size_t)(b * 2 + kvh) * 128 * 128;
    nsa2_stage(lds, 0, kcb, 128, vcb, 128, wave, lane);
    nsa2_stage(lds, 1, kcb + 64 * 128, 128, vcb + 64, 128, wave, lane);
    bf16x8 Qf[8];
    { const bf16* qp = W.z + row * ZW + ZC_NQ + hq * 128 + 8 * h;
#pragma unroll
      for (int s = 0; s < 8; ++s) Qf[s] = *(const GAS bf16x8*)(qp + 16 * s); }
    const float g0 = sigmoidf_(bf2f(W.z[row * ZW + ZC_NG + hq * 3 + 0])), g1 = sigmoidf_(bf2f(W.z[row * ZW + ZC_NG + hq * 3 + 1])), g2 = sigmoidf_(bf2f(W.z[row * ZW + ZC_NG + hq * 3 + 2]));
    if (tid < 65) SEL[tid] = 0u;
    float* op = W.oacc + row * 1024 + hq * 128 + 4 * h;
    asm volatile("s_waitcnt vmcnt(0)" ::: "memory");
    __syncthreads();
    constexpr float C = 0.08838834764831845f * 1.4426950408889634f;
    f32x16 O[4];
    {
        const int lim = t >= 31 ? ((t - 31) >> 4) : -1;
        const int limc = lim < NCMP - 1 ? lim : NCMP - 1;
        float m2 = -1e30f, l = 0.f;
#pragma unroll
        for (int db = 0; db < 4; ++db)
#pragma unroll
            for (int r = 0; r < 16; ++r) O[db][r] = 0.f;
        nsa2_flash(lds, 0, Qf, koff, voff, O, m2, l, -1, limc, h);
        nsa2_flash(lds, 1, Qf, koff, voff, O, m2, l, -1, limc - 64, h);
        const float lt = xhalf_sum(l), inv = lt > 0.f ? 1.f / lt : 0.f, og = inv * g0;
#pragma unroll
        for (int db = 0; db < 4; ++db)
#pragma unroll
            for (int r4 = 0; r4 < 4; ++r4) *(GAS f32x4*)(op + 32 * db + 8 * r4) = (f32x4){O[db][4 * r4] * og, O[db][4 * r4 + 1] * og, O[db][4 * r4 + 2] * og, O[db][4 * r4 + 3] * og};
        LAS float* iw = IMPW + (wave * 32 + q) * 33 + h;
        float prev = 0.f;
#pragma unroll
        for (int blk = 0; blk < 2; ++blk) {
            f32x16 st[2];
            nsa2_qk(lds, blk, Qf, koff, st);
#pragma unroll
            for (int kt = 0; kt < 2; ++kt)
#pragma unroll
                for (int r4 = 0; r4 < 4; ++r4) {
                    float pv[4];
#pragma unroll
                    for (int i = 0; i < 4; ++i) { const int kk = 64 * blk + 32 * kt + 8 * r4 + 4 * h + i; pv[i] = kk <= limc ? __builtin_amdgcn_exp2f(st[kt][4 * r4 + i] * C - m2) * inv : 0.f; }
                    const float s4 = (pv[0] + pv[1]) + (pv[2] + pv[3]);
                    const float o = xhalf_other(pv[3]);
                    const float add = h ? o : prev; prev = o;
                    iw[2 * (8 * blk + 4 * kt + r4)] = s4 + add;
                }
        }
    }
    __syncthreads();
    const bf16* ksb = W.z + (size_t)b * SEQ * ZW + ZC_KS + kvh * 128; const bf16* vsb = W.vts + (size_t)(b * 2 + kvh) * 128 * SEQ;
    const bf16* kwb = W.z + (size_t)b * SEQ * ZW + ZC_KW + kvh * 128; const bf16* vwb = W.vtw + (size_t)(b * 2 + kvh) * 128 * SEQ;
    nsa2_stage(lds, 0, ksb, ZW, vsb, SEQ, wave, lane);
    for (int e = tid; e < 64 * 32; e += 512) { const int q64 = e >> 5, j = e & 31; const int wq = (q64 >> 5), ql = q64 & 31;
        IMP[q64 * 33 + j] = ((IMPW[((0 + wq) * 32 + ql) * 33 + j] + IMPW[((2 + wq) * 32 + ql) * 33 + j]) + IMPW[((4 + wq) * 32 + ql) * 33 + j]) + IMPW[((6 + wq) * 32 + ql) * 33 + j]; }
    __syncthreads();
    for (int e = tid; e < 64 * 32; e += 512) { const int q64 = e >> 5, j = e & 31;
        const float vj = (j == 0 || j == c || j == c - 1) ? 1e4f : (j > c ? -1.f : IMP[q64 * 33 + j]);
        int rank = 0;
        for (int i = 0; i < 32; ++i) { const float vi = (i == 0 || i == c || i == c - 1) ? 1e4f : (i > c ? -1.f : IMP[q64 * 33 + i]); rank += (vi > vj || (vi == vj && i < j)) ? 1 : 0; }
        if (j <= c && rank < TOPK) { __hip_atomic_fetch_or(&SEL[q64], 1u << j, __ATOMIC_RELAXED, __HIP_MEMORY_SCOPE_WORKGROUP); __hip_atomic_fetch_or(&SEL[64], 1u << j, __ATOMIC_RELAXED, __HIP_MEMORY_SCOPE_WORKGROUP); } }
    __syncthreads();
    const unsigned mysel = SEL[rq];
    const unsigned anysel = __builtin_amdgcn_readfirstlane(SEL[64]);
    const int j0w = c > 8 ? c - 8 : 0, nsl = __builtin_popcount(anysel), nit = nsl + (c - j0w + 1);
    unsigned rem = anysel & ~1u;
    float m2 = -1e30f, l = 0.f;
#pragma unroll
    for (int db = 0; db < 4; ++db)
#pragma unroll
        for (int r = 0; r < 16; ++r) O[db][r] = 0.f;
    int jcur = 0;
    for (int it = 0; it < nit; ++it) {
        const int buf = it & 1; const bool is_sel = it < nsl;
        int jn = 0; const int itn = it + 1;
        if (itn < nit) {
            if (itn < nsl) { jn = __builtin_ctz(rem); rem &= rem - 1u; nsa2_stage(lds, buf ^ 1, ksb + (size_t)jn * 64 * ZW, ZW, vsb + jn * 64, SEQ, wave, lane); }
            else { jn = j0w + (itn - nsl); nsa2_stage(lds, buf ^ 1, kwb + (size_t)jn * 64 * ZW, ZW, vwb + jn * 64, SEQ, wave, lane); }
        }
        const int j = jcur;
        int lo_k = -1, hi_k = 63; bool lane_on = true;
        if (j == c) hi_k = rq;
        if (is_sel) lane_on = (mysel >> j) & 1u; else if (j == c - 8) lo_k = rq;
        if (!lane_on) hi_k = -1;
        if (__builtin_amdgcn_ballot_w64(lane_on) != 0ull) nsa2_flash(lds, buf, Qf, koff, voff, O, m2, l, lo_k, hi_k, h);
        if (it == nsl - 1 || it == nit - 1) {
            const float lt = xhalf_sum(l); const float sc = (it == nsl - 1 ? g1 : g2) / lt;
            if (it == nsl - 1) {
#pragma unroll
                for (int db = 0; db < 4; ++db)
#pragma unroll
                    for (int r4 = 0; r4 < 4; ++r4) { GAS f32x4* p = (GAS f32x4*)(op + 32 * db + 8 * r4); f32x4 v = *p;
                        v.x += O[db][4 * r4] * sc; v.y += O[db][4 * r4 + 1] * sc; v.z += O[db][4 * r4 + 2] * sc; v.w += O[db][4 * r4 + 3] * sc; *p = v; }
                m2 = -1e30f; l = 0.f;
#pragma unroll
                for (int db = 0; db < 4; ++db)
#pragma unroll
                    for (int r = 0; r < 16; ++r) O[db][r] = 0.f;
            } else {
                float ss = 0.f; bf16* mp = W.mix + row * 2048 + 1024 + hq * 128 + 4 * h;
#pragma unroll
                for (int db = 0; db < 4; ++db)
#pragma unroll
                    for (int r4 = 0; r4 < 4; ++r4) { const f32x4 v = *(const GAS f32x4*)(op + 32 * db + 8 * r4);
                        const float a0 = v.x + O[db][4 * r4] * sc, a1 = v.y + O[db][4 * r4 + 1] * sc, a2 = v.z + O[db][4 * r4 + 2] * sc, a3 = v.w + O[db][4 * r4 + 3] * sc;
                        ss += (a0 * a0 + a1 * a1) + (a2 * a2 + a3 * a3);
                        *(GAS unsigned long long*)(mp + 32 * db + 8 * r4) = (unsigned long long)pk2(a0, a1) | ((unsigned long long)pk2(a2, a3) << 32); }
                ss = xhalf_sum(ss);
                if (h == 0) W.ssq[(size_t)hq * M + row] = ss;
            }
        }
        jcur = jn;
        asm volatile("s_waitcnt vmcnt(0)" ::: "memory");
        __syncthreads();
    }
}

__device__ __forceinline__ void ph_vt(Frame& F, const WsPtrs& W) {
    LAS bf16* T = (LAS bf16*)F.lds;
    for (int tile = F.bid; tile < 1024; tile += F.G) {
        const int which = tile & 1, kvh = (tile >> 1) & 1, tb = (tile >> 2) & 31, b = tile >> 7;
        const int zc = (which ? ZC_VW : ZC_VS) + kvh * 128; const size_t r0 = (size_t)b * SEQ + tb * 64;
        for (int e = F.tid; e < 64 * 16; e += 512) { const int r = e >> 4, qd = e & 15; *(LAS v4u*)(T + r * 136 + 8 * qd) = *(const GAS v4u*)(W.z + (r0 + r) * ZW + zc + 8 * qd); }
        __syncthreads();
        bf16* dst = (which ? W.vtw : W.vts) + (size_t)(b * 2 + kvh) * 128 * SEQ + tb * 64;
        for (int e = F.tid; e < 128 * 8; e += 512) { const int d = e >> 3, u = e & 7, kb = 16 * (u >> 1) + 4 * (u & 1);
            unsigned w[4];
#pragma unroll
            for (int i = 0; i < 4; ++i) { const int k0 = kb + (i >> 1) * 8 + (i & 1) * 2; w[i] = (unsigned)T[k0 * 136 + d] | ((unsigned)T[(k0 + 1) * 136 + d] << 16); }
            v4u o; o.x = w[0]; o.y = w[1]; o.z = w[2]; o.w = w[3];
            *(GAS v4u*)(dst + (size_t)d * SEQ + 8 * u) = o; }
        __syncthreads();
    }
}

__device__ __forceinline__ void ph_nsa_norm(Frame& F, const LayerPtrs& L, const WsPtrs& W) {
    const size_t total = (size_t)M * 128;
    for (size_t i = (size_t)F.bid * 512 + F.tid; i < total; i += (size_t)F.G * 512) {
        const int m = (int)(i >> 7), q = (int)(i & 127);
        float sq = 0.f;
#pragma unroll
        for (int hh = 0; hh < 8; ++hh) sq += W.ssq[(size_t)hh * M + m];
        const float rstd = 1.f / sqrtf(sq * (1.f / 1024.f) + NORM_EPS);
        GAS v4u* p = (GAS v4u*)(W.mix + (size_t)m * 2048 + 1024 + 8 * q); v4u v = *p; const float* gn = L.nsa_norm + 8 * q;
        unsigned w[4] = {v.x, v.y, v.z, v.w};
#pragma unroll
        for (int k = 0; k < 4; ++k) { const float lo = bf2f((bf16)(w[k] & 0xffffu)) * rstd * gn[2 * k], hi = bf2f((bf16)(w[k] >> 16)) * rstd * gn[2 * k + 1]; w[k] = pk2(lo, hi); }
        v.x = w[0]; v.y = w[1]; v.z = w[2]; v.w = w[3]; *p = v;
    }
}
__device__ __forceinline__ void ph_ffn_gate(Frame& F, const LayerPtrs& L, const WsPtrs& W) {
    constexpr int FG = D_FF / 8, NITEM = FG * (M / 64);
    for (int it = F.bid * 512 + F.tid; it < NITEM; it += F.G * 512) {
        const int blk = it / FG, q = it - blk * FG, f0 = 8 * q; const bool first = (blk & (SEQ / 64 - 1)) == 0;
        const bf16* e0 = W.u + (size_t)blk * 4 * (2 * D_FF) + f0; const bf16* ep = e0 - 4 * (2 * D_FF);
        v4u r[2][4];
#pragma unroll
        for (int s = 0; s < 2; ++s) { r[s][2] = *(const GAS v4u*)(e0 + s * D_FF); r[s][3] = *(const GAS v4u*)(e0 + (2 * D_FF) + s * D_FF);
            if (first) { r[s][0] = (v4u){0u, 0u, 0u, 0u}; r[s][1] = r[s][0]; } else { r[s][0] = *(const GAS v4u*)(ep + 2 * (2 * D_FF) + s * D_FF); r[s][1] = *(const GAS v4u*)(ep + 3 * (2 * D_FF) + s * D_FF); } }
        float wg[3][8], wu[3][8], bg[8], bu[8];
#pragma unroll
        for (int j = 0; j < 3; ++j) { const float* p = L.ffn_conv_w + (size_t)j * (2 * D_FF) + f0;
#pragma unroll
            for (int i = 0; i < 8; ++i) { wg[j][i] = p[i]; wu[j][i] = p[D_FF + i]; } }
#pragma unroll
        for (int i = 0; i < 8; ++i) { bg[i] = L.ffn_conv_b[f0 + i]; bu[i] = L.ffn_conv_b[D_FF + f0 + i]; }
#pragma unroll
        for (int e = 0; e < 2; ++e) {
            float yy[8];
#pragma unroll
            for (int k2 = 0; k2 < 4; ++k2) { float y[2];
#pragma unroll
                for (int hh = 0; hh < 2; ++hh) { const int i = 2 * k2 + hh;
                    const unsigned g2 = ((const unsigned*)&r[0][e])[k2], g1 = ((const unsigned*)&r[0][e + 1])[k2], gc = ((const unsigned*)&r[0][e + 2])[k2];
                    const unsigned u2 = ((const unsigned*)&r[1][e])[k2], u1 = ((const unsigned*)&r[1][e + 1])[k2], uc = ((const unsigned*)&r[1][e + 2])[k2];
                    const float ga = bg[i] + wg[0][i] * bf2f((bf16)(hh ? g2 >> 16 : g2 & 0xffffu)) + wg[1][i] * bf2f((bf16)(hh ? g1 >> 16 : g1 & 0xffffu)) + wg[2][i] * bf2f((bf16)(hh ? gc >> 16 : gc & 0xffffu));
                    const float ua = bu[i] + wu[0][i] * bf2f((bf16)(hh ? u2 >> 16 : u2 & 0xffffu)) + wu[1][i] * bf2f((bf16)(hh ? u1 >> 16 : u1 & 0xffffu)) + wu[2][i] * bf2f((bf16)(hh ? uc >> 16 : uc & 0xffffu));
                    y[hh] = siluf_(ga) * ua; }
                yy[2 * k2] = y[0] * pg8::F8_GS; yy[2 * k2 + 1] = y[1] * pg8::F8_GS; }
            *(GAS unsigned long long*)((unsigned char*)W.g + ((size_t)blk * 64 + e) * D_FF + f0) = (unsigned long long)pg8::pk4_fp8(yy[0], yy[1], yy[2], yy[3]) | ((unsigned long long)pg8::pk4_fp8(yy[4], yy[5], yy[6], yy[7]) << 32);
        }
    }
}


__device__ __forceinline__ void call_prologue(Frame& F, int layer) {
    const LayerPtrs L = make_L(F, layer); const WsPtrs W = make_W(F, layer); ph_prologue(F, L, W, layer == 0 ? inptr(F, 0) : (const float*)F.out, layer);
}
__device__ __forceinline__ void call_mix1(Frame& F, int layer) {
    const LayerPtrs L = make_L(F, layer); const WsPtrs W = make_W(F, layer);
    for (int u = F.bid; u < 256; u += F.G) cmp_unit(F, L, W, u, layer);
}
constexpr int I_UP = (D_MODEL / 64) * (2 * D_FF / 64), I_DN = (D_FF / 64) * (D_MODEL / 64), NCONV = (I_UP + I_DN) / 8;
static_assert((I_UP + I_DN) % 8 == 0, "conversion items");
constexpr int CW_QUEUE = 8192;
__device__ __forceinline__ void call_nsa(Frame& F, int layer, int pass) {
    const WsPtrs W = make_W(F, layer);
    if (F.bid < 64) { const LayerPtrs L = make_L(F, layer); for (int rep = 0; rep < (PROBE_DUP == 41 ? 2 : 1); ++rep) for (int u = F.bid; u < 64; u += (F.G < 64 ? F.G : 64)) mlstm2_unit(F, L, W, u >> 3, u & 7); }
    unsigned* head = (unsigned*)(F.ws + WS_CTL) + CW_QUEUE + 64 * layer + 256 * (1 - pass);
    LAS int* slot = (LAS int*)(F.lds + MISC_OFF + 64);
    for (;;) {
        __syncthreads();
        if (F.tid == 0) *slot = (int)__hip_atomic_fetch_add(head, 1u, __ATOMIC_RELAXED, __HIP_MEMORY_SCOPE_AGENT);
        __syncthreads();
        int u = *slot;
        if (u >= 512 + NCONV + (layer + 1 < DEPTH ? NSMALL / 8 : 0)) break;
        if (u < 1536) { const int t3 = u / 3, r3 = u - 3 * t3; u = r3 == 0 ? t3 : 512 + 2 * t3 + r3 - 1; }
        if (u >= 512 + NCONV) { const LayerPtrs L1 = make_L(F, layer + 1); const WsPtrs W1 = make_W(F, layer + 1); small_item(F, L1, W1, (u - 512 - NCONV) * 8 + F.wave, true); continue; }
        if (u >= 512) {
            const int wt = (u - 512) * 8 + F.wave;
            if (wt < I_UP) transpose_item<2>(inptr(F, 17) + (size_t)layer * D_MODEL * 2 * D_FF, D_MODEL, 2 * D_FF, 2 * D_FF, W.wup, wt, F.lane, inptr(F, 16) + (size_t)layer * D_MODEL);
            else transpose_item<3>(inptr(F, 20) + (size_t)layer * D_FF * D_MODEL, D_FF, D_MODEL, D_MODEL, W.wdn, wt - I_UP, F.lane);
            continue;
        }
        for (int p_ = (PROBE_DUP == 42 ? 0 : 1); p_ < 2; ++p_) nsa2_unit(F, W, (u & 15) >> 1, u & 1, 31 - (u >> 4), p_);
    }
}

struct Args { const float* in[22]; float* out; unsigned char* ws; int ph_lo, ph_hi, pad0, pad1; };
__global__ void __launch_bounds__(NWAVES * 64, 2) hymba_fwd(Args args) {
    extern __shared__ __attribute__((aligned(16))) unsigned char lds[];
    Frame F;
    F.lds = (LAS unsigned char*)lds;
    F.MISC = (volatile LAS unsigned*)(F.lds + MISC_OFF);
    F.tid = threadIdx.x; F.lane = F.tid & 63; F.wave = __builtin_amdgcn_readfirstlane(F.tid >> 6);
    F.G = gridDim.x; F.bid = blockIdx.x;
    unsigned char* ws = args.ws;
    F.ws = args.ws; F.out = args.out;
    F.ctl = (gu32*)(ws + WS_CTL);
    for (int u = F.tid; u < (LDS_BYTES - LDSCTL_OFF) / 4; u += NWAVES * 64) ((LAS unsigned*)(F.lds + LDSCTL_OFF))[u] = 0u;
    __syncthreads();
    if (F.tid < 22) ((LAS unsigned long long*)(F.lds + PT_OFF))[F.tid] = (unsigned long long)args.in[F.tid];
    __syncthreads();
    if (!MK_PER_PHASE) (void)xcd_barrier_post((unsigned*)(F.ctl + CW_BAR), F.MISC + 8);
#define GRID_BAR() do { if (MK_PER_PHASE) { if (F.tid == 0) __hip_atomic_store(F.ctl + 0, 0xBADBA0u, RLX_AGENT); } else { const WsPtrs Wb_ = make_W(F); unsigned st_ = (unsigned)(__UINTPTR_TYPE__)(F.lds + MISC_OFF + 32); asm volatile("" : "+s"(st_)); xcd_barrier_fn((unsigned*)Wb_.ropec - (WS_ROPE - WS_CTL) / 4 + CW_BAR, st_, (int)(F.tid == 0)); } } while (0)
    const int lo = args.ph_lo, hi = args.ph_hi;
#ifndef PH_MASK
#define PH_MASK 0xFFFFFF
#endif
#define PH_EN(k) ((PH_MASK >> (k)) & 1)
#define IN(k) (lo <= (k) && (k) < hi)
#define xcd_barrier_dummy() do { } while (0)
#define SEAM(k) do { if (IN((k) + 1)) GRID_BAR(); } while (0)
#define PHASE_FRAME(Fp) Frame Fp = F; { int l_ = (int)__builtin_amdgcn_mbcnt_hi(~0u, __builtin_amdgcn_mbcnt_lo(~0u, 0u)); asm volatile("" : "+v"(l_)); Fp.lane = l_; Fp.tid = F.wave * 64 + l_; int b_ = F.bid, g_ = F.G; asm volatile("" : "+s"(b_), "+s"(g_)); Fp.bid = b_; Fp.G = g_; }
#define LAYER_BODY(layer) { \
        const int pb = layer * PH_PER_LAYER; \
        if (layer == 0 && PH_EN(0) && IN(pb + 0)) { PHASE_FRAME(Fp); call_prologue(Fp, layer); if (PROBE_DUP == 0) { PHASE_FRAME(Fq); call_prologue(Fq, layer); } SEAM(pb + 0); } \
        if (PH_EN(1) && IN(pb + 1)) { \
            const WsPtrs W = make_W(F, layer); \
            pg8::Gemm g{layer == 0 ? W.xn : W.xr, W.win, M, ZW, D_MODEL}; pg8::StaticOrder S; S.init(M, ZW, F.G, F.bid); \
            pg8::EpiBf16<0> E{W.z, ZW, nullptr, 0, 0, 1.f, pg8::RowScale{layer == 0 ? (const float*)nullptr : (const float*)W.ssqp, 1.f / D_MODEL, NORM_EPS}, W.ropec, W.ropes, 0x15F0000u, SEQ - 1}; \
            pg8::gemm_phase<pg8::EpiBf16<0>, pg8::StaticOrder, PG8_ALIGN, PG8_SP2>(F.lds + RING_OFF, g, S, E, F.wave); \
            if (PROBE_DUP == 1) pg8::gemm_phase<pg8::EpiBf16<0>, pg8::StaticOrder, PG8_ALIGN, PG8_SP2>(F.lds + RING_OFF, g, S, E, F.wave); \
            SEAM(pb + 1); \
        } \
        if (PH_EN(2) && IN(pb + 2)) { PHASE_FRAME(Fp); { const WsPtrs W = make_W(Fp, layer); ph_vt(Fp, W); } call_mix1(Fp, layer); SEAM(pb + 2); } \
        if (PH_EN(4) && IN(pb + 4)) { for (int pass_ = (PROBE_DUP == 4 ? 0 : 1); pass_ < 2; ++pass_) { PHASE_FRAME(Fp); call_nsa(Fp, layer, pass_); } SEAM(pb + 4); } \
        if (PH_EN(6) && IN(pb + 6)) { \
            const WsPtrs W = make_W(F, layer); \
            pg8::Gemm g{W.mix, W.wout, M, D_MODEL, D_MODEL}; pg8::StaticOrder S; S.init(M, D_MODEL, F.G, F.bid); \
            if (layer == 0) { pg8::EpiRes<true> E{W.xr, (const void*)inptr(F, 0), D_MODEL, W.ssqp, 1.f, W.ssq, M}; pg8::gemm_phase<pg8::EpiRes<true>, pg8::StaticOrder, PG8_ALIGN, PG8_SP2, false, true>(F.lds + RING_OFF, g, S, E, F.wave); } \
            else { pg8::EpiRes<false> E{W.xr, (const void*)W.xr, D_MODEL, W.ssqp, 1.f, W.ssq, M}; pg8::gemm_phase<pg8::EpiRes<false>, pg8::StaticOrder, PG8_ALIGN, PG8_SP2, false, true>(F.lds + RING_OFF, g, S, E, F.wave); } \
            SEAM(pb + 6); \
        } \
        if (PH_EN(8) && IN(pb + 8)) { \
            const WsPtrs W = make_W(F, layer); \
            pg8::Gemm g{W.xr, W.wup, M, 2 * D_FF, D_MODEL}; pg8::StaticOrder S; S.init(M, 2 * D_FF, F.G, F.bid); \
            pg8::EpiGate E{pg8::RowScale{W.ssqp, 1.f / D_MODEL, NORM_EPS}, W.g, D_FF, inptr(F, 18) + (size_t)layer * 3 * 2 * D_FF, inptr(F, 19) + (size_t)layer * 2 * D_FF, D_FF, W.u}; \
            pg8::gemm_phase<pg8::EpiGate, pg8::StaticOrder, PG8_ALIGN, PG8_SP2>(F.lds + RING_OFF, g, S, E, F.wave); \
            SEAM(pb + 8); \
        } \
        if (PH_EN(9) && IN(pb + 9)) { PHASE_FRAME(Fp); const LayerPtrs L = make_L(Fp, layer); const WsPtrs W = make_W(Fp, layer); ph_ffn_gate(Fp, L, W); SEAM(pb + 9); } \
        if (PH_EN(10) && IN(pb + 10)) { \
            const WsPtrs W = make_W(F, layer); \
            pg8::Gemm g{W.g, W.wdn, M, D_MODEL, D_FF / 2}; pg8::StaticOrder S; S.init(M, D_MODEL, F.G, F.bid);     \
            pg8::EpiRes<false, true> E{W.xr, (const void*)W.xr, D_MODEL, W.ssqp, 1.f / (pg8::F8_GS * pg8::F8_WS)}; \
            pg8::gemm_phase<pg8::EpiRes<false, true>, pg8::StaticOrder, PG8_ALIGN, PG8_SP2, true>(F.lds + RING_OFF, g, S, E, F.wave); \
            SEAM(pb + 10); \
        } \
     \
    }
    LAYER_BODY(0)
    LAYER_BODY(1)
#undef LAYER_BODY
    if (IN(DEPTH * PH_PER_LAYER)) {
        PHASE_FRAME(Fp); const float* gain = inptr(Fp, 21);
        const int gw = Fp.bid * NWAVES + Fp.wave, NGW = Fp.G * NWAVES;
        const WsPtrs Wf = make_W(Fp, 0);
        for (int m = gw; m < M; m += NGW) rms_brow_to_f32(Wf.xr + (size_t)m * D_MODEL, gain, Fp.out + (size_t)m * D_MODEL, Fp.lane);
    }
#undef IN
#undef SEAM
}

extern "C" void kernel_launch(void* const* d_in, const int* in_sizes, int n_in, void* d_out, int out_size, void* d_ws, size_t ws_size, hipStream_t stream) {
    static int grid = 0;
    if (grid == 0) {
        if (n_in != 22 || in_sizes[0] != M * D_MODEL || out_size != M * D_MODEL || ws_size < WS_END) { fprintf(stderr, "kernel_launch: unexpected shapes (n_in %d, in0 %d, out %d, ws %zu < %zu); nothing launched\n", n_in, n_in > 0 ? in_sizes[0] : -1, out_size, ws_size, (size_t)WS_END); grid = -1; return; }
        int dev = 0, cus = 0, per_cu = 0;
        if (hipGetDevice(&dev) != hipSuccess || hipDeviceGetAttribute(&cus, hipDeviceAttributeMultiprocessorCount, dev) != hipSuccess) { fprintf(stderr, "kernel_launch: device query failed\n"); grid = -1; return; }
        if (hipFuncSetAttribute((const void*)hymba_fwd, hipFuncAttributeMaxDynamicSharedMemorySize, LDS_BYTES) != hipSuccess) { fprintf(stderr, "kernel_launch: hipFuncSetAttribute failed\n"); grid = -1; return; }
        if (hipOccupancyMaxActiveBlocksPerMultiprocessor(&per_cu, (const void*)hymba_fwd, NWAVES * 64, LDS_BYTES) != hipSuccess || per_cu < 1)
            fprintf(stderr, "kernel_launch: note: occupancy query reports %d workgroups per CU\n", per_cu);
        (void)hipGetLastError();
        grid = cus;
    }
    if (grid < 0) return;
    if (hipMemsetAsync((char*)d_ws + WS_CTL, 0, CTL_ZERO_BYTES, stream) != hipSuccess) { fprintf(stderr, "kernel_launch: memset failed\n"); return; }
    Args a{};
    for (int i = 0; i < 22; ++i) a.in[i] = (const float*)d_in[i];
    a.out = (float*)d_out; a.ws = (unsigned char*)d_ws; a.pad0 = 0; a.pad1 = 0;
#if MK_PER_PHASE
    for (int p = 0; p < N_PHASES; ++p) { a.ph_lo = p; a.ph_hi = p + 1; hipLaunchKernelGGL(hymba_fwd, dim3(grid), dim3(NWAVES * 64), LDS_BYTES, stream, a); }
#else
    a.ph_lo = 0; a.ph_hi = N_PHASES; hipLaunchKernelGGL(hymba_fwd, dim3(grid), dim3(NWAVES * 64), LDS_BYTES, stream, a);
#endif
    const hipError_t le = hipPeekAtLastError();
    if (le != hipSuccess) fprintf(stderr, "kernel_launch: launch failed: %s\n", hipGetErrorName(le));
}
```

```cpp
#include <hip/hip_runtime.h>
#include <cstdio>
#include <cstdint>
#ifndef PROBE_DUP
#define PROBE_DUP -1
#endif
namespace pg8 {
#define PG8_LAS __attribute__((address_space(3)))
#ifndef EPI_SPLIT_BF16
#define EPI_SPLIT_BF16 true
#endif
#ifndef EPI_SPLIT_RES
#define EPI_SPLIT_RES true
#endif
#ifndef EPI_SPLIT_GATE
#define EPI_SPLIT_GATE true
#endif
#define PG8_GAS __attribute__((address_space(1)))
typedef unsigned short bf16_t;
typedef short bf16x8 __attribute__((ext_vector_type(8)));
typedef float f32x4 __attribute__((ext_vector_type(4)));
typedef unsigned u32x4 __attribute__((ext_vector_type(4)));
constexpr int BM = 256, BK = 64, HALF = 128, HTB = HALF * BK * 2  , STAGE_BYTES = 8 * HTB, NXCD = 8, WGM = 8;

__host__ __device__ __forceinline__ int lds_byte(int r, int c) { const int st = (r >> 4) * 2 + (c >> 5), rr = r & 15, cc = c & 31, ob = rr * 64 + cc * 2; return st * 1024 + (ob ^ (((ob >> 9) & 1) << 5)); }
__host__ __device__ __forceinline__ void stage_rc(int b, int& R, int& C) { const int st = b / 1024, sb = b % 1024, swz = sb ^ (((sb >> 9) & 1) << 5); R = (st >> 1) * 16 + swz / 64; C = (st & 1) * 32 + (swz % 64) / 2; }
__host__ __device__ __forceinline__ int perm32(int rho) { const int n = rho >> 4, i = rho & 15; return 8 * (i >> 2) + 4 * n + (i & 3); }

struct Unit { int pm, pn; };
struct Gemm { const bf16_t* A; const bf16_t* Bt; int M, N, K; };

struct StaticOrder {
    int nM, nN, nwg, G, c;
    __host__ __device__ void init(int M, int N, int G_, int c_) { nM = M / BM; nN = N / BM; nwg = nM * nN; G = G_; c = c_; }
    __host__ __device__ bool next(int i, Unit& u) const {
        const long L = (long)i * G + c; if (L >= nwg) return false;
        int wgid = (int)L; { const int q = nwg / NXCD, r = nwg % NXCD, xcd = wgid % NXCD, off = wgid / NXCD; wgid = (xcd < r ? xcd * (q + 1) : r * (q + 1) + (xcd - r) * q) + off; }
        const int nig = WGM * nN, gid = wgid / nig, fm = gid * WGM, gsz = (nM - fm) < WGM ? (nM - fm) : WGM;
        u.pm = fm + ((wgid % nig) % gsz); u.pn = (wgid % nig) / gsz; return true;
    }
    __device__ __forceinline__ void a_ready(const Unit&) const {}
    __device__ __forceinline__ void done(const Unit&) const {}
};

__device__ __forceinline__ unsigned cvt_pk_bf16(float lo, float hi) { unsigned r; asm volatile("v_cvt_pk_bf16_f32 %0, %1, %2" : "=v"(r) : "v"(lo), "v"(hi)); return r; }
typedef float f32x2 __attribute__((ext_vector_type(2)));
typedef int i32x4 __attribute__((ext_vector_type(4)));
typedef int i32x8 __attribute__((ext_vector_type(8)));
constexpr float F8_GS = 8.f, F8_WS = 64.f;
__device__ __forceinline__ unsigned pk4_fp8(float a, float b, float c, float d) {
    a = __builtin_amdgcn_fmed3f(a, -448.f, 448.f); b = __builtin_amdgcn_fmed3f(b, -448.f, 448.f); c = __builtin_amdgcn_fmed3f(c, -448.f, 448.f); d = __builtin_amdgcn_fmed3f(d, -448.f, 448.f);
    unsigned w; asm volatile("v_cvt_pk_fp8_f32 %0, %1, %2\n\tv_cvt_pk_fp8_f32 %0, %3, %4 op_sel:[0,0,1]" : "=&v"(w) : "v"(a), "v"(b), "v"(c), "v"(d)); return w; }
__device__ __forceinline__ f32x2 gelu_pk(f32x2 v) {
    const f32x2 av = __builtin_elementwise_abs(v), d = av * 0.2316418882f + 1.0f;
    f32x2 t; t.x = __builtin_amdgcn_rcpf(d.x); t.y = __builtin_amdgcn_rcpf(d.y);
    f32x2 q = t * 0.5307027145f + (-0.7265760135f); q = q * t + 0.7107068705f; q = q * t + (-0.142248368f); q = q * t + 0.127414796f; q = q * t;
    const f32x2 s = (v * v) * (-0.72134752044f);
    f32x2 e; e.x = __builtin_amdgcn_exp2f(s.x); e.y = __builtin_amdgcn_exp2f(s.y);
    const f32x2 m = v * (q * e), r = v - m;
    f32x2 o; o.x = v.x < 0.f ? m.x : r.x; o.y = v.y < 0.f ? m.y : r.y; return o;
}

constexpr int RS_OFF = STAGE_BYTES;
struct RowScale {
    const float* part; float inv_n, eps;
    struct Pre { f32x4 v[2]; };
    __device__ __forceinline__ void issue(const Unit& u, int tid, Pre& p) const {
        if (part != nullptr && tid < BM) { const PG8_GAS f32x4* q = (const PG8_GAS f32x4*)(part + (size_t)(u.pm * BM + tid) * 8); p.v[0] = q[0]; p.v[1] = q[1]; } }
    __device__ __forceinline__ void finish(const Pre& p, int slot, int tid, PG8_LAS unsigned char* lds) const {
        if (part != nullptr && tid < BM) { const float s = ((p.v[0][0] + p.v[0][1]) + (p.v[0][2] + p.v[0][3])) + ((p.v[1][0] + p.v[1][1]) + (p.v[1][2] + p.v[1][3]));
            ((PG8_LAS float*)(lds + RS_OFF))[slot * BM + tid] = 1.0f / sqrtf(s * inv_n + eps); } }
    __device__ __forceinline__ float get(PG8_LAS unsigned char* lds, int slot, int r) const { return part != nullptr ? ((const PG8_LAS float*)(lds + RS_OFF))[slot * BM + r] : 1.f; }
};
template <int ACT  > struct EpiBf16 {
    static constexpr bool PERM = true, AFTER_DRAIN = false; static_assert(ACT == 0 || ACT == 1, "EpiBf16: ACT is 0 (none) or 1 (gelu_pk)");
    bf16_t* O; int ldc; const float* bias; int split_cols; size_t split_stride; float scale0;
    RowScale rsc;
    typedef RowScale::Pre Pre; static constexpr bool SPLIT_PRE = EPI_SPLIT_BF16;
    __device__ __forceinline__ void issue(const Unit& u, int tid, Pre& p) const { rsc.issue(u, tid, p); }
    __device__ __forceinline__ void finish(const Pre& p, const Unit&, int slot, int tid, PG8_LAS unsigned char* lds) const { rsc.finish(p, slot, tid, lds); }
    const float* rc; const float* rs; unsigned rmask; int posmask; unsigned smask = 0u;
    static __device__ __forceinline__ float other32(float v, bool hi) { auto rr = __builtin_amdgcn_permlane32_swap(__builtin_bit_cast(unsigned, v), __builtin_bit_cast(unsigned, v), false, false); return __builtin_bit_cast(float, hi ? rr[0] : rr[1]); }
    __device__ __forceinline__ void operator()(const f32x4 (&acc)[2][2][4][2], const Unit& u, int wr, int wc, int fr, int fq, PG8_LAS unsigned char* lds, int slot) const {
        const int row0 = u.pm * BM + wr * 64 + fr; int colt = u.pn * BM; bf16_t* base = O;
        float sc = 1.f; if (split_cols) { const int t = colt / split_cols; base += (size_t)t * split_stride; colt -= t * split_cols; if (t == 0) sc = scale0; }
        const int col0 = colt + wc * 32 + 8 * fq, bcol0 = u.pn * BM + wc * 32 + 8 * fq;
        const bool do_rope = rc != nullptr && wc == 0 && ((rmask >> u.pn) & 1u);
        f32x4 bv[2][2];
#pragma unroll
        for (int bj = 0; bj < 2; ++bj)
#pragma unroll
            for (int n = 0; n < 2; ++n) bv[bj][n] = bias ? *(const PG8_GAS f32x4*)(bias + bcol0 + bj * HALF + 4 * n) : (f32x4){0.f, 0.f, 0.f, 0.f};
        f32x4 nc0 = {1.f, 1.f, 1.f, 1.f}, nc1 = nc0, ns0 = {0.f, 0.f, 0.f, 0.f}, ns1 = ns0;
        if (do_rope) { const int pos = row0 & posmask; const float* tc = rc + pos * 16 + 8 * (fq & 1); const float* ts = rs + pos * 16 + 8 * (fq & 1);
            nc0 = *(const PG8_GAS f32x4*)tc; nc1 = *(const PG8_GAS f32x4*)(tc + 4); ns0 = *(const PG8_GAS f32x4*)ts; ns1 = *(const PG8_GAS f32x4*)(ts + 4); }
#pragma unroll
        for (int ai = 0; ai < 2; ++ai)
#pragma unroll
            for (int m = 0; m < 4; ++m) { bf16_t* rowp = base + (size_t)(row0 + ai * HALF + m * 16) * ldc + col0;
                f32x4 c0 = nc0, c1 = nc1, s0 = ns0, s1 = ns1;
                if (do_rope) { if (fq < 2) { s0 = -s0; s1 = -s1; }
                    if (ai * 4 + m < 7) { const int gn = ai * 4 + m + 1; const int pos = (row0 + (gn >> 2) * HALF + (gn & 3) * 16) & posmask; const float* tc = rc + pos * 16 + 8 * (fq & 1); const float* ts = rs + pos * 16 + 8 * (fq & 1);
                        nc0 = *(const PG8_GAS f32x4*)tc; nc1 = *(const PG8_GAS f32x4*)(tc + 4); ns0 = *(const PG8_GAS f32x4*)ts; ns1 = *(const PG8_GAS f32x4*)(ts + 4); } }
                const float rsv = rsc.get(lds, slot, ai * HALF + wr * 64 + m * 16 + fr);
#pragma unroll
                for (int bj = 0; bj < 2; ++bj) { f32x4 v0 = (acc[ai][bj][m][0] + bv[bj][0]) * rsv, v1 = (acc[ai][bj][m][1] + bv[bj][1]) * rsv;
                    if (do_rope) {
#pragma unroll
                        for (int i = 0; i < 4; ++i) { const float p0 = other32(v0[i], fq >= 2), p1 = other32(v1[i], fq >= 2); v0[i] = v0[i] * c0[i] + p0 * s0[i]; v1[i] = v1[i] * c1[i] + p1 * s1[i]; } }
                    if (ACT == 1) { f32x2 a = gelu_pk((f32x2){v0[0], v0[1]}), b = gelu_pk((f32x2){v0[2], v0[3]}), c = gelu_pk((f32x2){v1[0], v1[1]}), d = gelu_pk((f32x2){v1[2], v1[3]});
                        v0 = (f32x4){a.x, a.y, b.x, b.y}; v1 = (f32x4){c.x, c.y, d.x, d.y}; }
                    if ((smask >> u.pn) & 1u) {
#pragma unroll
                        for (int i = 0; i < 4; ++i) { v0[i] = __builtin_amdgcn_rcpf(1.f + __builtin_amdgcn_exp2f(-1.4426950408889634f * v0[i])); v1[i] = __builtin_amdgcn_rcpf(1.f + __builtin_amdgcn_exp2f(-1.4426950408889634f * v1[i])); } }
                    v0 = v0 * sc; v1 = v1 * sc; u32x4 w; w.x = cvt_pk_bf16(v0[0], v0[1]); w.y = cvt_pk_bf16(v0[2], v0[3]); w.z = cvt_pk_bf16(v1[0], v1[1]); w.w = cvt_pk_bf16(v1[2], v1[3]);
                    *(PG8_GAS u32x4*)(rowp + bj * HALF) = w; } }
    }
};
template <bool RF32, bool SC = false> struct EpiRes {
    static constexpr bool PERM = true, AFTER_DRAIN = false;
    bf16_t* X; const void* R; int ldc; float* SSQP; float osc = 1.f;
    const float* hssq = nullptr; int hM = 0;
    struct Pre { float v[8]; }; static constexpr bool SPLIT_PRE = EPI_SPLIT_RES;
    __device__ __forceinline__ void issue(const Unit& u, int tid, Pre& p) const {
        if (hssq != nullptr && tid < BM) { const PG8_GAS float* q = (const PG8_GAS float*)hssq + u.pm * BM + tid;
#pragma unroll
            for (int h = 0; h < 8; ++h) p.v[h] = q[(size_t)h * hM]; } }
    __device__ __forceinline__ void finish(const Pre& p, const Unit&, int slot, int tid, PG8_LAS unsigned char* lds) const {
        if (hssq != nullptr && tid < BM) { float s = 0.f;
#pragma unroll
            for (int h = 0; h < 8; ++h) s += p.v[h];
            ((PG8_LAS float*)(lds + RS_OFF))[slot * BM + tid] = 1.0f / sqrtf(s * (1.f / 1024.f) + 1e-6f); } }
    __device__ __forceinline__ void mid(f32x4 (&acc)[2][2][4][2], int wr, int fr, PG8_LAS unsigned char* lds, int slot) const {
#pragma unroll
        for (int ai = 0; ai < 2; ++ai)
#pragma unroll
            for (int m = 0; m < 4; ++m) { const float rs = ((const PG8_LAS float*)(lds + RS_OFF))[slot * BM + ai * HALF + wr * 64 + m * 16 + fr];
#pragma unroll
                for (int bj = 0; bj < 2; ++bj)
#pragma unroll
                    for (int n = 0; n < 2; ++n) acc[ai][bj][m][n] = acc[ai][bj][m][n] * rs; } }
    static __device__ __forceinline__ float sq8(const u32x4 w) { float s = 0.f; const unsigned a[4] = {w.x, w.y, w.z, w.w};
#pragma unroll
        for (int i = 0; i < 4; ++i) { const float lo = __builtin_bit_cast(float, a[i] << 16), hi = __builtin_bit_cast(float, a[i] & 0xffff0000u); s += lo * lo + hi * hi; } return s; }
    static constexpr int SQ_OFF = 136192;
    __device__ __forceinline__ void put_ssq(float ss, int rloc, int wc, int fq, PG8_LAS unsigned char* lds) const {
        ss += __builtin_bit_cast(float, __builtin_amdgcn_ds_swizzle(__builtin_bit_cast(int, ss), 0x401F));
        if ((fq & 1) == 0) ((PG8_LAS float*)(lds + SQ_OFF))[(wc * 2 + (fq >> 1)) * BM + rloc] = ss; }
    __device__ __forceinline__ void flush_ssq(const Unit& u, int wr, int wc, int fr, int fq, PG8_LAS unsigned char* lds) const {
        asm volatile("s_waitcnt lgkmcnt(0)" ::: "memory"); __builtin_amdgcn_s_barrier();
        if (wr == 0) { const int r = wc * 64 + fq * 16 + fr; const PG8_LAS float* t = (const PG8_LAS float*)(lds + SQ_OFF) + r; float s = 0.f;
#pragma unroll
            for (int j = 0; j < 8; ++j) s += t[j * BM];
            ((PG8_GAS float*)SSQP)[(size_t)(u.pm * BM + r) * 8 + u.pn] = s; } }
    __device__ __forceinline__ void operator()(const f32x4 (&acc)[2][2][4][2], const Unit& u, int wr, int wc, int fr, int fq, PG8_LAS unsigned char* lds, int slot) const {
        const int row0 = u.pm * BM + wr * 64 + fr, col0 = u.pn * BM + wc * 32 + 8 * fq;
#pragma unroll
        for (int ai = 0; ai < 2; ++ai) {
            if constexpr (RF32) {
                f32x4 rv[4][2][2];
#pragma unroll
                for (int m = 0; m < 4; ++m) { const size_t off = (size_t)(row0 + ai * HALF + m * 16) * ldc + col0;
#pragma unroll
                    for (int bj = 0; bj < 2; ++bj)
#pragma unroll
                        for (int n = 0; n < 2; ++n) rv[m][bj][n] = *(const PG8_GAS f32x4*)((const float*)R + off + bj * HALF + n * 4); }
#pragma unroll
                for (int m = 0; m < 4; ++m) { const size_t off = (size_t)(row0 + ai * HALF + m * 16) * ldc + col0; float ss = 0.f;
#pragma unroll
                    for (int bj = 0; bj < 2; ++bj) { const f32x4 v0 = acc[ai][bj][m][0] + rv[m][bj][0], v1 = acc[ai][bj][m][1] + rv[m][bj][1];
                        u32x4 w; w.x = cvt_pk_bf16(v0[0], v0[1]); w.y = cvt_pk_bf16(v0[2], v0[3]); w.z = cvt_pk_bf16(v1[0], v1[1]); w.w = cvt_pk_bf16(v1[2], v1[3]);
                        ss += sq8(w); *(PG8_GAS u32x4*)(X + off + bj * HALF) = w; }
                    put_ssq(ss, ai * HALF + wr * 64 + m * 16 + fr, wc, fq, lds); }
            } else {
                u32x4 rv[4][2];
#pragma unroll
                for (int m = 0; m < 4; ++m) { const size_t off = (size_t)(row0 + ai * HALF + m * 16) * ldc + col0;
#pragma unroll
                    for (int bj = 0; bj < 2; ++bj) rv[m][bj] = *(const PG8_GAS u32x4*)((const bf16_t*)R + off + bj * HALF); }
#pragma unroll
                for (int m = 0; m < 4; ++m) { const size_t off = (size_t)(row0 + ai * HALF + m * 16) * ldc + col0; float ss = 0.f;
#pragma unroll
                    for (int bj = 0; bj < 2; ++bj) { const u32x4 r = rv[m][bj];
                        const f32x4 r0 = (f32x4){__builtin_bit_cast(float, r.x << 16), __builtin_bit_cast(float, r.x & 0xffff0000u), __builtin_bit_cast(float, r.y << 16), __builtin_bit_cast(float, r.y & 0xffff0000u)};
                        const f32x4 r1 = (f32x4){__builtin_bit_cast(float, r.z << 16), __builtin_bit_cast(float, r.z & 0xffff0000u), __builtin_bit_cast(float, r.w << 16), __builtin_bit_cast(float, r.w & 0xffff0000u)};
                        const f32x4 v0 = SC ? acc[ai][bj][m][0] * osc + r0 : acc[ai][bj][m][0] + r0, v1 = SC ? acc[ai][bj][m][1] * osc + r1 : acc[ai][bj][m][1] + r1;
                        u32x4 w; w.x = cvt_pk_bf16(v0[0], v0[1]); w.y = cvt_pk_bf16(v0[2], v0[3]); w.z = cvt_pk_bf16(v1[0], v1[1]); w.w = cvt_pk_bf16(v1[2], v1[3]);
                        ss += sq8(w); *(PG8_GAS u32x4*)(X + off + bj * HALF) = w; }
                    put_ssq(ss, ai * HALF + wr * 64 + m * 16 + fr, wc, fq, lds); }
            }
            asm volatile("" ::: "memory");
        }
        flush_ssq(u, wr, wc, fr, fq, lds);
    }
};

struct EpiGate {
    static constexpr bool PERM = true, AFTER_DRAIN = false;
    RowScale rsc;
    static constexpr int TAP_OFF = 136192;
    struct Pre { RowScale::Pre r; float a0, a1, a2, a3; }; static constexpr bool SPLIT_PRE = EPI_SPLIT_GATE;
    __device__ __forceinline__ void issue(const Unit& u, int tid, Pre& p) const {
        const int ch = tid & 127, path = (tid >> 7) & 1;
        if (tid < BM) { const PG8_GAS float* pg_ = (const PG8_GAS float*)(cw + (size_t)path * dff + u.pn * 128 + ch); p.a0 = pg_[0]; p.a1 = pg_[2 * dff]; p.a2 = pg_[4 * dff]; p.a3 = ((const PG8_GAS float*)cb)[(size_t)path * dff + u.pn * 128 + ch]; }
        rsc.issue(u, tid, p.r); }
    __device__ __forceinline__ void finish(const Pre& p, const Unit&, int slot, int tid, PG8_LAS unsigned char* lds) const {
        rsc.finish(p.r, slot, tid, lds);
        if (tid < BM) { const int ch = tid & 127, path = (tid >> 7) & 1; PG8_LAS float* t = (PG8_LAS float*)(lds + TAP_OFF) + slot * 1024 + path * 512 + ch; t[0] = p.a0; t[128] = p.a1; t[256] = p.a2; t[384] = p.a3; } }
    bf16_t* G; int ldg; const float* cw; const float* cb; int dff; bf16_t* edge;
    __device__ __forceinline__ void operator()(const f32x4 (&acc)[2][2][4][2], const Unit& u, int wr, int wc, int fr, int fq, PG8_LAS unsigned char* lds, int slot) const {
        const int f0 = u.pn * 128 + wc * 32 + 8 * fq;
        const float m0 = fr == 0 ? 1.f : 0.f, m01 = fr < 2 ? 1.f : 0.f;
#define PG8_DPP(v, ctrl) __builtin_bit_cast(float, __builtin_amdgcn_update_dpp(0, __builtin_bit_cast(int, (v)), (ctrl), 0xf, 0xf, true))
#pragma unroll
        for (int ai = 0; ai < 2; ++ai) {
            const int rowb = u.pm * BM + ai * HALF + wr * 64;
            unsigned og[4][2];
            float rsv[4];
#pragma unroll
            for (int m = 0; m < 4; ++m) rsv[m] = rsc.get(lds, slot, ai * HALF + wr * 64 + 16 * m + fr);
#pragma unroll
            for (int n = 0; n < 2; ++n) {
                const PG8_LAS float* tp = (const PG8_LAS float*)(lds + TAP_OFF) + slot * 1024 + wc * 32 + 8 * fq + 4 * n;
                const f32x4 g0 = *(const PG8_LAS f32x4*)tp, g1 = *(const PG8_LAS f32x4*)(tp + 128), g2 = *(const PG8_LAS f32x4*)(tp + 256), gb = *(const PG8_LAS f32x4*)(tp + 384);
                const f32x4 u0 = *(const PG8_LAS f32x4*)(tp + 512), u1 = *(const PG8_LAS f32x4*)(tp + 640), u2 = *(const PG8_LAS f32x4*)(tp + 768), ub = *(const PG8_LAS f32x4*)(tp + 896);
                const f32x4 g1m = g1 * m0, g0m = g0 * m01, u1m = u1 * m0, u0m = u0 * m01;
#define PG8_TAPS(y, x, t1, t0, c1, c0) asm volatile("s_nop 1\n\t" \
                    "v_fmac_f32_dpp %0, %4, %8 " c1 " row_mask:0xf bank_mask:0xf bound_ctrl:1\n\tv_fmac_f32_dpp %1, %5, %9 " c1 " row_mask:0xf bank_mask:0xf bound_ctrl:1\n\t" \
                    "v_fmac_f32_dpp %2, %6, %10 " c1 " row_mask:0xf bank_mask:0xf bound_ctrl:1\n\tv_fmac_f32_dpp %3, %7, %11 " c1 " row_mask:0xf bank_mask:0xf bound_ctrl:1\n\t" \
                    "v_fmac_f32_dpp %0, %4, %12 " c0 " row_mask:0xf bank_mask:0xf bound_ctrl:1\n\tv_fmac_f32_dpp %1, %5, %13 " c0 " row_mask:0xf bank_mask:0xf bound_ctrl:1\n\t" \
                    "v_fmac_f32_dpp %2, %6, %14 " c0 " row_mask:0xf bank_mask:0xf bound_ctrl:1\n\tv_fmac_f32_dpp %3, %7, %15 " c0 " row_mask:0xf bank_mask:0xf bound_ctrl:1" \
                    : "+v"(y[0]), "+v"(y[1]), "+v"(y[2]), "+v"(y[3]) : "v"(x[0]), "v"(x[1]), "v"(x[2]), "v"(x[3]), "v"(t1[0]), "v"(t1[1]), "v"(t1[2]), "v"(t1[3]), "v"(t0[0]), "v"(t0[1]), "v"(t0[2]), "v"(t0[3]))
                f32x4 pg, pu;
#pragma unroll
                for (int m = 0; m < 4; ++m) {
                    float yo[4];
                    const f32x4 xg = acc[ai][0][m][n] * rsv[m], xu = acc[ai][1][m][n] * rsv[m];
                    f32x4 yg = gb + g2 * xg, yu = ub + u2 * xu;
                    PG8_TAPS(yg, xg, g1, g0, "row_shr:1", "row_shr:2"); PG8_TAPS(yu, xu, u1, u0, "row_shr:1", "row_shr:2");
                    if (m > 0) { PG8_TAPS(yg, pg, g1m, g0m, "row_ror:1", "row_ror:2"); PG8_TAPS(yu, pu, u1m, u0m, "row_ror:1", "row_ror:2"); }
                    pg = xg; pu = xu;
#pragma unroll
                    for (int i = 0; i < 4; ++i) {
                        const float sg = yg[i] * __builtin_amdgcn_rcpf(1.f + __builtin_amdgcn_exp2f(-1.4426950408889634f * yg[i]));
                        yo[i] = sg * yu[i];
                    }
                    og[m][n] = pk4_fp8(yo[0] * F8_GS, yo[1] * F8_GS, yo[2] * F8_GS, yo[3] * F8_GS);
                }
            }
#pragma unroll
            for (int m = 0; m < 4; ++m) {
                if (m > 0 || fr >= 2) { unsigned long long w = (unsigned long long)og[m][0] | ((unsigned long long)og[m][1] << 32); *(PG8_GAS unsigned long long*)((unsigned char*)G + (size_t)(rowb + 16 * m + fr) * ldg + f0) = w; }
            }
            if (fr < 2 || fr >= 14) { const int m = fr < 2 ? 0 : 3, e = fr < 2 ? fr : fr - 12;
                bf16_t* ep = edge + ((size_t)(rowb >> 6) * 4 + e) * (2 * dff) + f0;
                u32x4 wg, wu;
                if (fr < 2) { wg.x = cvt_pk_bf16((acc[ai][0][0][0][0] * rsv[0]), (acc[ai][0][0][0][1] * rsv[0])); wg.y = cvt_pk_bf16((acc[ai][0][0][0][2] * rsv[0]), (acc[ai][0][0][0][3] * rsv[0])); wg.z = cvt_pk_bf16((acc[ai][0][0][1][0] * rsv[0]), (acc[ai][0][0][1][1] * rsv[0])); wg.w = cvt_pk_bf16((acc[ai][0][0][1][2] * rsv[0]), (acc[ai][0][0][1][3] * rsv[0]));
                              wu.x = cvt_pk_bf16((acc[ai][1][0][0][0] * rsv[0]), (acc[ai][1][0][0][1] * rsv[0])); wu.y = cvt_pk_bf16((acc[ai][1][0][0][2] * rsv[0]), (acc[ai][1][0][0][3] * rsv[0])); wu.z = cvt_pk_bf16((acc[ai][1][0][1][0] * rsv[0]), (acc[ai][1][0][1][1] * rsv[0])); wu.w = cvt_pk_bf16((acc[ai][1][0][1][2] * rsv[0]), (acc[ai][1][0][1][3] * rsv[0])); }
                else {        wg.x = cvt_pk_bf16((acc[ai][0][3][0][0] * rsv[3]), (acc[ai][0][3][0][1] * rsv[3])); wg.y = cvt_pk_bf16((acc[ai][0][3][0][2] * rsv[3]), (acc[ai][0][3][0][3] * rsv[3])); wg.z = cvt_pk_bf16((acc[ai][0][3][1][0] * rsv[3]), (acc[ai][0][3][1][1] * rsv[3])); wg.w = cvt_pk_bf16((acc[ai][0][3][1][2] * rsv[3]), (acc[ai][0][3][1][3] * rsv[3]));
                              wu.x = cvt_pk_bf16((acc[ai][1][3][0][0] * rsv[3]), (acc[ai][1][3][0][1] * rsv[3])); wu.y = cvt_pk_bf16((acc[ai][1][3][0][2] * rsv[3]), (acc[ai][1][3][0][3] * rsv[3])); wu.z = cvt_pk_bf16((acc[ai][1][3][1][0] * rsv[3]), (acc[ai][1][3][1][1] * rsv[3])); wu.w = cvt_pk_bf16((acc[ai][1][3][1][2] * rsv[3]), (acc[ai][1][3][1][3] * rsv[3])); }
                (void)m; *(PG8_GAS u32x4*)ep = wg; *(PG8_GAS u32x4*)(ep + dff) = wu; }
        }
#undef PG8_DPP
#undef PG8_TAPS
    }
};

template <bool F8> struct Frag;
template <> struct Frag<false> { bf16x8 k[2]; __device__ __forceinline__ void ld(int i, const PG8_LAS unsigned char* p) { k[i] = *(const PG8_LAS bf16x8*)p; } };
template <> struct Frag<true> { i32x8 v; __device__ __forceinline__ void ld(int i, const PG8_LAS unsigned char* p) { if (i == 0) v.lo = *(const PG8_LAS i32x4*)p; else v.hi = *(const PG8_LAS i32x4*)p; } };
template <class Epi, class Sched, bool ALIGN_EPI = false, bool SP2 = false, bool F8 = false, bool KROT = false>
__device__ __forceinline__ void gemm_phase(PG8_LAS unsigned char* lds, const Gemm g, const Sched& S, const Epi& E, const int wave_id) {
    int lane_ = (int)__builtin_amdgcn_mbcnt_hi(~0u, __builtin_amdgcn_mbcnt_lo(~0u, 0u)); asm volatile("" : "+v"(lane_));
    const int tid = wave_id * 64 + lane_, wid = __builtin_amdgcn_readfirstlane(tid >> 6), lane = tid & 63, wr = wid >> 2, wc = wid & 3, fr = lane & 15, fq = lane >> 4;
    const int K = g.K, nt = K / BK;
    unsigned voffA[2], voffB[2];
#pragma unroll
    for (int i = 0; i < 2; ++i) { int R, C; stage_rc(tid * 16 + i * 8192, R, C); const int Rb = Epi::PERM ? ((R & ~31) + perm32(R & 31)) : R;
        voffA[i] = (unsigned)(R * K + C) * 2u; voffB[i] = (unsigned)(Rb * K + C) * 2u; }
    const size_t kstep = (size_t)(BK * 2);
    const size_t rot = KROT ? (size_t)(nt / 2) * kstep : 0;
#define PG8_KO(t) (KROT ? (size_t)(((t) + nt / 2) & (nt - 1)) * kstep : (size_t)(t) * kstep)
    const size_t hstep = (size_t)HALF * K * 2;
    const size_t tstep = 2 * hstep;
    const unsigned ldsw = (unsigned)wid * 1024u;
    const int aoff = lds_byte(wr * 64 + fr, fq * 8), boff = lds_byte(wc * 32 + fr, fq * 8);
#define PG8_SA(b, h) (((b) * 2 + (h)) * HTB)
#define PG8_SB(b, h) ((4 + (b) * 2 + (h)) * HTB)
#define PG8_STAGE(bufoff, gbase, voff) do { _Pragma("unroll") for (int _i = 0; _i < 2; ++_i) \
        __builtin_amdgcn_global_load_lds((const unsigned*)((const char*)(gbase) + (voff)[_i]), (PG8_LAS unsigned*)(lds + (bufoff) + ldsw + _i * 8192), 16, 0, 0); } while (0)
#define PG8_LDA(dst, b, h) do { _Pragma("unroll") for (int m = 0; m < 4; ++m) _Pragma("unroll") for (int k = 0; k < 2; ++k) dst[m].ld(k, lds + PG8_SA(b, h) + aoff + m * 2048 + k * 1024); } while (0)
#define PG8_LDB(dst, b, h) do { _Pragma("unroll") for (int n = 0; n < 2; ++n) _Pragma("unroll") for (int k = 0; k < 2; ++k) dst[n].ld(k, lds + PG8_SB(b, h) + boff + n * 2048 + k * 1024); } while (0)
#define PG8_MMA(ai, bj, At, Bt) do { __builtin_amdgcn_s_setprio(1); _Pragma("unroll") for (int m = 0; m < 4; ++m) _Pragma("unroll") for (int n = 0; n < 2; ++n) { \
        if constexpr (F8) asm volatile("v_mfma_f32_16x16x128_f8f6f4 %0, %1, %2, %0" : "+v"(acc[ai][bj][m][n]) : "v"(Bt[n].v), "v"(At[m].v));         \
        else { _Pragma("unroll") for (int k = 0; k < 2; ++k) acc[ai][bj][m][n] = __builtin_amdgcn_mfma_f32_16x16x32_bf16(Bt[n].k[k], At[m].k[k], acc[ai][bj][m][n], 0, 0, 0); } } __builtin_amdgcn_s_setprio(0); } while (0)
#define PG8_WAIT_V(n) asm volatile("s_waitcnt vmcnt(" #n ")" ::: "memory")
#define PG8_WAIT_L(n) asm volatile("s_waitcnt lgkmcnt(" #n ")" ::: "memory")
#define PG8_BAR __builtin_amdgcn_s_barrier()
#define PG8_SCHED __builtin_amdgcn_sched_barrier(0)
    Unit cur, nxt; int ui = 0;
    if (!S.next(0, cur)) return;
    f32x4 acc[2][2][4][2];
#pragma unroll
    for (int a = 0; a < 2; ++a)
#pragma unroll
        for (int b = 0; b < 2; ++b)
#pragma unroll
            for (int m = 0; m < 4; ++m)
#pragma unroll
                for (int n = 0; n < 2; ++n) acc[a][b][m][n] = (f32x4){0.f, 0.f, 0.f, 0.f};
    Frag<F8> At[4], B0[2], B1[2];
    const char* cA = (const char*)g.A + (size_t)cur.pm * tstep; const char* cB = (const char*)g.Bt + (size_t)cur.pn * tstep;
    S.a_ready(cur);
    { typename Epi::Pre pre0; E.issue(cur, tid, pre0); E.finish(pre0, cur, 0, tid, lds); }
    if constexpr (SP2) {
        PG8_STAGE(PG8_SB(0, 0), cB + rot, voffB); PG8_STAGE(PG8_SB(0, 1), cB + rot + hstep, voffB); PG8_STAGE(PG8_SA(0, 0), cA + rot, voffA); PG8_STAGE(PG8_SA(0, 1), cA + rot + hstep, voffA);
        if (wr == 1) PG8_BAR;
        PG8_WAIT_V(2); PG8_BAR;
        PG8_STAGE(PG8_SB(1, 0), cB + rot + kstep, voffB); PG8_STAGE(PG8_SA(1, 0), cA + rot + kstep, voffA); PG8_STAGE(PG8_SB(1, 1), cB + rot + hstep + kstep, voffB);
        PG8_WAIT_V(6); PG8_BAR;
    } else {
        PG8_STAGE(PG8_SB(0, 0), cB, voffB); PG8_STAGE(PG8_SA(0, 0), cA, voffA); PG8_STAGE(PG8_SB(0, 1), cB + hstep, voffB); PG8_STAGE(PG8_SA(0, 1), cA + hstep, voffA);
        if (wr == 1) PG8_BAR;
        PG8_WAIT_V(4); PG8_BAR;
        PG8_STAGE(PG8_SB(1, 0), cB + kstep, voffB); PG8_STAGE(PG8_SA(1, 0), cA + kstep, voffA); PG8_STAGE(PG8_SB(1, 1), cB + hstep + kstep, voffB);
        PG8_WAIT_V(6); PG8_BAR;
    }
    for (;;) {
        const bool has_next = S.next(ui + 1, nxt);
        const char* nA = has_next ? (const char*)g.A + (size_t)nxt.pm * tstep : cA; const char* nB = has_next ? (const char*)g.Bt + (size_t)nxt.pn * tstep : cB;
        for (int t = 0; t < nt; t += 2) {
            const bool last = (t == nt - 2);
            const char* a1 = cA + PG8_KO(t + 1);
            const char* a2 = last ? nA + rot : cA + PG8_KO(t + 2); const char* b2 = last ? nB + rot : cB + PG8_KO(t + 2);
            const char* a3 = a2 + kstep; const char* b3 = b2 + kstep;
            if (last && has_next) S.a_ready(nxt);
            if constexpr (SP2) {
            PG8_LDB(B0, 0, 0); PG8_LDB(B1, 0, 1); PG8_SCHED; PG8_LDA(At, 0, 0); PG8_STAGE(PG8_SA(1, 1), a1 + hstep, voffA);
            PG8_WAIT_V(8); PG8_WAIT_L(0); PG8_BAR; PG8_MMA(0, 0, At, B0); PG8_MMA(0, 1, At, B1); PG8_BAR; PG8_SCHED;
            PG8_LDA(At, 0, 1); PG8_STAGE(PG8_SB(0, 0), b2, voffB); PG8_STAGE(PG8_SB(0, 1), b2 + hstep, voffB); PG8_STAGE(PG8_SA(0, 0), a2, voffA);
            PG8_WAIT_V(8); PG8_WAIT_L(0); PG8_BAR; PG8_MMA(1, 0, At, B0); PG8_MMA(1, 1, At, B1); PG8_BAR; PG8_SCHED;
            PG8_LDB(B0, 1, 0); PG8_LDB(B1, 1, 1); PG8_SCHED; PG8_LDA(At, 1, 0); PG8_STAGE(PG8_SA(0, 1), a2 + hstep, voffA);
            PG8_WAIT_V(8); PG8_WAIT_L(0); PG8_BAR; PG8_MMA(0, 0, At, B0); PG8_MMA(0, 1, At, B1); PG8_BAR; PG8_SCHED;
            PG8_LDA(At, 1, 1); PG8_STAGE(PG8_SB(1, 0), b3, voffB); PG8_STAGE(PG8_SB(1, 1), b3 + hstep, voffB); PG8_STAGE(PG8_SA(1, 0), a3, voffA);
            PG8_WAIT_V(8); PG8_WAIT_L(0); PG8_BAR; PG8_MMA(1, 0, At, B0); PG8_MMA(1, 1, At, B1); PG8_BAR; PG8_SCHED;
            } else {
            PG8_LDB(B0, 0, 0); PG8_SCHED; PG8_LDA(At, 0, 0); PG8_STAGE(PG8_SA(1, 1), a1 + hstep, voffA);
            PG8_WAIT_L(8); PG8_BAR; PG8_WAIT_L(0); PG8_MMA(0, 0, At, B0); PG8_BAR; PG8_SCHED;
            PG8_LDB(B1, 0, 1); PG8_STAGE(PG8_SB(0, 0), b2, voffB);
            PG8_BAR; PG8_WAIT_L(0); PG8_MMA(0, 1, At, B1); PG8_BAR;
            PG8_LDA(At, 0, 1); PG8_STAGE(PG8_SA(0, 0), a2, voffA);
            PG8_BAR; PG8_WAIT_L(0); PG8_MMA(1, 0, At, B0); PG8_BAR; PG8_SCHED;
            PG8_STAGE(PG8_SB(0, 1), b2 + hstep, voffB);
            PG8_WAIT_V(6); PG8_BAR; PG8_MMA(1, 1, At, B1); PG8_BAR;
            PG8_LDB(B0, 1, 0); PG8_SCHED; PG8_LDA(At, 1, 0); PG8_STAGE(PG8_SA(0, 1), a2 + hstep, voffA);
            PG8_WAIT_L(8); PG8_BAR; PG8_WAIT_L(0); PG8_MMA(0, 0, At, B0); PG8_BAR; PG8_SCHED;
            PG8_LDB(B1, 1, 1); PG8_STAGE(PG8_SB(1, 0), b3, voffB);
            PG8_BAR; PG8_WAIT_L(0); PG8_MMA(0, 1, At, B1); PG8_BAR;
            PG8_LDA(At, 1, 1); PG8_STAGE(PG8_SA(1, 0), a3, voffA);
            PG8_BAR; PG8_WAIT_L(0); PG8_MMA(1, 0, At, B0); PG8_BAR; PG8_SCHED;
            PG8_STAGE(PG8_SB(1, 1), b3 + hstep, voffB);
            PG8_WAIT_V(6); PG8_BAR; PG8_MMA(1, 1, At, B1); PG8_BAR;
            }
            if constexpr (KROT) { if (t == nt / 2 - 2) E.mid(acc, wr, fr, lds, ui & 1); }
        }
        if constexpr (ALIGN_EPI) { if (wr == 0) PG8_BAR; }
        if constexpr (F8) asm volatile("s_nop 15\n\ts_nop 15" ::: "memory");
        typename Epi::Pre pre;
        if (has_next) { E.issue(nxt, tid, pre); if constexpr (!Epi::SPLIT_PRE) E.finish(pre, nxt, (ui + 1) & 1, tid, lds); }
        if constexpr (!Epi::AFTER_DRAIN) { int le = lane; asm volatile("" : "+v"(le));
            E(acc, cur, wr, wc, le & 15, le >> 4, lds, ui & 1); S.done(cur); }
        if constexpr (Epi::SPLIT_PRE) { if (has_next) E.finish(pre, nxt, (ui + 1) & 1, tid, lds); }
        if (!has_next) break;
#pragma unroll
        for (int a = 0; a < 2; ++a)
#pragma unroll
            for (int b = 0; b < 2; ++b)
#pragma unroll
                for (int m = 0; m < 4; ++m)
#pragma unroll
                    for (int n = 0; n < 2; ++n) acc[a][b][m][n] = (f32x4){0.f, 0.f, 0.f, 0.f};
        cur = nxt; cA = nA; cB = nB; ++ui;
        if constexpr (ALIGN_EPI) { if (wr == 1) PG8_BAR; }
    }
    PG8_WAIT_V(0);
    if constexpr (!ALIGN_EPI) { if (wr == 0) PG8_BAR; }
    PG8_BAR;
    if constexpr (Epi::AFTER_DRAIN) { E.fused(acc, cur, wr, wc, fr, fq, lds, wid, lane); S.done(cur); }
#undef PG8_KO
#undef PG8_SA
#undef PG8_SB
#undef PG8_STAGE
#undef PG8_LDA
#undef PG8_LDB
#undef PG8_MMA
#undef PG8_WAIT_V
#undef PG8_WAIT_L
#undef PG8_BAR
#undef PG8_SCHED
}
}

#ifndef PG8_SP2
#define PG8_SP2 true
#endif
#ifndef PG8_ALIGN
#define PG8_ALIGN true
#endif
constexpr int NWAVES = 8;
#ifndef MK_PER_PHASE
#define MK_PER_PHASE 0
#endif
constexpr int D_MODEL = 2048, BATCH = 8, SEQ = 2048, DEPTH = 2, M = BATCH * SEQ;
constexpr int NCMP = 127, NSEL = 32, TOPK = 16, WINDOW = 512;
constexpr int D_FF = 5632, N_IN = 6696, ZW = 6912;
constexpr float NORM_EPS = 1e-6f;
constexpr int ZC_MQ = 0, ZC_MK = 1024, ZC_MV = 2048, ZC_MO = 3072, ZC_NQ = 4096, ZC_KC = 5120, ZC_VC = 5376, ZC_KS = 5632, ZC_VS = 5888, ZC_KW = 6144, ZC_VW = 6400, ZC_MI = 6656, ZC_MF = 6664, ZC_NG = 6672;
__host__ __device__ __forceinline__ int colmap_in(int nd) {
    if (nd < 4096) return nd; if (nd < 6656) return nd + 16; if (nd < 6672) return nd - 2560; if (nd < N_IN) return nd; return -1; }
constexpr int PH_PER_LAYER = 11, N_PHASES = DEPTH * PH_PER_LAYER + 1;

constexpr size_t MiB = 1u << 20;
constexpr size_t WS_CTL = 0, CTL_ZERO_BYTES = 1 * MiB;
constexpr size_t WS_ROPE = 1 * MiB;
constexpr size_t WS_SSQ = WS_ROPE + 512 * 1024;
constexpr size_t WS_PBP = WS_ROPE + 640 * 1024, WS_PB = WS_ROPE + 768 * 1024;
constexpr size_t WS_WIN = 2 * MiB, WS_WOUT = 29 * MiB, WS_WUP = 37 * MiB, WS_WDN = 81 * MiB;
constexpr size_t WS_C1K = 103 * MiB, WS_C1V = 105 * MiB, WS_C2K = 107 * MiB, WS_C2V = 107 * MiB + 512 * 1024;
constexpr size_t WS_XN = 108 * MiB;
constexpr size_t WS_Z = 172 * MiB;
constexpr size_t WS_MIX = 388 * MiB;
constexpr size_t WS_KCMP = 452 * MiB, WS_VCMP = 453 * MiB;
constexpr size_t WS_OACC = 456 * MiB;
constexpr size_t WS_VTS = 520 * MiB, WS_VTW = 528 * MiB;
constexpr size_t WS_G = 172 * MiB;
constexpr size_t WS_EDGE = 348 * MiB;
constexpr size_t WS_L1 = 540 * MiB;
constexpr size_t WS_PBP1 = WS_L1 + 107 * MiB;
constexpr size_t WS_SSQP = 536 * MiB;
constexpr size_t WS_XR = 576 * MiB;
constexpr size_t WS_END = 700 * MiB;
constexpr int CW_BAR = 4096;
constexpr int CW_PB = 16384;

constexpr int RING_OFF = 0, RING_BYTES = 135168;
constexpr int LDSCTL_OFF = RING_BYTES, MISC_OFF = LDSCTL_OFF + 320;
constexpr int LDS_BYTES = 147456;

#define GAS __attribute__((address_space(1)))
#define LAS __attribute__((address_space(3)))
typedef unsigned short bf16;
typedef unsigned v4u __attribute__((ext_vector_type(4)));
typedef float f32x4 __attribute__((ext_vector_type(4)));
typedef short bf16x8 __attribute__((ext_vector_type(8)));
typedef GAS unsigned gu32;
#define RLX_AGENT __ATOMIC_RELAXED, __HIP_MEMORY_SCOPE_AGENT
#define LDS_WAIT() asm volatile("s_waitcnt lgkmcnt(0)" ::: "memory")
#define VM_WAIT() asm volatile("s_waitcnt vmcnt(0)" ::: "memory")
__device__ __forceinline__ unsigned f2bf(float f) { unsigned u = __builtin_bit_cast(unsigned, f); return (u + 0x7fffu + ((u >> 16) & 1u)) >> 16; }
__device__ __forceinline__ unsigned pk2(float lo, float hi) { return f2bf(lo) | (f2bf(hi) << 16); }
typedef float f32x2t_ __attribute__((ext_vector_type(2)));
typedef __bf16 bf16x2t_ __attribute__((ext_vector_type(2)));
__device__ __forceinline__ unsigned cvtpk(float lo, float hi) { const f32x2t_ v = {lo, hi}; return __builtin_bit_cast(unsigned, __builtin_convertvector(v, bf16x2t_)); }
__device__ __forceinline__ float bf2f(bf16 v) { return __builtin_bit_cast(float, (unsigned)v << 16); }
__device__ __forceinline__ float sigmoidf_(float x) { return __builtin_amdgcn_rcpf(1.f + __builtin_amdgcn_exp2f(-1.4426950408889634f * x)); }
__device__ __forceinline__ float siluf_(float x) { return x * __builtin_amdgcn_rcpf(1.f + __builtin_amdgcn_exp2f(-1.4426950408889634f * x)); }
__device__ __forceinline__ float gelu_tanh(float x) { const float u = 0.7978845608028654f * (x + 0.044715f * x * x * x); return 0.5f * x * (1.f + tanhf(u)); }
__device__ __forceinline__ float logsigmoidf_(float x) { return fminf(x, 0.f) - log1pf(__expf(-fabsf(x))); }
#define DPP_F(v, ctrl) __builtin_bit_cast(float, __builtin_amdgcn_update_dpp(0, __builtin_bit_cast(int, (v)), (ctrl), 0xf, 0xf, true))
#define DPP_F_ID(idv, v, ctrl, rmask) __builtin_bit_cast(float, __builtin_amdgcn_update_dpp(__builtin_bit_cast(int, (idv)), __builtin_bit_cast(int, (v)), (ctrl), (rmask), 0xf, false))
__device__ __forceinline__ float xor16_f(float v) { return __builtin_bit_cast(float, __builtin_amdgcn_ds_swizzle(__builtin_bit_cast(int, v), 0x401F)); }
__device__ __forceinline__ float swap32_other(float v) { auto rr = __builtin_amdgcn_permlane32_swap(__float_as_uint(v), __float_as_uint(v), false, false);
    return (__builtin_amdgcn_mbcnt_hi(~0u, __builtin_amdgcn_mbcnt_lo(~0u, 0u)) & 32u) ? __uint_as_float(rr[0]) : __uint_as_float(rr[1]); }
__device__ __forceinline__ float wave_sum(float v) {
    v += DPP_F(v, 0xB1); v += DPP_F(v, 0x4E); v += DPP_F(v, 0x124); v += DPP_F(v, 0x128);
    v += xor16_f(v);
    auto rr = __builtin_amdgcn_permlane32_swap(__float_as_uint(v), __float_as_uint(v), false, false); return __uint_as_float(rr[0]) + __uint_as_float(rr[1]);
}
__device__ __forceinline__ float wave_max(float v) {
    v = fmaxf(v, DPP_F(v, 0xB1)); v = fmaxf(v, DPP_F(v, 0x4E)); v = fmaxf(v, DPP_F(v, 0x124)); v = fmaxf(v, DPP_F(v, 0x128));
    v = fmaxf(v, xor16_f(v));
    auto rr = __builtin_amdgcn_permlane32_swap(__float_as_uint(v), __float_as_uint(v), false, false); return fmaxf(__uint_as_float(rr[0]), __uint_as_float(rr[1]));
}
__device__ __forceinline__ float q4_sum(float v) {
    v += xor16_f(v);
    auto rr = __builtin_amdgcn_permlane32_swap(__float_as_uint(v), __float_as_uint(v), false, false); return __uint_as_float(rr[0]) + __uint_as_float(rr[1]);
}
__device__ __forceinline__ float scan_sum(float v) {
    v += DPP_F_ID(0.f, v, 0x111, 0xf); v += DPP_F_ID(0.f, v, 0x112, 0xf); v += DPP_F_ID(0.f, v, 0x114, 0xf); v += DPP_F_ID(0.f, v, 0x118, 0xf);
    v += DPP_F_ID(0.f, v, 0x142, 0xa); v += DPP_F_ID(0.f, v, 0x143, 0xc); return v;
}
__device__ __forceinline__ float scan_max(float v) {
    const float ninf = -3.0e38f;
    v = fmaxf(v, DPP_F_ID(ninf, v, 0x111, 0xf)); v = fmaxf(v, DPP_F_ID(ninf, v, 0x112, 0xf)); v = fmaxf(v, DPP_F_ID(ninf, v, 0x114, 0xf)); v = fmaxf(v, DPP_F_ID(ninf, v, 0x118, 0xf));
    v = fmaxf(v, DPP_F_ID(ninf, v, 0x142, 0xa)); v = fmaxf(v, DPP_F_ID(ninf, v, 0x143, 0xc)); return v;
}
__device__ __forceinline__ float lane63(float v) { return __builtin_bit_cast(float, __builtin_amdgcn_readlane(__builtin_bit_cast(int, v), 63)); }

#define XB_TMO      128
#define XB_XCNT(j)  (256  + 64 * (j))
#define XB_XSUB(j)  (1280 + 64 * (j))
#define XB_XGEN(j)  (2304 + 64 * (j))
#define XB_TOP      3328
#define XB_TOPGEN   3392
#define XCD_BAR_WORDS 3456
#define XB_SPIN_CAP (1u << 22)

__device__ __forceinline__ unsigned xb_ld(unsigned* p)              { return __hip_atomic_load(p, __ATOMIC_RELAXED, __HIP_MEMORY_SCOPE_AGENT); }
__device__ __forceinline__ unsigned xb_add(unsigned* p, unsigned v) { return __hip_atomic_fetch_add(p, v, __ATOMIC_RELAXED, __HIP_MEMORY_SCOPE_AGENT); }
__device__ __forceinline__ unsigned xb_xcc_id() { return (unsigned)__builtin_amdgcn_s_getreg((3 << 11) | 20) & 0xFu; }
#define XB_SPIN(cond, bar) do { unsigned _sp = 0; while (cond) { __builtin_amdgcn_s_sleep(1); \
    if ((++_sp & 255u) == 0u) { if (xb_ld(&(bar)[XB_TMO])) break; if (_sp > XB_SPIN_CAP) { atomicAdd(&(bar)[XB_TMO], 1u); break; } } } } while (0)

struct XcdBarrier {
    unsigned* bar; unsigned x;
    volatile LAS unsigned* st;
};
__device__ __forceinline__ XcdBarrier xcd_barrier_post(unsigned* bar, volatile LAS unsigned* st) {
    XcdBarrier b; b.bar = bar; b.x = xb_xcc_id(); b.st = st;
    if (threadIdx.x == 0) (void)xb_add(&bar[XB_XCNT(b.x)], 1u);
    return b;
}
__device__ __forceinline__ void xcd_barrier_complete(unsigned* bar, unsigned x, unsigned& nloc, unsigned& nx) {
    const unsigned G = gridDim.x * gridDim.y * gridDim.z;
    unsigned sum, cnt, mine, sp = 0u;
    for (;;) {
        sum = 0u; cnt = 0u; mine = 0u;
#pragma unroll
        for (unsigned j = 0; j < 16; ++j) { const unsigned c = xb_ld(&bar[XB_XCNT(j)]); sum += c; cnt += (c > 0u) ? 1u : 0u; mine = (j == x) ? c : mine; }
        if (sum == G) break;
        __builtin_amdgcn_s_sleep(1);
        if ((++sp & 255u) == 0u) { if (xb_ld(&bar[XB_TMO])) break; if (sp > XB_SPIN_CAP) { atomicAdd(&bar[XB_TMO], 1u); break; } }
    }
    nloc = mine > 0u ? mine : 1u; nx = cnt > 0u ? cnt : 1u;
}
__device__ __attribute__((noinline)) void xcd_barrier_fn(unsigned* bar, unsigned lds_st, int tid0) {
    volatile LAS unsigned* st = (volatile LAS unsigned*)lds_st;
    asm volatile("s_waitcnt vmcnt(0)" ::: "memory");
    __syncthreads();
    if (tid0) {
        const unsigned bx = xb_xcc_id();
        __builtin_amdgcn_s_waitcnt(0);
        unsigned nloc = st[0], nx = st[1];
        if (nloc == 0u) { xcd_barrier_complete(bar, bx, nloc, nx); st[0] = nloc; st[1] = nx; }
        const unsigned old = xb_add(&bar[XB_XSUB(bx)], 1u);
        const unsigned gen = old / nloc;
        if (old + 1u == (gen + 1u) * nloc) {
            __builtin_amdgcn_fence(__ATOMIC_RELEASE, "agent");
            asm volatile("s_waitcnt vmcnt(0)" ::: "memory");
            const unsigned og = xb_add(&bar[XB_TOP], 1u);
            const unsigned tg = og / nx;
            if (og + 1u == (tg + 1u) * nx) xb_add(&bar[XB_TOPGEN], 1u);
            else XB_SPIN(xb_ld(&bar[XB_TOPGEN]) == tg, bar);
            __builtin_amdgcn_fence(__ATOMIC_ACQUIRE, "agent");
            xb_add(&bar[XB_XGEN(bx)], 1u);
            asm volatile("s_waitcnt vmcnt(0)" ::: "memory");
        } else {
            XB_SPIN(xb_ld(&bar[XB_XGEN(bx)]) == gen, bar);
            __builtin_amdgcn_fence(__ATOMIC_ACQUIRE, "agent");
            asm volatile("s_waitcnt vmcnt(0)" ::: "memory");
        }
    }
    __syncthreads();
}

struct Frame {
    LAS unsigned char* lds;
    volatile LAS unsigned* MISC;
    gu32* ctl;
    int tid, lane, wave;
    int bid, G;
    unsigned char* ws; float* out;
};
constexpr int PT_OFF = MISC_OFF + 256;
__device__ __forceinline__ const float* inptr(const Frame& F, int k) {
    const LAS unsigned* p = (const LAS unsigned*)(F.lds + PT_OFF) + 2 * k;
    const unsigned lo = p[0], hi = p[1];
    return (const float*)(((unsigned long long)hi << 32) | lo);
}

template <bool ACC>
__device__ __forceinline__ void lds_gemm(LAS float* C, int ldc, const LAS bf16* A, int lda, const LAS bf16* Bt, int ldb, int Mt, int Nt, int K, int wave, int lane) {
    const int tn = Nt >> 4, nt = (Mt >> 4) * tn;
    for (int t = wave; t < nt; t += NWAVES) {
        const int i = t / tn, j = t - i * tn;
        f32x4 acc = {0.f, 0.f, 0.f, 0.f};
        const LAS bf16* ap = A + (i * 16 + (lane & 15)) * lda + 8 * (lane >> 4);
        const LAS bf16* bp = Bt + (j * 16 + (lane & 15)) * ldb + 8 * (lane >> 4);
        for (int k0 = 0; k0 < K; k0 += 32) {
            const bf16x8 a = *(const LAS bf16x8*)(ap + k0), b = *(const LAS bf16x8*)(bp + k0);
            acc = __builtin_amdgcn_mfma_f32_16x16x32_bf16(a, b, acc, 0, 0, 0);
        }
        LAS float* cp = C + (i * 16 + 4 * (lane >> 4)) * ldc + j * 16 + (lane & 15);
#pragma unroll
        for (int r = 0; r < 4; ++r) cp[r * ldc] = (ACC ? cp[r * ldc] : 0.f) + acc[r];
    }
}

template <int MODE>
__device__ __forceinline__ void tr_load(const float* W, int Nsrc, int Ndst, int item, int lane, f32x4 (&v)[16]) {
    const int nblk = Ndst / 64, kb = item / nblk, nb = item - kb * nblk, k0 = 64 * kb + 16 * (lane >> 4), n0 = 64 * nb + 4 * (lane & 15);
    const int ns = MODE == 1 ? colmap_in(n0) : (MODE == 2 ? ((n0 >> 7) & 1) * D_FF + (n0 >> 8) * 128 + (n0 & 127) : n0);
    if (ns >= 0) { const float* p = W + (size_t)k0 * Nsrc + ns;
#pragma unroll
        for (int i = 0; i < 16; ++i) v[i] = *(const GAS f32x4*)(p + (size_t)i * Nsrc); }
    else {
#pragma unroll
        for (int i = 0; i < 16; ++i) v[i] = (f32x4){0.f, 0.f, 0.f, 0.f}; }
}
template <int MODE>
__device__ __forceinline__ void tr_store(int K, int Ndst, bf16* WT, int item, int lane, f32x4 (&v)[16], const float* kg) {
    const int nblk = Ndst / 64, kb = item / nblk, nb = item - kb * nblk, k0 = 64 * kb + 16 * (lane >> 4), n0 = 64 * nb + 4 * (lane & 15);
    if (kg != nullptr) {
#pragma unroll
        for (int i = 0; i < 4; ++i) { const f32x4 g4 = *(const GAS f32x4*)(kg + k0 + 4 * i);
#pragma unroll
            for (int j = 0; j < 4; ++j) v[4 * i + j] = v[4 * i + j] * g4[j]; } }
    if constexpr (MODE == 3) {
#pragma unroll
        for (int j = 0; j < 4; ++j) { unsigned char* o = (unsigned char*)WT + (size_t)(n0 + j) * K + k0; constexpr float s = pg8::F8_WS;
            *(GAS v4u*)o = (v4u){pg8::pk4_fp8(v[0][j] * s, v[1][j] * s, v[2][j] * s, v[3][j] * s), pg8::pk4_fp8(v[4][j] * s, v[5][j] * s, v[6][j] * s, v[7][j] * s),
                                 pg8::pk4_fp8(v[8][j] * s, v[9][j] * s, v[10][j] * s, v[11][j] * s), pg8::pk4_fp8(v[12][j] * s, v[13][j] * s, v[14][j] * s, v[15][j] * s)}; }
        return; }
#pragma unroll
    for (int j = 0; j < 4; ++j) { bf16* o = MODE == 4 ? WT + (size_t)(k0 >> 7) * (Ndst * 128) + (n0 + j) * 128 + (k0 & 127) : WT + (size_t)(n0 + j) * K + k0;
        *(GAS v4u*)o = (v4u){cvtpk(v[0][j], v[1][j]), cvtpk(v[2][j], v[3][j]), cvtpk(v[4][j], v[5][j]), cvtpk(v[6][j], v[7][j])};
        *(GAS v4u*)(o + 8) = (v4u){cvtpk(v[8][j], v[9][j]), cvtpk(v[10][j], v[11][j]), cvtpk(v[12][j], v[13][j]), cvtpk(v[14][j], v[15][j])}; }
}
template <int MODE>
__device__ __forceinline__ void transpose_item(const float* W, int K, int Nsrc, int Ndst, bf16* WT, int item, int lane, const float* kg = nullptr) {
    asm volatile("" : "+v"(lane));
    f32x4 v[16];
    tr_load<MODE>(W, Nsrc, Ndst, item, lane, v); tr_store<MODE>(K, Ndst, WT, item, lane, v, kg);
}
template <int MODE>
__device__ __forceinline__ void transpose_items4(const float* W, int K, int Nsrc, int Ndst, bf16* WT, int item0, int lane, const float* kg = nullptr) {
    asm volatile("" : "+v"(lane));
    f32x4 va[16], vb[16];
    tr_load<MODE>(W, Nsrc, Ndst, item0, lane, va);
    tr_load<MODE>(W, Nsrc, Ndst, item0 + 1, lane, vb); tr_store<MODE>(K, Ndst, WT, item0, lane, va, kg);
    tr_load<MODE>(W, Nsrc, Ndst, item0 + 2, lane, va); tr_store<MODE>(K, Ndst, WT, item0 + 1, lane, vb, kg);
    tr_load<MODE>(W, Nsrc, Ndst, item0 + 3, lane, vb); tr_store<MODE>(K, Ndst, WT, item0 + 2, lane, va, kg);
    tr_store<MODE>(K, Ndst, WT, item0 + 3, lane, vb, kg);
}
__device__ __forceinline__ void rms_row_to_bf16(const float* xrow, const float* gain, bf16* orow, int lane) {
    const GAS f32x4* xr = (const GAS f32x4*)xrow + lane; const GAS f32x4* gr = (const GAS f32x4*)gain + lane;
    f32x4 v[8]; float s = 0.f;
#pragma unroll
    for (int j = 0; j < 8; ++j) { v[j] = xr[64 * j]; s += (v[j].x * v[j].x + v[j].y * v[j].y) + (v[j].z * v[j].z + v[j].w * v[j].w); }
    const float rstd = 1.f / sqrtf(wave_sum(s) * (1.f / D_MODEL) + NORM_EPS);
    GAS unsigned long long* o8 = (GAS unsigned long long*)orow + lane;
#pragma unroll
    for (int j = 0; j < 8; ++j) { const f32x4 g = gr[64 * j];
        o8[64 * j] = (unsigned long long)pk2(v[j].x * rstd * g.x, v[j].y * rstd * g.y) | ((unsigned long long)pk2(v[j].z * rstd * g.z, v[j].w * rstd * g.w) << 32); }
}
__device__ __forceinline__ void rms_brow_to_bf16(const bf16* xrow, const float* gain, bf16* orow, int lane) {
    const GAS v4u* xr = (const GAS v4u*)xrow + lane; v4u v[4]; float s = 0.f;
#pragma unroll
    for (int j = 0; j < 4; ++j) { v[j] = xr[64 * j]; const unsigned w[4] = {v[j].x, v[j].y, v[j].z, v[j].w};
#pragma unroll
        for (int i = 0; i < 4; ++i) { const float a = __builtin_bit_cast(float, w[i] << 16), b = __builtin_bit_cast(float, w[i] & 0xffff0000u); s += a * a + b * b; } }
    const float rstd = 1.f / sqrtf(wave_sum(s) * (1.f / D_MODEL) + NORM_EPS);
    GAS v4u* o = (GAS v4u*)orow + lane;
#pragma unroll
    for (int j = 0; j < 4; ++j) { const unsigned w[4] = {v[j].x, v[j].y, v[j].z, v[j].w}; const float* g = gain + 8 * (lane + 64 * j);
        const f32x4 g0 = *(const GAS f32x4*)g, g1 = *(const GAS f32x4*)(g + 4); const float gg[8] = {g0[0], g0[1], g0[2], g0[3], g1[0], g1[1], g1[2], g1[3]};
        unsigned ow[4];
#pragma unroll
        for (int i = 0; i < 4; ++i) ow[i] = cvtpk(__builtin_bit_cast(float, w[i] << 16) * rstd * gg[2 * i], __builtin_bit_cast(float, w[i] & 0xffff0000u) * rstd * gg[2 * i + 1]);
        o[64 * j] = (v4u){ow[0], ow[1], ow[2], ow[3]}; }
}
__device__ __forceinline__ void rms_brow_to_f32(const bf16* xrow, const float* gain, float* orow, int lane) {
    const GAS v4u* xr = (const GAS v4u*)xrow + lane; v4u v[4]; float s = 0.f;
#pragma unroll
    for (int j = 0; j < 4; ++j) { v[j] = xr[64 * j]; const unsigned w[4] = {v[j].x, v[j].y, v[j].z, v[j].w};
#pragma unroll
        for (int i = 0; i < 4; ++i) { const float a = __builtin_bit_cast(float, w[i] << 16), b = __builtin_bit_cast(float, w[i] & 0xffff0000u); s += a * a + b * b; } }
    const float rstd = 1.f / sqrtf(wave_sum(s) * (1.f / D_MODEL) + NORM_EPS);
#pragma unroll
    for (int j = 0; j < 4; ++j) { const unsigned w[4] = {v[j].x, v[j].y, v[j].z, v[j].w}; const float* g = gain + 8 * (lane + 64 * j); float* o = orow + 8 * (lane + 64 * j);
        const f32x4 g0 = *(const GAS f32x4*)g, g1 = *(const GAS f32x4*)(g + 4);
        *(GAS f32x4*)o = (f32x4){__builtin_bit_cast(float, w[0] << 16) * rstd * g0[0], __builtin_bit_cast(float, w[0] & 0xffff0000u) * rstd * g0[1], __builtin_bit_cast(float, w[1] << 16) * rstd * g0[2], __builtin_bit_cast(float, w[1] & 0xffff0000u) * rstd * g0[3]};
        *(GAS f32x4*)(o + 4) = (f32x4){__builtin_bit_cast(float, w[2] << 16) * rstd * g1[0], __builtin_bit_cast(float, w[2] & 0xffff0000u) * rstd * g1[1], __builtin_bit_cast(float, w[3] << 16) * rstd * g1[2], __builtin_bit_cast(float, w[3] & 0xffff0000u) * rstd * g1[3]}; }
}
__device__ __forceinline__ void rms_row_to_f32(const float* xrow, const float* gain, float* orow, int lane) {
    const GAS f32x4* xr = (const GAS f32x4*)xrow + lane; const GAS f32x4* gr = (const GAS f32x4*)gain + lane;
    f32x4 v[8]; float s = 0.f;
#pragma unroll
    for (int j = 0; j < 8; ++j) { v[j] = xr[64 * j]; s += (v[j].x * v[j].x + v[j].y * v[j].y) + (v[j].z * v[j].z + v[j].w * v[j].w); }
    const float rstd = 1.f / sqrtf(wave_sum(s) * (1.f / D_MODEL) + NORM_EPS);
    GAS f32x4* o = (GAS f32x4*)orow + lane;
#pragma unroll
    for (int j = 0; j < 8; ++j) { const f32x4 g = gr[64 * j]; o[64 * j] = v[j] * rstd * g; }
}

struct LayerPtrs {
    const float *attn_norm, *w_in, *qk_conv_w, *qk_conv_b, *i_bias, *f_bias, *mlstm_norm, *pe_k, *pe_v, *w1_k, *w2_k, *w1_v, *w2_v, *nsa_norm, *w_out, *ffn_norm, *w_up, *ffn_conv_w, *ffn_conv_b, *w_down;
};
struct WsPtrs {
    float *ropec, *ropes, *ssq, *oacc, *pbp, *ssqp;
    bf16 *win, *wout, *wup, *wdn, *c1k, *c1v, *c2k, *c2v, *xn, *z, *mix, *kcmp, *vcmpt, *vts, *vtw, *u, *g, *xr;
};

__device__ __forceinline__ LayerPtrs make_L(const Frame& F, int layer) {
    LayerPtrs L;
    L.attn_norm = inptr(F, 1) + (size_t)layer * D_MODEL; L.w_in = inptr(F, 2) + (size_t)layer * D_MODEL * N_IN;
    L.qk_conv_w = inptr(F, 3) + (size_t)layer * 4 * 2048; L.qk_conv_b = inptr(F, 4) + (size_t)layer * 2048;
    L.i_bias = inptr(F, 5) + layer * 8; L.f_bias = inptr(F, 6) + layer * 8; L.mlstm_norm = inptr(F, 7) + layer * 1024;
    L.pe_k = inptr(F, 8) + layer * 32 * 128; L.pe_v = inptr(F, 9) + layer * 32 * 128;
    L.w1_k = inptr(F, 10) + (size_t)layer * 4096 * 256; L.w2_k = inptr(F, 11) + (size_t)layer * 256 * 128;
    L.w1_v = inptr(F, 12) + (size_t)layer * 4096 * 256; L.w2_v = inptr(F, 13) + (size_t)layer * 256 * 128;
    L.nsa_norm = inptr(F, 14) + layer * 1024; L.w_out = inptr(F, 15) + (size_t)layer * D_MODEL * D_MODEL;
    L.ffn_norm = inptr(F, 16) + (size_t)layer * D_MODEL; L.w_up = inptr(F, 17) + (size_t)layer * D_MODEL * 2 * D_FF;
    L.ffn_conv_w = inptr(F, 18) + (size_t)layer * 3 * 2 * D_FF; L.ffn_conv_b = inptr(F, 19) + (size_t)layer * 2 * D_FF;
    L.w_down = inptr(F, 20) + (size_t)layer * D_FF * D_MODEL;
    return L;
}
__device__ __forceinline__ WsPtrs make_W(const Frame& F, int layer = 0) {
    const unsigned long long wsu = (unsigned long long)F.ws;
    unsigned wlo = __builtin_amdgcn_readfirstlane((unsigned)wsu), whi = __builtin_amdgcn_readfirstlane((unsigned)(wsu >> 32));
    asm volatile("" : "+s"(wlo), "+s"(whi));
    unsigned char* ws = (unsigned char*)(((unsigned long long)whi << 32) | wlo);
    WsPtrs W;
    W.ropec = (float*)(ws + WS_ROPE); W.ropes = W.ropec + SEQ * 16; W.ssq = (float*)(ws + 454 * MiB);     W.oacc = (float*)(ws + WS_OACC); W.ssqp = (float*)(ws + WS_SSQP);
    const size_t lo_ = layer ? (WS_L1 - WS_WIN) : 0; W.pbp = (float*)(ws + (layer ? WS_PBP1 : WS_PBP));
    W.win = (bf16*)(ws + WS_WIN + lo_); W.wout = (bf16*)(ws + WS_WOUT + lo_); W.wup = (bf16*)(ws + WS_WUP); W.wdn = (bf16*)(ws + WS_WDN);
    W.c1k = (bf16*)(ws + WS_C1K + lo_); W.c1v = (bf16*)(ws + WS_C1V + lo_); W.c2k = (bf16*)(ws + WS_C2K + lo_); W.c2v = (bf16*)(ws + WS_C2V + lo_);
    W.xn = (bf16*)(ws + WS_XN); W.z = (bf16*)(ws + WS_Z); W.mix = (bf16*)(ws + WS_MIX); W.kcmp = (bf16*)(ws + WS_KCMP); W.vcmpt = (bf16*)(ws + WS_VCMP); W.vts = (bf16*)(ws + WS_VTS); W.vtw = (bf16*)(ws + WS_VTW);
    W.u = (bf16*)(ws + WS_EDGE); W.xr = (bf16*)(ws + WS_XR); W.g = (bf16*)(ws + WS_G);
    return W;
}
constexpr int I_IN = (D_MODEL / 64) * (ZW / 64), I_OUT = (D_MODEL / 64) * (D_MODEL / 64), I_C1 = (4096 / 64) * (256 / 64), I_C2 = (256 / 64) * (128 / 64);
constexpr int NSMALL = I_IN + I_OUT + 2 * I_C1 + 2 * I_C2 + 512;
static_assert(NSMALL % 8 == 0, "small conversion items");
__device__ __forceinline__ void small_item(Frame& F, const LayerPtrs& L, const WsPtrs& W, int r, bool fold) {
    if (r < I_IN) { transpose_item<1>(L.w_in, D_MODEL, N_IN, ZW, W.win, r, F.lane, fold ? L.attn_norm : nullptr); return; } r -= I_IN;
    if (r < I_OUT) { transpose_item<0>(L.w_out, D_MODEL, D_MODEL, D_MODEL, W.wout, r, F.lane, r / (D_MODEL / 64) >= 16 ? L.nsa_norm - 1024 : nullptr); return; } r -= I_OUT;
    if (r < I_C1) { transpose_item<4>(L.w1_k, 4096, 256, 256, W.c1k, r, F.lane); return; } r -= I_C1;
    if (r < I_C1) { transpose_item<4>(L.w1_v, 4096, 256, 256, W.c1v, r, F.lane); return; } r -= I_C1;
    if (r < I_C2) { transpose_item<0>(L.w2_k, 256, 128, 128, W.c2k, r, F.lane); return; } r -= I_C2;
    if (r < I_C2) { transpose_item<0>(L.w2_v, 256, 128, 128, W.c2v, r, F.lane); return; } r -= I_C2;
    {
        const int br = r >> 8, cg = (r >> 6) & 3, kp = r & 63, col = 64 * cg + F.lane;
        const float* w1 = (br ? L.w1_v : L.w1_k) + (size_t)(64 * kp) * 256 + col; const float* pe = (br ? L.pe_v : L.pe_k) + 64 * kp;
        float a = 0.f;
#pragma unroll 16
        for (int i = 0; i < 64; ++i) a += pe[i] * w1[(size_t)i * 256];
        W.pbp[(br * 64 + kp) * 256 + col] = a;
    }
}
__device__ __forceinline__ void ph_prologue(Frame& F, const LayerPtrs& L, const WsPtrs& W, const float* xin, int layer) {
    const int gw = F.bid * NWAVES + F.wave, NGW = F.G * NWAVES;
    if (layer == 0) for (int it = gw; it < NSMALL; it += NGW) small_item(F, L, W, it, false);
    if (layer == 0) for (int i = F.bid * 512 + F.tid; i < SEQ * 16; i += F.G * 512) {
        const int pos = i >> 4, k = i & 15;
        const float inv = powf(500000.0f, -(float)(2 * k) / 32.0f);
        const float ang = (float)pos * inv;
        const double rev = (double)ang * 0.15915494309189535;
        const float fr = (float)(rev - floor(rev));
        W.ropec[i] = __builtin_amdgcn_cosf(fr); W.ropes[i] = __builtin_amdgcn_sinf(fr);
    }
    if (layer == 0) { for (int m = gw; m < M; m += NGW) rms_row_to_bf16(xin + (size_t)m * D_MODEL, L.attn_norm, W.xn + (size_t)m * D_MODEL, F.lane); }
    else { for (int m = gw; m < M; m += NGW) rms_brow_to_bf16(W.xr + (size_t)m * D_MODEL, L.attn_norm, W.xn + (size_t)m * D_MODEL, F.lane); }
}

__device__ __forceinline__ void ph_rope(Frame& F, const WsPtrs& W) {
    const size_t total = (size_t)M * 224;
    for (size_t i = (size_t)F.bid * 512 + F.tid; i < total; i += (size_t)F.G * 512) {
        const int m = (int)(i / 224), r = (int)(i - (size_t)m * 224), slot = r >> 4, k = r & 15;
        const int col = slot < 8 ? ZC_NQ + slot * 128 : (slot < 10 ? ZC_KC + (slot - 8) * 128 : (slot < 12 ? ZC_KS + (slot - 10) * 128 : ZC_KW + (slot - 12) * 128));
        const int pos = m & (SEQ - 1);
        const float c = W.ropec[pos * 16 + k], s = W.ropes[pos * 16 + k];
        bf16* p = W.z + (size_t)m * ZW + col + k;
        const float x1 = bf2f(p[0]), x2 = bf2f(p[16]);
        p[0] = (bf16)f2bf(x1 * c - x2 * s); p[16] = (bf16)f2bf(x2 * c + x1 * s);
    }
}

constexpr int M2_QB = 0, M2_KB = 17408, M2_KT = 34816, M2_VT = 53248, M2_PL = 71680, M2_SC = 80896;
__device__ __forceinline__ void mlstm2_unit(Frame& F, const LayerPtrs& L, const WsPtrs& W, int b, int hd) {
    LAS bf16* QB = (LAS bf16*)(F.lds + M2_QB);
    LAS bf16* KB = (LAS bf16*)(F.lds + M2_KB);
    LAS bf16* KT = (LAS bf16*)(F.lds + M2_KT);
    LAS bf16* VT = (LAS bf16*)(F.lds + M2_VT);
    LAS bf16* PL = (LAS bf16*)(F.lds + M2_PL);
    LAS float* SC = (LAS float*)(F.lds + M2_SC);
    LAS float *colf = SC, *rowf = SC + 64, *wi = SC + 128, *emt = SC + 192, *wkv = SC + 256, *nvec = SC + 320, *ssp = SC + 448, *ms = SC + 960, *dinv = SC + 2304;
    int lane_ = F.lane; asm volatile("" : "+v"(lane_));
    const int lane = lane_, wave = F.wave, tid = wave * 64 + lane, r = lane & 15, q4 = lane >> 4;
    const int d2 = tid & 63, sg = wave, dA = 2 * d2;
    const int coff = hd * 128 + dA;
    LAS float* CWL = SC + 1024;
    for (int e = tid; e < 10 * 128; e += 512) { const int k = e >> 7, d = e & 127, cq = hd * 128 + d;
        CWL[e] = k < 4 ? L.qk_conv_w[k * 2048 + cq] : (k < 8 ? L.qk_conv_w[(k - 4) * 2048 + 1024 + cq] : (k == 8 ? L.qk_conv_b[cq] : L.qk_conv_b[1024 + cq])); }
    const f32x4 gain = *(const GAS f32x4*)(L.mlstm_norm + hd * 128 + 16 * wave + 4 * q4);
    const float ibias = L.i_bias[hd], fbias = L.f_bias[hd];
    f32x4 cacc[8];
#pragma unroll
    for (int i = 0; i < 8; ++i) cacc[i] = (f32x4){0.f, 0.f, 0.f, 0.f};
    float nreg = 0.f;
    if (tid < 128) nvec[tid] = 0.f;
    if (tid == 0) ms[0] = 0.f;
    const bf16* zb = W.z + (size_t)b * SEQ * ZW;
    unsigned qraw[11], kraw[11], vraw[8]; bf16 graw0 = 0, graw1 = 0;
#pragma unroll
    for (int k = 0; k < 11; ++k) { const int t = 8 * sg - 3 + k;
        const bf16* rp = zb + (ptrdiff_t)(t >= 0 ? t : 0) * ZW;
        qraw[k] = t >= 0 ? *(const GAS unsigned*)(rp + ZC_MQ + coff) : 0u; kraw[k] = t >= 0 ? *(const GAS unsigned*)(rp + ZC_MK + coff) : 0u; }
#pragma unroll
    for (int k = 0; k < 8; ++k) { const bf16* rp = zb + (size_t)(8 * sg + k) * ZW; vraw[k] = *(const GAS unsigned*)(rp + ZC_MV + coff); }
    if (wave == 0) { graw0 = zb[(size_t)lane * ZW + ZC_MI + hd]; graw1 = zb[(size_t)lane * ZW + ZC_MF + hd]; }
    __syncthreads();
    for (int c = 0; c < SEQ / 64; ++c) {
        const int t0 = c * 64; const size_t row0 = (size_t)b * SEQ + t0;
        {
            unsigned kt0[4], kt1[4], vt0[4], vt1[4];
            typedef float f32x2_ __attribute__((ext_vector_type(2)));
            f32x2_ cw[10];
#pragma unroll
            for (int k = 0; k < 10; ++k) cw[k] = *(const LAS f32x2_*)(CWL + k * 128 + dA);
            f32x2_ xq[11], xk[11]; unsigned kprev = 0u;
#pragma unroll
            for (int k = 0; k < 11; ++k) { xq[k] = (f32x2_){__builtin_bit_cast(float, qraw[k] << 16), __builtin_bit_cast(float, qraw[k] & 0xffff0000u)}; xk[k] = (f32x2_){__builtin_bit_cast(float, kraw[k] << 16), __builtin_bit_cast(float, kraw[k] & 0xffff0000u)}; }
#pragma unroll
            for (int i = 0; i < 8; ++i) {
                f32x2_ yq = cw[8], yk = cw[9];
#pragma unroll
                for (int j = 0; j < 4; ++j) { yq += cw[j] * xq[i + j]; yk += cw[4 + j] * xk[i + j]; }
                f32x2_ tq = yq * -1.4426950408889634f, tk = yk * -1.4426950408889634f;
                f32x2_ eq = {__builtin_amdgcn_exp2f(tq[0]), __builtin_amdgcn_exp2f(tq[1])}, ek = {__builtin_amdgcn_exp2f(tk[0]), __builtin_amdgcn_exp2f(tk[1])};
                eq += 1.f; ek += 1.f;
                const f32x2_ rq = {__builtin_amdgcn_rcpf(eq[0]), __builtin_amdgcn_rcpf(eq[1])}, rk = {__builtin_amdgcn_rcpf(ek[0]), __builtin_amdgcn_rcpf(ek[1])};
                const f32x2_ sq2 = yq * rq, sk2 = (yk * 0.08838834764831845f) * rk;
                const int s = 8 * sg + i;
                *(LAS unsigned*)(QB + s * 136 + dA) = cvtpk(sq2[0], sq2[1]);
                const unsigned kpk = cvtpk(sk2[0], sk2[1]);
                *(LAS unsigned*)(KB + s * 136 + dA) = kpk;
                if (i & 1) {
                    kt0[i >> 1] = __builtin_amdgcn_perm(kpk, kprev, 0x05040100u); kt1[i >> 1] = __builtin_amdgcn_perm(kpk, kprev, 0x07060302u);
                    vt0[i >> 1] = __builtin_amdgcn_perm(vraw[i], vraw[i - 1], 0x05040100u); vt1[i >> 1] = __builtin_amdgcn_perm(vraw[i], vraw[i - 1], 0x07060302u); }
                kprev = kpk;
                __builtin_amdgcn_sched_barrier(0);
            }
            *(LAS v4u*)(KT + dA * 72 + 8 * sg) = (v4u){kt0[0], kt0[1], kt0[2], kt0[3]}; *(LAS v4u*)(KT + (dA + 1) * 72 + 8 * sg) = (v4u){kt1[0], kt1[1], kt1[2], kt1[3]};
            *(LAS v4u*)(VT + dA * 72 + 8 * sg) = (v4u){vt0[0], vt0[1], vt0[2], vt0[3]}; *(LAS v4u*)(VT + (dA + 1) * 72 + 8 * sg) = (v4u){vt1[0], vt1[1], vt1[2], vt1[3]};
        }
        if (wave == 0) {
            const float ig = bf2f(graw0) + ibias, fp = bf2f(graw1) + fbias;
            const float bsum = scan_sum(logsigmoidf_(fp));
            const float ibv = ig - bsum; const float pm = scan_max(ibv);
            const float mprev = ms[0];
            const float mtv = bsum + fmaxf(mprev, pm);
            const float bL = lane63(bsum), pmL = lane63(pm);
            const float mnew = bL + fmaxf(mprev, pmL);
            colf[lane] = __expf(ibv); rowf[lane] = __expf(bsum - mtv); wi[lane] = __expf(bsum + mprev - mtv); emt[lane] = __expf(-mtv); wkv[lane] = __expf(bL + ibv - mnew);
            if (lane == 0) { ms[1] = __expf(bL + mprev - mnew); ms[2] = mnew; }
        }
        if (c + 1 < SEQ / 64) { const bf16* zn = zb + (size_t)(t0 + 64) * ZW;
#pragma unroll
            for (int k = 0; k < 11; ++k) { const int t = 8 * sg - 3 + k;
                const bf16* rp = zn + (ptrdiff_t)t * ZW;
                qraw[k] = *(const GAS unsigned*)(rp + ZC_MQ + coff); kraw[k] = *(const GAS unsigned*)(rp + ZC_MK + coff); }
#pragma unroll
            for (int k = 0; k < 8; ++k) { const bf16* rp = zn + (size_t)(8 * sg + k) * ZW; vraw[k] = *(const GAS unsigned*)(rp + ZC_MV + coff); }
            if (wave == 0) { graw0 = zn[(size_t)lane * ZW + ZC_MI + hd]; graw1 = zn[(size_t)lane * ZW + ZC_MF + hd]; } }
        __syncthreads();
        unsigned long long mo4[4];
#pragma unroll
        for (int jj = 0; jj < 4; ++jj) mo4[jj] = *(const GAS unsigned long long*)(W.z + (row0 + 16 * jj + r) * ZW + ZC_MO + hd * 128 + 16 * wave + 4 * q4);
        { const int i = wave >> 1;
#pragma unroll
          for (int e = 0; e < 2; ++e) { const int jj = 2 * (wave & 1) + e; const int t = 16 * jj + r;
              f32x4 acc = {0.f, 0.f, 0.f, 0.f};
              if (i <= jj) { bf16x8 sa[4], sb[4];
#pragma unroll
                  for (int kk = 0; kk < 4; ++kk) { sa[kk] = *(const LAS bf16x8*)(KB + (16 * i + r) * 136 + 32 * kk + 8 * q4); sb[kk] = *(const LAS bf16x8*)(QB + t * 136 + 32 * kk + 8 * q4); }
                  __builtin_amdgcn_sched_barrier(0);
#pragma unroll
                  for (int kk = 0; kk < 4; ++kk) acc = __builtin_amdgcn_mfma_f32_16x16x32_bf16(sa[kk], sb[kk], acc, 0, 0, 0);
                  const f32x4 cf = *(const LAS f32x4*)(colf + 16 * i + 4 * q4); const float rf = rowf[t];
#pragma unroll
                  for (int g = 0; g < 4; ++g) acc[g] = (16 * i + 4 * q4 + g <= t) ? acc[g] * cf[g] * rf : 0.f;
              }
              *(LAS unsigned long long*)(PL + t * 72 + 16 * i + 4 * q4) = (unsigned long long)cvtpk(acc[0], acc[1]) | ((unsigned long long)cvtpk(acc[2], acc[3]) << 32); } }
        __syncthreads();
        f32x4 hout[4];
        {
            bf16x8 av[2];
#pragma unroll
            for (int ks = 0; ks < 2; ++ks) av[ks] = *(const LAS bf16x8*)(VT + (16 * wave + r) * 72 + 32 * ks + 8 * q4);
#pragma unroll
            for (int jj = 0; jj < 4; ++jj) { const int t = 16 * jj + r;
                f32x4 hi = {0.f, 0.f, 0.f, 0.f}, ha = {0.f, 0.f, 0.f, 0.f};
                unsigned long long qlo[4], qhi[4]; bf16x8 pw[2];
#pragma unroll
                for (int kk = 0; kk < 4; ++kk) { qlo[kk] = *(const LAS unsigned long long*)(QB + t * 136 + 32 * kk + 4 * q4); qhi[kk] = *(const LAS unsigned long long*)(QB + t * 136 + 32 * kk + 16 + 4 * q4); }
#pragma unroll
                for (int ks = 0; ks < 2; ++ks) pw[ks] = *(const LAS bf16x8*)(PL + t * 72 + 32 * ks + 8 * q4);
                __builtin_amdgcn_sched_barrier(0);
#pragma unroll
                for (int kk = 0; kk < 4; ++kk) {
                    const unsigned long long lo = qlo[kk], hi8 = qhi[kk];
                    v4u w; w.x = (unsigned)lo; w.y = (unsigned)(lo >> 32); w.z = (unsigned)hi8; w.w = (unsigned)(hi8 >> 32);
                    v4u cw4; cw4.x = cvtpk(cacc[2 * kk][0], cacc[2 * kk][1]); cw4.y = cvtpk(cacc[2 * kk][2], cacc[2 * kk][3]); cw4.z = cvtpk(cacc[2 * kk + 1][0], cacc[2 * kk + 1][1]); cw4.w = cvtpk(cacc[2 * kk + 1][2], cacc[2 * kk + 1][3]);
                    hi = __builtin_amdgcn_mfma_f32_16x16x32_bf16(__builtin_bit_cast(bf16x8, cw4), __builtin_bit_cast(bf16x8, w), hi, 0, 0, 0); }
#pragma unroll
                for (int ks = 0; ks < 2; ++ks) ha = __builtin_amdgcn_mfma_f32_16x16x32_bf16(av[ks], pw[ks], ha, 0, 0, 0);
                hout[jj] = hi * wi[t] + ha;
                float ss = (hout[jj][0] * hout[jj][0] + hout[jj][1] * hout[jj][1]) + (hout[jj][2] * hout[jj][2] + hout[jj][3] * hout[jj][3]);
                ss = q4_sum(ss);
                if (q4 == 0) ssp[wave * 64 + t] = ss; }
            { const int t = 8 * wave + (lane >> 3), p = lane & 7;
              float a = 0.f;
#pragma unroll
              for (int e = 0; e < 2; ++e) { const v4u w = *(const LAS v4u*)(QB + t * 136 + 16 * p + 8 * e); const f32x4 n0 = *(const LAS f32x4*)(nvec + 16 * p + 8 * e), n1 = *(const LAS f32x4*)(nvec + 16 * p + 8 * e + 4);
                  a += bf2f((bf16)(w.x & 0xffffu)) * n0[0] + bf2f((bf16)(w.x >> 16)) * n0[1] + bf2f((bf16)(w.y & 0xffffu)) * n0[2] + bf2f((bf16)(w.y >> 16)) * n0[3]
                     + bf2f((bf16)(w.z & 0xffffu)) * n1[0] + bf2f((bf16)(w.z >> 16)) * n1[1] + bf2f((bf16)(w.w & 0xffffu)) * n1[2] + bf2f((bf16)(w.w >> 16)) * n1[3]; }
              const v4u w = *(const LAS v4u*)(PL + t * 72 + 8 * p);
              float d = (bf2f((bf16)(w.x & 0xffffu)) + bf2f((bf16)(w.x >> 16))) + (bf2f((bf16)(w.y & 0xffffu)) + bf2f((bf16)(w.y >> 16))) + (bf2f((bf16)(w.z & 0xffffu)) + bf2f((bf16)(w.z >> 16))) + (bf2f((bf16)(w.w & 0xffffu)) + bf2f((bf16)(w.w >> 16)));
              float den = wi[t] * a + d;
              den += DPP_F(den, 0xB1); den += DPP_F(den, 0x4E); den += DPP_F(den, 0x141);
              if (p == 0) dinv[t] = 1.f / fmaxf(fabsf(den), emt[t]); }
        }
        __syncthreads();
        float sq[4][8], dv[4];
#pragma unroll
        for (int jj = 0; jj < 4; ++jj) {
#pragma unroll
            for (int w8 = 0; w8 < 8; ++w8) sq[jj][w8] = ssp[w8 * 64 + 16 * jj + r];
            dv[jj] = dinv[16 * jj + r]; }
        __builtin_amdgcn_sched_barrier(0);
#pragma unroll
        for (int jj = 0; jj < 4; ++jj) { const int t = 16 * jj + r;
            float tot = 0.f;
#pragma unroll
            for (int w8 = 0; w8 < 8; ++w8) tot += sq[jj][w8];
            const float iv = dv[jj]; const float rstd = iv * __builtin_amdgcn_rsqf(tot * iv * iv * (1.f / 128.f) + NORM_EPS);
            const unsigned long long mo = mo4[jj];
            const float o0 = hout[jj][0] * rstd * gain[0] * bf2f((bf16)(mo & 0xffffu)), o1 = hout[jj][1] * rstd * gain[1] * bf2f((bf16)((mo >> 16) & 0xffffu));
            const float o2 = hout[jj][2] * rstd * gain[2] * bf2f((bf16)((mo >> 32) & 0xffffu)), o3 = hout[jj][3] * rstd * gain[3] * bf2f((bf16)(mo >> 48));
            *(GAS unsigned long long*)(W.mix + (row0 + t) * 2048 + hd * 128 + 16 * wave + 4 * q4) = (unsigned long long)cvtpk(o0, o1) | ((unsigned long long)cvtpk(o2, o3) << 32); }
        {
            const float decay = ms[1];
            bf16x8 bv[2];
#pragma unroll
            for (int ks = 0; ks < 2; ++ks) { const v4u w = *(const LAS v4u*)(VT + (16 * wave + r) * 72 + 32 * ks + 8 * q4);
                const f32x4 k0 = *(const LAS f32x4*)(wkv + 32 * ks + 8 * q4), k1 = *(const LAS f32x4*)(wkv + 32 * ks + 8 * q4 + 4);
                v4u o; o.x = cvtpk(bf2f((bf16)(w.x & 0xffffu)) * k0[0], bf2f((bf16)(w.x >> 16)) * k0[1]); o.y = cvtpk(bf2f((bf16)(w.y & 0xffffu)) * k0[2], bf2f((bf16)(w.y >> 16)) * k0[3]);
                o.z = cvtpk(bf2f((bf16)(w.z & 0xffffu)) * k1[0], bf2f((bf16)(w.z >> 16)) * k1[1]); o.w = cvtpk(bf2f((bf16)(w.w & 0xffffu)) * k1[2], bf2f((bf16)(w.w >> 16)) * k1[3]);
                bv[ks] = __builtin_bit_cast(bf16x8, o); }
#define M2_KTF(i) (*(const LAS bf16x8*)(KT + (16 * ((i) >> 1) + r) * 72 + 32 * ((i) & 1) + 8 * q4))
            bf16x8 fa = M2_KTF(0), fb = M2_KTF(1);
            __builtin_amdgcn_sched_barrier(0);
#pragma unroll
            for (int i = 0; i < 16; ++i) { const int dt = i >> 1;
                bf16x8 fc = fb; if (i + 2 < 16) fc = M2_KTF(i + 2);
                if ((i & 1) == 0) cacc[dt] = cacc[dt] * decay;
                __builtin_amdgcn_sched_barrier(0);
                cacc[dt] = __builtin_amdgcn_mfma_f32_16x16x32_bf16(fa, bv[i & 1], cacc[dt], 0, 0, 0);
                __builtin_amdgcn_sched_barrier(0);
                fa = fb; fb = fc; }
#undef M2_KTF
            if (tid < 128) { float a = nreg * decay;
#pragma unroll
                for (int s8 = 0; s8 < 8; ++s8) { const v4u w = *(const LAS v4u*)(KT + tid * 72 + 8 * s8); const f32x4 k0 = *(const LAS f32x4*)(wkv + 8 * s8), k1 = *(const LAS f32x4*)(wkv + 8 * s8 + 4);
                    a += bf2f((bf16)(w.x & 0xffffu)) * k0[0] + bf2f((bf16)(w.x >> 16)) * k0[1] + bf2f((bf16)(w.y & 0xffffu)) * k0[2] + bf2f((bf16)(w.y >> 16)) * k0[3]
                       + bf2f((bf16)(w.z & 0xffffu)) * k1[0] + bf2f((bf16)(w.z >> 16)) * k1[1] + bf2f((bf16)(w.w & 0xffffu)) * k1[2] + bf2f((bf16)(w.w >> 16)) * k1[3]; }
                nreg = a; nvec[tid] = a; }
            if (tid == 0) ms[0] = ms[2];
        }
        __syncthreads();
    }
}

__device__ __forceinline__ void vt_tiles4(Frame& F, const WsPtrs& W, int tile0) {
    LAS bf16* T = (LAS bf16*)(F.lds + 90112);
    v4u ld[4][2];
#pragma unroll
    for (int q = 0; q < 4; ++q) { const int tile = tile0 + q * F.G;
        if (tile < 1024) { const int which = tile & 1, kvh = (tile >> 1) & 1, tb = (tile >> 2) & 31, b = tile >> 7;
            const int zc = (which ? ZC_VW : ZC_VS) + kvh * 128; const size_t r0 = (size_t)b * SEQ + tb * 64;
#pragma unroll
            for (int h = 0; h < 2; ++h) { const int e = F.tid + 512 * h, r = e >> 4, qd = e & 15; ld[q][h] = *(const GAS v4u*)(W.z + (r0 + r) * ZW + zc + 8 * qd); } } }
#pragma unroll
    for (int q = 0; q < 4; ++q) { const int tile = tile0 + q * F.G;
        if (tile < 1024) { const int which = tile & 1, kvh = (tile >> 1) & 1, tb = (tile >> 2) & 31, b = tile >> 7;
#pragma unroll
            for (int h = 0; h < 2; ++h) { const int e = F.tid + 512 * h, r = e >> 4, qd = e & 15; *(LAS v4u*)(T + r * 136 + 8 * qd) = ld[q][h]; }
            __syncthreads();
            bf16* dst = (which ? W.vtw : W.vts) + (size_t)(b * 2 + kvh) * 128 * SEQ + tb * 64;
            for (int e = F.tid; e < 128 * 8; e += 512) { const int d = e >> 3, u = e & 7, kb = 16 * (u >> 1) + 4 * (u & 1);
                unsigned w[4];
#pragma unroll
                for (int i = 0; i < 4; ++i) { const int k0 = kb + (i >> 1) * 8 + (i & 1) * 2; w[i] = (unsigned)T[k0 * 136 + d] | ((unsigned)T[(k0 + 1) * 136 + d] << 16); }
                v4u o; o.x = w[0]; o.y = w[1]; o.z = w[2]; o.w = w[3];
                *(GAS v4u*)(dst + (size_t)d * SEQ + 8 * u) = o; }
            __syncthreads(); } }
}
template <bool VT>
__device__ __forceinline__ void cmp_unit(Frame& F, const LayerPtrs& L, const WsPtrs& W, int u, int layer) {
    const int branch = u >> 7, rem = u & 127, bk = rem >> 3, b = bk >> 1, kvh = bk & 1, n0 = (rem & 7) * 16;
    LAS bf16* Hb = (LAS bf16*)(F.lds);
    int lane_ = F.lane; asm volatile("" : "+v"(lane_));
    const int lane = lane_, wave = F.wave, r = lane & 15, q4 = lane >> 4;
    const bf16* w1t = branch ? W.c1v : W.c1k; const bf16* w2t = branch ? W.c2v : W.c2k;
    const int zc = (branch ? ZC_VC : ZC_KC) + kvh * 128;
    const bf16* bp0 = w1t + (size_t)(32 * wave + r) * 128 + 8 * q4; const bf16* bp1 = bp0 + (size_t)16 * 128;
    f32x4 acc0 = {0.f, 0.f, 0.f, 0.f}, acc1 = {0.f, 0.f, 0.f, 0.f};
    bf16x8 fb[4][2][4];
    const GAS float* pb = (const GAS float*)(W.pbp + branch * 64 * 256 + 32 * wave + r);
    float pr[4][4], b0 = 0.f, b1 = 0.f;
#define CMP_LDB(s, l) do { _Pragma("unroll") for (int i = 0; i < 4; ++i) { fb[s][0][i] = *(const GAS bf16x8*)(bp0 + 32768 * (l) + 32 * i); fb[s][1][i] = *(const GAS bf16x8*)(bp1 + 32768 * (l) + 32 * i); } \
        pr[s][0] = pb[(2 * (l)) * 256]; pr[s][1] = pb[(2 * (l) + 1) * 256]; pr[s][2] = pb[(2 * (l)) * 256 + 16]; pr[s][3] = pb[(2 * (l) + 1) * 256 + 16]; } while (0)
    CMP_LDB(0, 0); CMP_LDB(1, 1); CMP_LDB(2, 2);
    LAS unsigned char* As = F.lds + 8448;
    { const int tid = wave * 64 + lane; v4u t[9];
#pragma unroll
      for (int j = 0; j < 9; ++j) { const int c = tid + 512 * j, rho = c >> 4; int row = 16 * n0 + rho; row = row < SEQ ? row : SEQ - 1;
          if (c < 272 * 16) t[j] = *(const GAS v4u*)(W.z + ((size_t)b * SEQ + row) * ZW + zc + 8 * (c & 15)); }
      if (VT) vt_tiles4(F, W, F.bid);
#pragma unroll
      for (int j = 0; j < 9; ++j) { const int c = tid + 512 * j, rho = c >> 4;
          if (c < 272 * 16) *(LAS v4u*)(As + ((rho & 15) * 18 + (rho >> 4)) * 272 + 16 * (c & 15)) = t[j]; } }
    __syncthreads();
    const LAS unsigned char* ar = As + r * 272 + q4 * 16;
#pragma unroll 1
    for (int l4 = 0; l4 < 32; l4 += 4) {
#pragma unroll
        for (int s = 0; s < 4; ++s) { const int l = l4 + s, lp = l + 3 < 32 ? l + 3 : 31;
            CMP_LDB((s + 3) & 3, lp);
            b0 += pr[s][0] + pr[s][1]; b1 += pr[s][2] + pr[s][3];
            bf16x8 fa[4];
#pragma unroll
            for (int i = 0; i < 4; ++i) fa[i] = *(const LAS bf16x8*)(ar + ((l & 15) * 18 + (l >> 4)) * 272 + 64 * i);
#pragma unroll
            for (int i = 0; i < 4; ++i) { acc0 = __builtin_amdgcn_mfma_f32_16x16x32_bf16(fa[i], fb[s][0][i], acc0, 0, 0, 0); acc1 = __builtin_amdgcn_mfma_f32_16x16x32_bf16(fa[i], fb[s][1][i], acc1, 0, 0, 0); } }
    }
#undef CMP_LDB
    bf16x8 w2f[8];
#pragma unroll
    for (int kk = 0; kk < 8; ++kk) w2f[kk] = *(const GAS bf16x8*)(w2t + (size_t)(16 * wave + r) * 256 + 32 * kk + 8 * q4);
    {
#pragma unroll
      for (int g = 0; g < 4; ++g) { Hb[(4 * q4 + g) * 264 + 32 * wave + r] = (bf16)(cvtpk(gelu_tanh(acc0[g] + b0), 0.f) & 0xffffu); Hb[(4 * q4 + g) * 264 + 32 * wave + 16 + r] = (bf16)(cvtpk(gelu_tanh(acc1[g] + b1), 0.f) & 0xffffu); } }
    __syncthreads();
    f32x4 o = {0.f, 0.f, 0.f, 0.f};
#pragma unroll
    for (int kk = 0; kk < 8; ++kk) { const bf16x8 a = *(const LAS bf16x8*)(Hb + r * 264 + 32 * kk + 8 * q4);
        o = __builtin_amdgcn_mfma_f32_16x16x32_bf16(a, w2f[kk], o, 0, 0, 0); }
    bf16* dst = (branch ? W.vcmpt : W.kcmp) + (size_t)bk * 128 * 128;
    const int d = 16 * wave + r;
#pragma unroll
    for (int g = 0; g < 4; ++g) { const int n = n0 + 4 * q4 + g; const bf16 ov = n < NCMP ? (bf16)(cvtpk(o[g], 0.f) & 0xffffu) : (bf16)0;
        if (branch) ((GAS bf16*)dst)[d * 128 + ((n & ~12) | ((n & 4) << 1) | ((n & 8) >> 1))] = ov; else ((GAS bf16*)dst)[n * 128 + d] = ov; }
    __syncthreads();
}

typedef float f32x16 __attribute__((ext_vector_type(16)));
struct NsaOff { unsigned base, x; __device__ __forceinline__ unsigned at(int s) const { return base + 32u * ((unsigned)s ^ x); } };
constexpr int N2_IMPW = 65536;
constexpr int N2_IMP = N2_IMPW + 33792;
constexpr int N2_SEL = N2_IMP + 8448;
#define N2_KOFF(buf) ((buf) * 32768)
#define N2_VOFF(buf) ((buf) * 32768 + 16384)
__device__ __forceinline__ float xhalf_max(float v) { auto rr = __builtin_amdgcn_permlane32_swap(__float_as_uint(v), __float_as_uint(v), false, false); return fmaxf(__uint_as_float(rr[0]), __uint_as_float(rr[1])); }
__device__ __forceinline__ float xhalf_sum(float v) { auto rr = __builtin_amdgcn_permlane32_swap(__float_as_uint(v), __float_as_uint(v), false, false); return __uint_as_float(rr[0]) + __uint_as_float(rr[1]); }
__device__ __forceinline__ float xhalf_other(float v) { return swap32_other(v); }
__device__ __forceinline__ void nsa2_stage(LAS unsigned char* lds, int kb, int vb, const bf16* kbase, int krs, const bf16* vtbase, int vrs, int wave, int lane) {
    asm volatile("" : "+v"(lane));
#pragma unroll
    for (int i = 0; i < 2; ++i) {
        const int p = wave * 2 + i;
        const int row = 4 * p + (lane >> 4), ch = (lane & 15) ^ (((row & 3) << 2) | ((row >> 2) & 3));
        __builtin_amdgcn_global_load_lds((const unsigned*)(kbase + (size_t)row * krs + 8 * ch), (LAS unsigned*)(lds + kb + p * 1024), 16, 0, 0);
        const int vrow = 8 * p + (lane >> 3), vc = (lane & 7) ^ ((vrow >> 1) & 7);
        __builtin_amdgcn_global_load_lds((const unsigned*)(vtbase + (size_t)vrow * vrs + 8 * vc), (LAS unsigned*)(lds + vb + p * 1024), 16, 0, 0);
    }
}
__device__ __forceinline__ void nsa2_qk(LAS unsigned char* lds, int kb, const bf16x8 (&Qf)[8], const NsaOff koff, f32x16 (&st)[2]) {
#pragma unroll
    for (int kt = 0; kt < 2; ++kt)
#pragma unroll
        for (int r = 0; r < 16; ++r) st[kt][r] = 0.f;
#define N2_KFRAG(i) (*(const LAS bf16x8*)(lds + kb + ((i) >> 3) * 8192 + koff.at((i) & 7)))
    bf16x8 fa = N2_KFRAG(0), fb = N2_KFRAG(1);
    __builtin_amdgcn_sched_barrier(0);
#pragma unroll
    for (int i = 0; i < 16; ++i) {
        bf16x8 fc = fb; if (i + 2 < 16) fc = N2_KFRAG(i + 2);
        __builtin_amdgcn_sched_barrier(0);
        st[i >> 3] = __builtin_amdgcn_mfma_f32_32x32x16_bf16(fa, Qf[i & 7], st[i >> 3], 0, 0, 0);
        __builtin_amdgcn_sched_barrier(0);
        fa = fb; fb = fc;
    }
#undef N2_KFRAG
}
__device__ __forceinline__ void nsa2_pv(LAS unsigned char* lds, int vb, const f32x16 (&st)[2], const NsaOff voff, f32x16 (&O)[4]) {
    bf16x8 pf[4];
#pragma unroll
    for (int ks = 0; ks < 4; ++ks) { const int kt = ks >> 1, b0 = (ks & 1) * 8;
        v4u w; w.x = cvtpk(st[kt][b0 + 0], st[kt][b0 + 1]); w.y = cvtpk(st[kt][b0 + 2], st[kt][b0 + 3]); w.z = cvtpk(st[kt][b0 + 4], st[kt][b0 + 5]); w.w = cvtpk(st[kt][b0 + 6], st[kt][b0 + 7]);
        pf[ks] = __builtin_bit_cast(bf16x8, w); }
#define N2_VFRAG(i) (*(const LAS bf16x8*)(lds + vb + ((i) >> 2) * 4096 + voff.at((i) & 3)))
    bf16x8 fa = N2_VFRAG(0), fb = N2_VFRAG(1);
    __builtin_amdgcn_sched_barrier(0);
#pragma unroll
    for (int i = 0; i < 16; ++i) {
        bf16x8 fc = fb; if (i + 2 < 16) fc = N2_VFRAG(i + 2);
        __builtin_amdgcn_sched_barrier(0);
        O[i >> 2] = __builtin_amdgcn_mfma_f32_32x32x16_bf16(fa, pf[i & 3], O[i >> 2], 0, 0, 0);
        __builtin_amdgcn_sched_barrier(0);
        fa = fb; fb = fc;
    }
#undef N2_VFRAG
}
template <bool FAST>
__device__ __forceinline__ void nsa2_sm(f32x16 (&st)[2], f32x16 (&O)[4], float& m2, float& l, int lo_k, int hi_k, int h) {
    constexpr float C = 0.08838834764831845f * 1.4426950408889634f;
    const bool full = lo_k < 0 && hi_k >= 63, off = hi_k < 0 || lo_k >= 63;
    const int mode = !FAST ? 2 : (__builtin_amdgcn_ballot_w64(!full) == 0ull ? 0 : (__builtin_amdgcn_ballot_w64(!(full || off)) == 0ull ? 1 : 2));
    const bool masked = mode == 2;
    float mx = -1e30f;
    if (mode == 1) {
#pragma unroll
        for (int kt = 0; kt < 2; ++kt)
#pragma unroll
            for (int r = 0; r < 16; ++r) { const float sv = full ? st[kt][r] : -1e30f; st[kt][r] = sv; mx = fmaxf(mx, sv); }
        mx *= C;
    } else if (masked) {
#pragma unroll
        for (int kt = 0; kt < 2; ++kt)
#pragma unroll
            for (int r = 0; r < 16; ++r) { const int kk = 32 * kt + (r & 3) + 8 * (r >> 2) + 4 * h; const bool valid = (kk > lo_k) && (kk <= hi_k);
                const float sv = valid ? st[kt][r] * C : -1e30f; st[kt][r] = sv; mx = fmaxf(mx, sv); }
    } else {
#pragma unroll
        for (int kt = 0; kt < 2; ++kt)
#pragma unroll
            for (int r = 0; r < 16; ++r) mx = fmaxf(mx, st[kt][r]);
        mx *= C;
    }
    mx = xhalf_max(mx);
    const bool resc = !FAST || __builtin_amdgcn_ballot_w64(mx > m2 + 11.5415603f) != 0ull;
    float mnew = m2, alpha = 1.f;
    if (resc) { mnew = fmaxf(m2, mx); alpha = __builtin_amdgcn_exp2f(m2 - mnew); m2 = mnew; }
    float ps = 0.f;
    if (mode == 1) {
        const float nms = -fmaxf(mnew, -1e28f);
#pragma unroll
        for (int kt = 0; kt < 2; ++kt)
#pragma unroll
            for (int r = 0; r < 16; ++r) { const float p = __builtin_amdgcn_exp2f(__builtin_fmaf(st[kt][r], C, nms)); st[kt][r] = p; ps += p; }
    } else if (masked) {
#pragma unroll
        for (int kt = 0; kt < 2; ++kt)
#pragma unroll
            for (int r = 0; r < 16; ++r) { const float p = st[kt][r] > -5e29f ? __builtin_amdgcn_exp2f(st[kt][r] - mnew) : 0.f; st[kt][r] = p; ps += p; }
    } else {
#pragma unroll
        for (int kt = 0; kt < 2; ++kt)
#pragma unroll
            for (int r = 0; r < 16; ++r) { const float p = __builtin_amdgcn_exp2f(__builtin_fmaf(st[kt][r], C, -mnew)); st[kt][r] = p; ps += p; }
    }
    l = l * alpha + ps;
    if (resc) {
#pragma unroll
        for (int db = 0; db < 4; ++db) O[db] = O[db] * alpha;
    }
}
template <bool FAST>
__device__ __forceinline__ void nsa2_flash(LAS unsigned char* lds, int buf, const bf16x8 (&Qf)[8], const NsaOff koff, const NsaOff voff, f32x16 (&O)[4], float& m2, float& l, int lo_k, int hi_k, int h) {
    f32x16 st[2];
    nsa2_qk(lds, N2_KOFF(buf), Qf, koff, st);
    nsa2_sm<FAST>(st, O, m2, l, lo_k, hi_k, h);
    nsa2_pv(lds, N2_VOFF(buf), st, voff, O);
}
__device__ __forceinline__ void nsa2_unit(Frame& F, const WsPtrs& W, int b, int kvh, int c, int pass) {
    LAS unsigned char* lds = F.lds;
    LAS float* IMPW = (LAS float*)(lds + N2_IMPW); LAS float* IMP = (LAS float*)(lds + N2_IMP); LAS unsigned* SEL = (LAS unsigned*)(lds + N2_SEL);
    int lane_ = F.lane; asm volatile("" : "+v"(lane_));
    const int lane = lane_, wave = F.wave, tid = wave * 64 + lane, g = wave >> 1, qh = wave & 1, q = lane & 31, h = lane >> 5, hq = kvh * 4 + g;
    const int rq = 32 * qh + q, t = c * 64 + rq; const size_t row = (size_t)b * SEQ + t;
    const int xr = ((q & 3) << 2) | ((q >> 2) & 3), xv = (q >> 1) & 7;
    const NsaOff koff = {(unsigned)(256 * q + 16 * ((h ^ xr) & 1)), (unsigned)(xr >> 1)}, voff = {(unsigned)(128 * q + 16 * ((h ^ xv) & 1)), (unsigned)(xv >> 1)};
    const bf16* kcb = W.kcmp + (size_t)(b * 2 + kvh) * 128 * 128; const bf16* vcb = W.vcmpt + (size_t)(b * 2 + kvh) * 128 * 128;
    nsa2_stage(lds, N2_KOFF(0), N2_VOFF(0), kcb, 128, vcb, 128, wave, lane);
    nsa2_stage(lds, N2_KOFF(1), N2_VOFF(1), kcb + 64 * 128, 128, vcb + 64, 128, wave, lane);
    bf16x8 Qf[8];
    { const bf16* qp = W.z + row * ZW + ZC_NQ + hq * 128 + 8 * h;
#pragma unroll
      for (int s = 0; s < 8; ++s) Qf[s] = *(const GAS bf16x8*)(qp + 16 * s); }
    const GAS bf16* zg_ = (const GAS bf16*)(W.z + row * ZW + ZC_NG + hq * 3);
    const float g0 = sigmoidf_(bf2f(zg_[0])), g1 = sigmoidf_(bf2f(zg_[1])), g2 = sigmoidf_(bf2f(zg_[2]));
    if (tid < 65) SEL[tid] = 0u;
    float* op = W.oacc + row * 1024 + hq * 128 + 4 * h;
    asm volatile("s_waitcnt vmcnt(0)" ::: "memory");
    __syncthreads();
    constexpr float C = 0.08838834764831845f * 1.4426950408889634f;
    f32x16 O[4];
    {
        const int lim = t >= 31 ? ((t - 31) >> 4) : -1;
        const int limc = lim < NCMP - 1 ? lim : NCMP - 1;
        float m2 = -1e30f, l = 0.f;
#pragma unroll
        for (int db = 0; db < 4; ++db)
#pragma unroll
            for (int r = 0; r < 16; ++r) O[db][r] = 0.f;
        nsa2_flash<false>(lds, 0, Qf, koff, voff, O, m2, l, -1, limc, h);
        nsa2_flash<false>(lds, 1, Qf, koff, voff, O, m2, l, -1, limc - 64, h);
        const float lt = xhalf_sum(l), inv = lt > 0.f ? 1.f / lt : 0.f, og = inv * g0;
#pragma unroll
        for (int db = 0; db < 4; ++db)
#pragma unroll
            for (int r4 = 0; r4 < 4; ++r4) *(GAS f32x4*)(op + 32 * db + 8 * r4) = (f32x4){O[db][4 * r4] * og, O[db][4 * r4 + 1] * og, O[db][4 * r4 + 2] * og, O[db][4 * r4 + 3] * og};
        LAS float* iw = IMPW + (wave * 32 + q) * 33 + h;
        float prev = 0.f;
#pragma unroll
        for (int blk = 0; blk < 2; ++blk) {
            f32x16 st[2];
            nsa2_qk(lds, N2_KOFF(blk), Qf, koff, st);
#pragma unroll
            for (int kt = 0; kt < 2; ++kt)
#pragma unroll
                for (int r4 = 0; r4 < 4; ++r4) {
                    float pv[4];
#pragma unroll
                    for (int i = 0; i < 4; ++i) { const int kk = 64 * blk + 32 * kt + 8 * r4 + 4 * h + i; pv[i] = kk <= limc ? __builtin_amdgcn_exp2f(st[kt][4 * r4 + i] * C - m2) * inv : 0.f; }
                    const float s4 = (pv[0] + pv[1]) + (pv[2] + pv[3]);
                    const float o = xhalf_other(pv[3]);
                    const float add = h ? o : prev; prev = o;
                    iw[2 * (8 * blk + 4 * kt + r4)] = s4 + add;
                }
        }
    }
    __syncthreads();
    const bf16* ksb = W.z + (size_t)b * SEQ * ZW + ZC_KS + kvh * 128; const bf16* vsb = W.vts + (size_t)(b * 2 + kvh) * 128 * SEQ;
    const bf16* kwb = W.z + (size_t)b * SEQ * ZW + ZC_KW + kvh * 128; const bf16* vwb = W.vtw + (size_t)(b * 2 + kvh) * 128 * SEQ;
    nsa2_stage(lds, N2_KOFF(0), N2_VOFF(0), ksb, ZW, vsb, SEQ, wave, lane);
    for (int e = tid; e < 64 * 32; e += 512) { const int q64 = e >> 5, j = e & 31; const int wq = (q64 >> 5), ql = q64 & 31;
        IMP[q64 * 33 + j] = ((IMPW[((0 + wq) * 32 + ql) * 33 + j] + IMPW[((2 + wq) * 32 + ql) * 33 + j]) + IMPW[((4 + wq) * 32 + ql) * 33 + j]) + IMPW[((6 + wq) * 32 + ql) * 33 + j]; }
    __syncthreads();
    for (int e = tid; e < 64 * 32; e += 512) { const int q64 = e >> 5, j = e & 31;
        float vv[32];
#pragma unroll
        for (int i = 0; i < 32; ++i) vv[i] = IMP[q64 * 33 + i];
        const float vjr = IMP[q64 * 33 + j];
        __builtin_amdgcn_sched_barrier(0);
        const float vj = (j == 0 || j == c || j == c - 1) ? 1e4f : (j > c ? -1.f : vjr);
        int rank = 0;
#pragma unroll
        for (int i = 0; i < 32; ++i) { const float vi = (i == 0 || i == c || i == c - 1) ? 1e4f : (i > c ? -1.f : vv[i]); rank += (vi > vj || (vi == vj && i < j)) ? 1 : 0; }
        if (j <= c && rank < TOPK) { __hip_atomic_fetch_or(&SEL[q64], 1u << j, __ATOMIC_RELAXED, __HIP_MEMORY_SCOPE_WORKGROUP); __hip_atomic_fetch_or(&SEL[64], 1u << j, __ATOMIC_RELAXED, __HIP_MEMORY_SCOPE_WORKGROUP); } }
    __syncthreads();
    const unsigned mysel = SEL[rq];
    const unsigned anysel = __builtin_amdgcn_readfirstlane(SEL[64]);
    const int j0w = c > 8 ? c - 8 : 0, nsl = __builtin_popcount(anysel), nit = nsl + (c - j0w + 1);
    unsigned rem = anysel & ~1u;
    float m2 = -1e30f, l = 0.f;
#pragma unroll
    for (int db = 0; db < 4; ++db)
#pragma unroll
        for (int r = 0; r < 16; ++r) O[db][r] = 0.f;
    int jcur = 0;
    const bool early = wave < 4;
    f32x16 st[2];
    int p_lo = -1, p_hi = 63, p_vb = N2_VOFF(0), vsl = 0; bool p_any = false;
    for (int it = 0; it <= nit; ++it) {
        const int kb = (it & 1) * 32768, vb = vsl == 0 ? 16384 : (vsl == 1 ? 49152 : 65536);
        const int vsn = vsl == 2 ? 0 : vsl + 1, vbn = vsn == 0 ? 16384 : (vsn == 1 ? 49152 : 65536);
        const bool is_sel = it < nsl;
        int jn = 0; const int itn = it + 1;
        if (itn < nit) {
            if (itn < nsl) { jn = __builtin_ctz(rem); rem &= rem - 1u; nsa2_stage(lds, (itn & 1) * 32768, vbn, ksb + (size_t)jn * 64 * ZW, ZW, vsb + jn * 64, SEQ, wave, lane); }
            else { jn = j0w + (itn - nsl); nsa2_stage(lds, (itn & 1) * 32768, vbn, kwb + (size_t)jn * 64 * ZW, ZW, vwb + jn * 64, SEQ, wave, lane); }
        }
        const int j = jcur;
        int lo_k = -1, hi_k = 63; bool lane_on = it < nit;
        if (j == c) hi_k = rq;
        if (is_sel) lane_on = (mysel >> j) & 1u; else if (j == c - 8) lo_k = rq;
        if (!lane_on) hi_k = -1;
        const bool any = it < nit && __builtin_amdgcn_ballot_w64(lane_on) != 0ull;
        if (it > 0 && p_any) { if (!early) nsa2_sm<true>(st, O, m2, l, p_lo, p_hi, h); nsa2_pv(lds, p_vb, st, voff, O); }
        const int e = it - 1;
        if (e >= 0 && (e == nsl - 1 || e == nit - 1)) {
            const float lt = xhalf_sum(l); const float sc = (e == nsl - 1 ? g1 : g2) / lt;
            if (e == nsl - 1) {
#pragma unroll
                for (int hb = 0; hb < 4; ++hb) { f32x4 tv[4];
#pragma unroll
                    for (int q8 = 0; q8 < 4; ++q8) tv[q8] = *(const GAS f32x4*)(op + 32 * hb + 8 * q8);
                    __builtin_amdgcn_sched_barrier(0);
#pragma unroll
                    for (int q8 = 0; q8 < 4; ++q8) { const int db = hb, r4 = q8; f32x4 v = tv[q8];
                        v.x += O[db][4 * r4] * sc; v.y += O[db][4 * r4 + 1] * sc; v.z += O[db][4 * r4 + 2] * sc; v.w += O[db][4 * r4 + 3] * sc; *(GAS f32x4*)(op + 32 * db + 8 * r4) = v; }
                    __builtin_amdgcn_sched_barrier(0); }
                m2 = -1e30f; l = 0.f;
#pragma unroll
                for (int db = 0; db < 4; ++db)
#pragma unroll
                    for (int r = 0; r < 16; ++r) O[db][r] = 0.f;
            } else {
                float ss = 0.f; bf16* mp = W.mix + row * 2048 + 1024 + hq * 128 + 4 * h;
#pragma unroll
                for (int hb = 0; hb < 4; ++hb) { f32x4 tv[4];
#pragma unroll
                    for (int q8 = 0; q8 < 4; ++q8) tv[q8] = *(const GAS f32x4*)(op + 32 * hb + 8 * q8);
                    __builtin_amdgcn_sched_barrier(0);
#pragma unroll
                    for (int q8 = 0; q8 < 4; ++q8) { const int db = hb, r4 = q8; const f32x4 v = tv[q8];
                        const float a0 = v.x + O[db][4 * r4] * sc, a1 = v.y + O[db][4 * r4 + 1] * sc, a2 = v.z + O[db][4 * r4 + 2] * sc, a3 = v.w + O[db][4 * r4 + 3] * sc;
                        ss += (a0 * a0 + a1 * a1) + (a2 * a2 + a3 * a3);
                        *(GAS unsigned long long*)(mp + 32 * db + 8 * r4) = (unsigned long long)pk2(a0, a1) | ((unsigned long long)pk2(a2, a3) << 32); }
                    __builtin_amdgcn_sched_barrier(0); }
                ss = xhalf_sum(ss);
                if (h == 0) W.ssq[(size_t)hq * M + row] = ss;
            }
        }
        if (any) { nsa2_qk(lds, kb, Qf, koff, st); if (early) nsa2_sm<true>(st, O, m2, l, lo_k, hi_k, h); }
        p_lo = lo_k; p_hi = hi_k; p_any = any; p_vb = vb; vsl = vsn;
        jcur = jn;
        asm volatile("s_waitcnt vmcnt(0)" ::: "memory");
        __syncthreads();
    }
}

__device__ __forceinline__ void ph_vt(Frame& F, const WsPtrs& W) {
    LAS bf16* T = (LAS bf16*)F.lds;
    for (int tile = F.bid; tile < 1024; tile += F.G) {
        const int which = tile & 1, kvh = (tile >> 1) & 1, tb = (tile >> 2) & 31, b = tile >> 7;
        const int zc = (which ? ZC_VW : ZC_VS) + kvh * 128; const size_t r0 = (size_t)b * SEQ + tb * 64;
        for (int e = F.tid; e < 64 * 16; e += 512) { const int r = e >> 4, qd = e & 15; *(LAS v4u*)(T + r * 136 + 8 * qd) = *(const GAS v4u*)(W.z + (r0 + r) * ZW + zc + 8 * qd); }
        __syncthreads();
        bf16* dst = (which ? W.vtw : W.vts) + (size_t)(b * 2 + kvh) * 128 * SEQ + tb * 64;
        for (int e = F.tid; e < 128 * 8; e += 512) { const int d = e >> 3, u = e & 7, kb = 16 * (u >> 1) + 4 * (u & 1);
            unsigned w[4];
#pragma unroll
            for (int i = 0; i < 4; ++i) { const int k0 = kb + (i >> 1) * 8 + (i & 1) * 2; w[i] = (unsigned)T[k0 * 136 + d] | ((unsigned)T[(k0 + 1) * 136 + d] << 16); }
            v4u o; o.x = w[0]; o.y = w[1]; o.z = w[2]; o.w = w[3];
            *(GAS v4u*)(dst + (size_t)d * SEQ + 8 * u) = o; }
        __syncthreads();
    }
}

__device__ __forceinline__ void ph_nsa_norm(Frame& F, const LayerPtrs& L, const WsPtrs& W) {
    const size_t total = (size_t)M * 128;
    for (size_t i = (size_t)F.bid * 512 + F.tid; i < total; i += (size_t)F.G * 512) {
        const int m = (int)(i >> 7), q = (int)(i & 127);
        float sq = 0.f;
#pragma unroll
        for (int hh = 0; hh < 8; ++hh) sq += W.ssq[(size_t)hh * M + m];
        const float rstd = 1.f / sqrtf(sq * (1.f / 1024.f) + NORM_EPS);
        GAS v4u* p = (GAS v4u*)(W.mix + (size_t)m * 2048 + 1024 + 8 * q); v4u v = *p; const float* gn = L.nsa_norm + 8 * q;
        unsigned w[4] = {v.x, v.y, v.z, v.w};
#pragma unroll
        for (int k = 0; k < 4; ++k) { const float lo = bf2f((bf16)(w[k] & 0xffffu)) * rstd * gn[2 * k], hi = bf2f((bf16)(w[k] >> 16)) * rstd * gn[2 * k + 1]; w[k] = pk2(lo, hi); }
        v.x = w[0]; v.y = w[1]; v.z = w[2]; v.w = w[3]; *p = v;
    }
}
__device__ __forceinline__ void ph_ffn_gate(Frame& F, const LayerPtrs& L, const WsPtrs& W) {
    constexpr int FG = D_FF / 8, NITEM = FG * (M / 64);
    for (int it = F.bid * 512 + F.tid; it < NITEM; it += F.G * 512) {
        const int blk = it / FG, q = it - blk * FG, f0 = 8 * q; const bool first = (blk & (SEQ / 64 - 1)) == 0;
        const bf16* e0 = W.u + (size_t)blk * 4 * (2 * D_FF) + f0; const bf16* ep = e0 - 4 * (2 * D_FF);
        v4u r[2][4];
#pragma unroll
        for (int s = 0; s < 2; ++s) { r[s][2] = *(const GAS v4u*)(e0 + s * D_FF); r[s][3] = *(const GAS v4u*)(e0 + (2 * D_FF) + s * D_FF);
            if (first) { r[s][0] = (v4u){0u, 0u, 0u, 0u}; r[s][1] = r[s][0]; } else { r[s][0] = *(const GAS v4u*)(ep + 2 * (2 * D_FF) + s * D_FF); r[s][1] = *(const GAS v4u*)(ep + 3 * (2 * D_FF) + s * D_FF); } }
        float wg[3][8], wu[3][8], bg[8], bu[8];
#pragma unroll
        for (int j = 0; j < 3; ++j) { const GAS f32x4* p = (const GAS f32x4*)(L.ffn_conv_w + (size_t)j * (2 * D_FF) + f0); const GAS f32x4* pu = (const GAS f32x4*)(L.ffn_conv_w + (size_t)j * (2 * D_FF) + D_FF + f0);
            const f32x4 a0 = p[0], a1 = p[1], c0 = pu[0], c1 = pu[1];
#pragma unroll
            for (int i = 0; i < 4; ++i) { wg[j][i] = a0[i]; wg[j][4 + i] = a1[i]; wu[j][i] = c0[i]; wu[j][4 + i] = c1[i]; } }
        { const GAS f32x4* p = (const GAS f32x4*)(L.ffn_conv_b + f0); const GAS f32x4* pu = (const GAS f32x4*)(L.ffn_conv_b + D_FF + f0); const f32x4 a0 = p[0], a1 = p[1], c0 = pu[0], c1 = pu[1];
#pragma unroll
          for (int i = 0; i < 4; ++i) { bg[i] = a0[i]; bg[4 + i] = a1[i]; bu[i] = c0[i]; bu[4 + i] = c1[i]; } }
#pragma unroll
        for (int e = 0; e < 2; ++e) {
            float yy[8];
#pragma unroll
            for (int k2 = 0; k2 < 4; ++k2) { float y[2];
#pragma unroll
                for (int hh = 0; hh < 2; ++hh) { const int i = 2 * k2 + hh;
                    const unsigned g2 = ((const unsigned*)&r[0][e])[k2], g1 = ((const unsigned*)&r[0][e + 1])[k2], gc = ((const unsigned*)&r[0][e + 2])[k2];
                    const unsigned u2 = ((const unsigned*)&r[1][e])[k2], u1 = ((const unsigned*)&r[1][e + 1])[k2], uc = ((const unsigned*)&r[1][e + 2])[k2];
                    const float ga = bg[i] + wg[0][i] * bf2f((bf16)(hh ? g2 >> 16 : g2 & 0xffffu)) + wg[1][i] * bf2f((bf16)(hh ? g1 >> 16 : g1 & 0xffffu)) + wg[2][i] * bf2f((bf16)(hh ? gc >> 16 : gc & 0xffffu));
                    const float ua = bu[i] + wu[0][i] * bf2f((bf16)(hh ? u2 >> 16 : u2 & 0xffffu)) + wu[1][i] * bf2f((bf16)(hh ? u1 >> 16 : u1 & 0xffffu)) + wu[2][i] * bf2f((bf16)(hh ? uc >> 16 : uc & 0xffffu));
                    y[hh] = siluf_(ga) * ua; }
                yy[2 * k2] = y[0] * pg8::F8_GS; yy[2 * k2 + 1] = y[1] * pg8::F8_GS; }
            *(GAS unsigned long long*)((unsigned char*)W.g + ((size_t)blk * 64 + e) * D_FF + f0) = (unsigned long long)pg8::pk4_fp8(yy[0], yy[1], yy[2], yy[3]) | ((unsigned long long)pg8::pk4_fp8(yy[4], yy[5], yy[6], yy[7]) << 32);
        }
    }
}


__device__ __forceinline__ void call_prologue(Frame& F, int layer) {
    const LayerPtrs L = make_L(F, layer); const WsPtrs W = make_W(F, layer); ph_prologue(F, L, W, layer == 0 ? inptr(F, 0) : (const float*)F.out, layer);
}
__device__ __forceinline__ void call_mix1(Frame& F, int layer) {
    const LayerPtrs L = make_L(F, layer); const WsPtrs W = make_W(F, layer);
    if (F.bid < 256) cmp_unit<true>(F, L, W, F.bid, layer); else vt_tiles4(F, W, F.bid);
    for (int t0 = F.bid + 4 * F.G; t0 < 1024; t0 += 4 * F.G) vt_tiles4(F, W, t0);
    for (int u = F.bid + F.G; u < 256; u += F.G) cmp_unit<false>(F, L, W, u, layer);
}
constexpr int I_UP = (D_MODEL / 64) * (2 * D_FF / 64), I_DN = (D_FF / 64) * (D_MODEL / 64), NCONV = (I_UP + I_DN) / 8;
static_assert(I_UP % 32 == 0 && I_DN % 32 == 0, "conversion items");
constexpr int CW_QUEUE = 8192;
__device__ __forceinline__ unsigned* conv_head(Frame& F, int layer) { return (unsigned*)(F.ws + WS_CTL) + CW_QUEUE + 512 + 64 * layer; }
__device__ __forceinline__ void conv_fine(Frame& F, const WsPtrs& W, int layer, int cu) {
    const int wt = cu * 8 + F.wave;
    if (wt < I_UP) transpose_item<2>(inptr(F, 17) + (size_t)layer * D_MODEL * 2 * D_FF, D_MODEL, 2 * D_FF, 2 * D_FF, W.wup, wt, F.lane, inptr(F, 16) + (size_t)layer * D_MODEL);
    else transpose_item<3>(inptr(F, 20) + (size_t)layer * D_FF * D_MODEL, D_FF, D_MODEL, D_MODEL, W.wdn, wt - I_UP, F.lane);
}
__device__ __forceinline__ void conv_coarse(Frame& F, const WsPtrs& W, int layer, int c) {
    if ((c & 3) == 0 && c + 4 <= NCONV) {
        const int wt = c * 8 + F.wave * 4;
        if (wt < I_UP) transpose_items4<2>(inptr(F, 17) + (size_t)layer * D_MODEL * 2 * D_FF, D_MODEL, 2 * D_FF, 2 * D_FF, W.wup, wt, F.lane, inptr(F, 16) + (size_t)layer * D_MODEL);
        else transpose_items4<3>(inptr(F, 20) + (size_t)layer * D_FF * D_MODEL, D_FF, D_MODEL, D_MODEL, W.wdn, wt - I_UP, F.lane);
    } else for (int i = c; i < c + 4 && i < NCONV; ++i) conv_fine(F, W, layer, i);
}
__device__ __forceinline__ void call_nsa(Frame& F, int layer, int pass) {
    const WsPtrs W = make_W(F, layer);
    if (F.bid < 64) { const LayerPtrs L = make_L(F, layer); for (int rep = 0; rep < (PROBE_DUP == 41 ? 2 : 1); ++rep) for (int u = F.bid; u < 64; u += (F.G < 64 ? F.G : 64)) mlstm2_unit(F, L, W, u >> 3, u & 7); }
    unsigned* head = (unsigned*)(F.ws + WS_CTL) + CW_QUEUE + 64 * layer + 256 * (1 - pass);
    unsigned* hq = (unsigned*)(F.ws + WS_CTL) + CW_QUEUE + 1024 + 256 * layer;
    const int xs = (int)(xb_xcc_id() & 7u);
    LAS int* slot = (LAS int*)(F.lds + MISC_OFF + 64);
    int kq = pass == 1 ? 0 : 10;
    for (;;) {
        if (kq >= 10) break;
        unsigned* hp = kq < 8 ? hq + 32 * ((xs + kq) & 7) : (kq == 8 ? conv_head(F, layer) : head);
        __syncthreads();
        if (F.tid == 0) *slot = (int)__hip_atomic_fetch_add(hp, 1u, __ATOMIC_RELAXED, __HIP_MEMORY_SCOPE_AGENT);
        __syncthreads();
        const int u = *slot;
        if (kq < 8) {
            if (u >= 64) { ++kq; continue; }
            nsa2_unit(F, W, (xs + kq) & 7, u & 1, 31 - (u >> 1), 1);
            if (u & 1) {
                __syncthreads();
                if (F.tid == 0) *slot = (int)__hip_atomic_fetch_add(conv_head(F, layer), 4u, __ATOMIC_RELAXED, __HIP_MEMORY_SCOPE_AGENT);
                __syncthreads();
                const int c = *slot;
                if (c < NCONV) conv_coarse(F, W, layer, c);
            }
            continue;
        }
        if (kq == 8) { if (u >= NCONV) { ++kq; continue; } conv_fine(F, W, layer, u); continue; }
        if (layer + 1 >= DEPTH || u >= NSMALL / 8) break;
        { const LayerPtrs L1 = make_L(F, layer + 1); const WsPtrs W1 = make_W(F, layer + 1); small_item(F, L1, W1, u * 8 + F.wave, true); }
    }
}

struct Args { const float* in[22]; float* out; unsigned char* ws; int ph_lo, ph_hi, pad0, pad1; };
__global__ void __launch_bounds__(NWAVES * 64, 2) hymba_fwd(Args args) {
    extern __shared__ __attribute__((aligned(16))) unsigned char lds[];
    Frame F;
    F.lds = (LAS unsigned char*)lds;
    F.MISC = (volatile LAS unsigned*)(F.lds + MISC_OFF);
    F.tid = threadIdx.x; F.lane = F.tid & 63; F.wave = __builtin_amdgcn_readfirstlane(F.tid >> 6);
    F.G = gridDim.x; F.bid = blockIdx.x;
    unsigned char* ws = args.ws;
    F.ws = args.ws; F.out = args.out;
    F.ctl = (gu32*)(ws + WS_CTL);
    for (int u = F.tid; u < (LDS_BYTES - LDSCTL_OFF) / 4; u += NWAVES * 64) ((LAS unsigned*)(F.lds + LDSCTL_OFF))[u] = 0u;
    __syncthreads();
    if (F.tid < 22) ((LAS unsigned long long*)(F.lds + PT_OFF))[F.tid] = (unsigned long long)args.in[F.tid];
    __syncthreads();
    if (!MK_PER_PHASE) (void)xcd_barrier_post((unsigned*)(F.ctl + CW_BAR), F.MISC + 8);
#define GRID_BAR() do { if (MK_PER_PHASE) { if (F.tid == 0) __hip_atomic_store(F.ctl + 0, 0xBADBA0u, RLX_AGENT); } else { const WsPtrs Wb_ = make_W(F); unsigned st_ = (unsigned)(__UINTPTR_TYPE__)(F.lds + MISC_OFF + 32); asm volatile("" : "+s"(st_)); xcd_barrier_fn((unsigned*)Wb_.ropec - (WS_ROPE - WS_CTL) / 4 + CW_BAR, st_, (int)(F.tid == 0)); } } while (0)
    const int lo = args.ph_lo, hi = args.ph_hi;
#ifndef PH_MASK
#define PH_MASK 0xFFFFFF
#endif
#define PH_EN(k) ((PH_MASK >> (k)) & 1)
#define IN(k) (lo <= (k) && (k) < hi)
#define xcd_barrier_dummy() do { } while (0)
#define SEAM(k) do { if (IN((k) + 1)) GRID_BAR(); } while (0)
#define PHASE_FRAME(Fp) Frame Fp = F; { int l_ = (int)__builtin_amdgcn_mbcnt_hi(~0u, __builtin_amdgcn_mbcnt_lo(~0u, 0u)); asm volatile("" : "+v"(l_)); Fp.lane = l_; Fp.tid = F.wave * 64 + l_; int b_ = F.bid, g_ = F.G; asm volatile("" : "+s"(b_), "+s"(g_)); Fp.bid = b_; Fp.G = g_; }
#define LAYER_BODY(layer) { \
        const int pb = layer * PH_PER_LAYER; \
        if (layer == 0 && PH_EN(0) && IN(pb + 0)) { PHASE_FRAME(Fp); call_prologue(Fp, layer); if (PROBE_DUP == 0) { PHASE_FRAME(Fq); call_prologue(Fq, layer); } SEAM(pb + 0); } \
        if (PH_EN(1) && IN(pb + 1)) { \
            const WsPtrs W = make_W(F, layer); \
            pg8::Gemm g{layer == 0 ? W.xn : W.xr, W.win, M, ZW, D_MODEL}; pg8::StaticOrder S; S.init(M, ZW, F.G, F.bid); \
            pg8::EpiBf16<0> E{W.z, ZW, nullptr, 0, 0, 1.f, pg8::RowScale{layer == 0 ? (const float*)nullptr : (const float*)W.ssqp, 1.f / D_MODEL, NORM_EPS}, W.ropec, W.ropes, 0x15F0000u, SEQ - 1, 0xF000u}; \
            pg8::gemm_phase<pg8::EpiBf16<0>, pg8::StaticOrder, PG8_ALIGN, PG8_SP2>(F.lds + RING_OFF, g, S, E, F.wave); \
            if (PROBE_DUP == 1) pg8::gemm_phase<pg8::EpiBf16<0>, pg8::StaticOrder, PG8_ALIGN, PG8_SP2>(F.lds + RING_OFF, g, S, E, F.wave); \
            SEAM(pb + 1); \
        } \
        if (PH_EN(2) && IN(pb + 2)) { PHASE_FRAME(Fp); call_mix1(Fp, layer); SEAM(pb + 2); } \
        if (PH_EN(4) && IN(pb + 4)) { for (int pass_ = (PROBE_DUP == 4 ? 0 : 1); pass_ < 2; ++pass_) { PHASE_FRAME(Fp); call_nsa(Fp, layer, pass_); } SEAM(pb + 4); } \
        if (PH_EN(6) && IN(pb + 6)) { \
            const WsPtrs W = make_W(F, layer); \
            pg8::Gemm g{W.mix, W.wout, M, D_MODEL, D_MODEL}; pg8::StaticOrder S; S.init(M, D_MODEL, F.G, F.bid); \
            if (layer == 0) { pg8::EpiRes<true> E{W.xr, (const void*)inptr(F, 0), D_MODEL, W.ssqp, 1.f, W.ssq, M}; pg8::gemm_phase<pg8::EpiRes<true>, pg8::StaticOrder, PG8_ALIGN, PG8_SP2, false, true>(F.lds + RING_OFF, g, S, E, F.wave); } \
            else { pg8::EpiRes<false> E{W.xr, (const void*)W.xr, D_MODEL, W.ssqp, 1.f, W.ssq, M}; pg8::gemm_phase<pg8::EpiRes<false>, pg8::StaticOrder, PG8_ALIGN, PG8_SP2, false, true>(F.lds + RING_OFF, g, S, E, F.wave); } \
            SEAM(pb + 6); \
        } \
        if (PH_EN(8) && IN(pb + 8)) { \
            const WsPtrs W = make_W(F, layer); \
            pg8::Gemm g{W.xr, W.wup, M, 2 * D_FF, D_MODEL}; pg8::StaticOrder S; S.init(M, 2 * D_FF, F.G, F.bid); \
            pg8::EpiGate E{pg8::RowScale{W.ssqp, 1.f / D_MODEL, NORM_EPS}, W.g, D_FF, inptr(F, 18) + (size_t)layer * 3 * 2 * D_FF, inptr(F, 19) + (size_t)layer * 2 * D_FF, D_FF, W.u}; \
            pg8::gemm_phase<pg8::EpiGate, pg8::StaticOrder, PG8_ALIGN, PG8_SP2>(F.lds + RING_OFF, g, S, E, F.wave); \
            SEAM(pb + 8); \
        } \
        if (PH_EN(9) && IN(pb + 9)) { PHASE_FRAME(Fp); const LayerPtrs L = make_L(Fp, layer); const WsPtrs W = make_W(Fp, layer); ph_ffn_gate(Fp, L, W); SEAM(pb + 9); } \
        if (PH_EN(10) && IN(pb + 10)) { \
            const WsPtrs W = make_W(F, layer); \
            pg8::Gemm g{W.g, W.wdn, M, D_MODEL, D_FF / 2}; pg8::StaticOrder S; S.init(M, D_MODEL, F.G, F.bid);     \
            pg8::EpiRes<false, true> E{W.xr, (const void*)W.xr, D_MODEL, W.ssqp, 1.f / (pg8::F8_GS * pg8::F8_WS)}; \
            pg8::gemm_phase<pg8::EpiRes<false, true>, pg8::StaticOrder, PG8_ALIGN, PG8_SP2, true>(F.lds + RING_OFF, g, S, E, F.wave); \
            SEAM(pb + 10); \
        } \
     \
    }
    LAYER_BODY(0)
    LAYER_BODY(1)
#undef LAYER_BODY
    if (IN(DEPTH * PH_PER_LAYER)) {
        PHASE_FRAME(Fp); const float* gain = inptr(Fp, 21);
        const int gw = Fp.bid * NWAVES + Fp.wave, NGW = Fp.G * NWAVES;
        const WsPtrs Wf = make_W(Fp, 0);
        for (int m = gw; m < M; m += NGW) rms_brow_to_f32(Wf.xr + (size_t)m * D_MODEL, gain, Fp.out + (size_t)m * D_MODEL, Fp.lane);
    }
#undef IN
#undef SEAM
}

extern "C" void kernel_launch(void* const* d_in, const int* in_sizes, int n_in, void* d_out, int out_size, void* d_ws, size_t ws_size, hipStream_t stream) {
    static int grid = 0;
    if (grid == 0) {
        if (n_in != 22 || in_sizes[0] != M * D_MODEL || out_size != M * D_MODEL || ws_size < WS_END) { fprintf(stderr, "kernel_launch: unexpected shapes (n_in %d, in0 %d, out %d, ws %zu < %zu); nothing launched\n", n_in, n_in > 0 ? in_sizes[0] : -1, out_size, ws_size, (size_t)WS_END); grid = -1; return; }
        int dev = 0, cus = 0, per_cu = 0;
        if (hipGetDevice(&dev) != hipSuccess || hipDeviceGetAttribute(&cus, hipDeviceAttributeMultiprocessorCount, dev) != hipSuccess) { fprintf(stderr, "kernel_launch: device query failed\n"); grid = -1; return; }
        if (hipFuncSetAttribute((const void*)hymba_fwd, hipFuncAttributeMaxDynamicSharedMemorySize, LDS_BYTES) != hipSuccess) { fprintf(stderr, "kernel_launch: hipFuncSetAttribute failed\n"); grid = -1; return; }
        if (hipOccupancyMaxActiveBlocksPerMultiprocessor(&per_cu, (const void*)hymba_fwd, NWAVES * 64, LDS_BYTES) != hipSuccess || per_cu < 1)
            fprintf(stderr, "kernel_launch: note: occupancy query reports %d workgroups per CU\n", per_cu);
        (void)hipGetLastError();
        grid = cus;
    }
    if (grid < 0) return;
    if (hipMemsetAsync((char*)d_ws + WS_CTL, 0, CTL_ZERO_BYTES, stream) != hipSuccess) { fprintf(stderr, "kernel_launch: memset failed\n"); return; }
    Args a{};
    for (int i = 0; i < 22; ++i) a.in[i] = (const float*)d_in[i];
    a.out = (float*)d_out; a.ws = (unsigned char*)d_ws; a.pad0 = 0; a.pad1 = 0;
#if MK_PER_PHASE
    for (int p = 0; p < N_PHASES; ++p) { a.ph_lo = p; a.ph_hi = p + 1; hipLaunchKernelGGL(hymba_fwd, dim3(grid), dim3(NWAVES * 64), LDS_BYTES, stream, a); }
#else
    a.ph_lo = 0; a.ph_hi = N_PHASES; hipLaunchKernelGGL(hymba_fwd, dim3(grid), dim3(NWAVES * 64), LDS_BYTES, stream, a);
#endif
    const hipError_t le = hipPeekAtLastError();
    if (le != hipSuccess) fprintf(stderr, "kernel_launch: launch failed: %s\n", hipGetErrorName(le));
}
```

```cpp
#include <hip/hip_runtime.h>
#include <cstdio>
#include <cstdint>
#ifndef PROBE_DUP
#define PROBE_DUP -1
#endif
namespace pg8 {
#define PG8_LAS __attribute__((address_space(3)))
#ifndef EPI_SPLIT_BF16
#define EPI_SPLIT_BF16 true
#endif
#ifndef EPI_SPLIT_RES
#define EPI_SPLIT_RES true
#endif
#ifndef EPI_SPLIT_GATE
#define EPI_SPLIT_GATE true
#endif
#define PG8_GAS __attribute__((address_space(1)))
typedef unsigned short bf16_t;
typedef short bf16x8 __attribute__((ext_vector_type(8)));
typedef float f32x4 __attribute__((ext_vector_type(4)));
typedef unsigned u32x4 __attribute__((ext_vector_type(4)));
constexpr int BM = 256, BK = 64, HALF = 128, HTB = HALF * BK * 2  , STAGE_BYTES = 8 * HTB, NXCD = 8, WGM = 8;

__host__ __device__ __forceinline__ int lds_byte(int r, int c) { const int st = (r >> 4) * 2 + (c >> 5), rr = r & 15, cc = c & 31, ob = rr * 64 + cc * 2; return st * 1024 + (ob ^ (((ob >> 9) & 1) << 5)); }
__host__ __device__ __forceinline__ void stage_rc(int b, int& R, int& C) { const int st = b / 1024, sb = b % 1024, swz = sb ^ (((sb >> 9) & 1) << 5); R = (st >> 1) * 16 + swz / 64; C = (st & 1) * 32 + (swz % 64) / 2; }
__host__ __device__ __forceinline__ int perm32(int rho) { const int n = rho >> 4, i = rho & 15; return 8 * (i >> 2) + 4 * n + (i & 3); }

struct Unit { int pm, pn; };
struct Gemm { const bf16_t* A; const bf16_t* Bt; int M, N, K; };

struct StaticOrder {
    int nM, nN, nwg, G, c;
    __host__ __device__ void init(int M, int N, int G_, int c_) { nM = M / BM; nN = N / BM; nwg = nM * nN; G = G_; c = c_; }
    __host__ __device__ bool next(int i, Unit& u) const {
        const long L = (long)i * G + c; if (L >= nwg) return false;
        int wgid = (int)L; { const int q = nwg / NXCD, r = nwg % NXCD, xcd = wgid % NXCD, off = wgid / NXCD; wgid = (xcd < r ? xcd * (q + 1) : r * (q + 1) + (xcd - r) * q) + off; }
        const int nig = WGM * nN, gid = wgid / nig, fm = gid * WGM, gsz = (nM - fm) < WGM ? (nM - fm) : WGM;
        u.pm = fm + ((wgid % nig) % gsz); u.pn = (wgid % nig) / gsz; return true;
    }
    __device__ __forceinline__ void a_ready(const Unit&) const {}
    __device__ __forceinline__ void done(const Unit&) const {}
};

__device__ __forceinline__ unsigned cvt_pk_bf16(float lo, float hi) { unsigned r; asm volatile("v_cvt_pk_bf16_f32 %0, %1, %2" : "=v"(r) : "v"(lo), "v"(hi)); return r; }
typedef float f32x2 __attribute__((ext_vector_type(2)));
typedef int i32x4 __attribute__((ext_vector_type(4)));
typedef int i32x8 __attribute__((ext_vector_type(8)));
constexpr float F8_GS = 8.f, F8_WS = 64.f;
__device__ __forceinline__ unsigned pk4_fp8(float a, float b, float c, float d) {
    a = __builtin_amdgcn_fmed3f(a, -448.f, 448.f); b = __builtin_amdgcn_fmed3f(b, -448.f, 448.f); c = __builtin_amdgcn_fmed3f(c, -448.f, 448.f); d = __builtin_amdgcn_fmed3f(d, -448.f, 448.f);
    unsigned w; asm volatile("v_cvt_pk_fp8_f32 %0, %1, %2\n\tv_cvt_pk_fp8_f32 %0, %3, %4 op_sel:[0,0,1]" : "=&v"(w) : "v"(a), "v"(b), "v"(c), "v"(d)); return w; }
__device__ __forceinline__ f32x2 gelu_pk(f32x2 v) {
    const f32x2 av = __builtin_elementwise_abs(v), d = av * 0.2316418882f + 1.0f;
    f32x2 t; t.x = __builtin_amdgcn_rcpf(d.x); t.y = __builtin_amdgcn_rcpf(d.y);
    f32x2 q = t * 0.5307027145f + (-0.7265760135f); q = q * t + 0.7107068705f; q = q * t + (-0.142248368f); q = q * t + 0.127414796f; q = q * t;
    const f32x2 s = (v * v) * (-0.72134752044f);
    f32x2 e; e.x = __builtin_amdgcn_exp2f(s.x); e.y = __builtin_amdgcn_exp2f(s.y);
    const f32x2 m = v * (q * e), r = v - m;
    f32x2 o; o.x = v.x < 0.f ? m.x : r.x; o.y = v.y < 0.f ? m.y : r.y; return o;
}

constexpr int RS_OFF = STAGE_BYTES;
struct RowScale {
    const float* part; float inv_n, eps;
    struct Pre { f32x4 v[2]; };
    __device__ __forceinline__ void issue(const Unit& u, int tid, Pre& p) const {
        if (part != nullptr && tid < BM) { const PG8_GAS f32x4* q = (const PG8_GAS f32x4*)(part + (size_t)(u.pm * BM + tid) * 8); p.v[0] = q[0]; p.v[1] = q[1]; } }
    __device__ __forceinline__ void finish(const Pre& p, int slot, int tid, PG8_LAS unsigned char* lds) const {
        if (part != nullptr && tid < BM) { const float s = ((p.v[0][0] + p.v[0][1]) + (p.v[0][2] + p.v[0][3])) + ((p.v[1][0] + p.v[1][1]) + (p.v[1][2] + p.v[1][3]));
            ((PG8_LAS float*)(lds + RS_OFF))[slot * BM + tid] = 1.0f / sqrtf(s * inv_n + eps); } }
    __device__ __forceinline__ float get(PG8_LAS unsigned char* lds, int slot, int r) const { return part != nullptr ? ((const PG8_LAS float*)(lds + RS_OFF))[slot * BM + r] : 1.f; }
};
template <int ACT  , bool PLAIN = false  > struct EpiBf16 {
    static constexpr bool PERM = true, AFTER_DRAIN = false; static_assert(ACT == 0 || ACT == 1, "EpiBf16: ACT is 0 (none) or 1 (gelu_pk)");
    bf16_t* O; int ldc; const float* bias; int split_cols; size_t split_stride; float scale0;
    RowScale rsc;
    typedef RowScale::Pre Pre; static constexpr bool SPLIT_PRE = EPI_SPLIT_BF16;
    __device__ __forceinline__ void issue(const Unit& u, int tid, Pre& p) const { rsc.issue(u, tid, p); }
    __device__ __forceinline__ void finish(const Pre& p, const Unit&, int slot, int tid, PG8_LAS unsigned char* lds) const { rsc.finish(p, slot, tid, lds); }
    const float* rc; const float* rs; unsigned rmask; int posmask; unsigned smask = 0u;
    static __device__ __forceinline__ float other32(float v, bool hi) { auto rr = __builtin_amdgcn_permlane32_swap(__builtin_bit_cast(unsigned, v), __builtin_bit_cast(unsigned, v), false, false); return __builtin_bit_cast(float, hi ? rr[0] : rr[1]); }
    __device__ __forceinline__ void operator()(const f32x4 (&acc)[2][2][4][2], const Unit& u, int wr, int wc, int fr, int fq, PG8_LAS unsigned char* lds, int slot) const {
        const int row0 = u.pm * BM + wr * 64 + fr; int colt = u.pn * BM; bf16_t* base = O;
        float sc = 1.f; if (!PLAIN && split_cols) { const int t = colt / split_cols; base += (size_t)t * split_stride; colt -= t * split_cols; if (t == 0) sc = scale0; }
        const int col0 = colt + wc * 32 + 8 * fq, bcol0 = u.pn * BM + wc * 32 + 8 * fq;
        const bool do_rope = rc != nullptr && wc == 0 && ((rmask >> u.pn) & 1u);
        f32x4 bv[2][2];
#pragma unroll
        for (int bj = 0; bj < 2; ++bj)
#pragma unroll
            for (int n = 0; n < 2; ++n) bv[bj][n] = (!PLAIN && bias) ? *(const PG8_GAS f32x4*)(bias + bcol0 + bj * HALF + 4 * n) : (f32x4){0.f, 0.f, 0.f, 0.f};
        f32x4 nc0 = {1.f, 1.f, 1.f, 1.f}, nc1 = nc0, ns0 = {0.f, 0.f, 0.f, 0.f}, ns1 = ns0;
        if (do_rope) { const int pos = row0 & posmask; const float* tc = rc + pos * 16 + 8 * (fq & 1); const float* ts = rs + pos * 16 + 8 * (fq & 1);
            nc0 = *(const PG8_GAS f32x4*)tc; nc1 = *(const PG8_GAS f32x4*)(tc + 4); ns0 = *(const PG8_GAS f32x4*)ts; ns1 = *(const PG8_GAS f32x4*)(ts + 4); }
#pragma unroll
        for (int ai = 0; ai < 2; ++ai)
#pragma unroll
            for (int m = 0; m < 4; ++m) { bf16_t* rowp = base + (size_t)(row0 + ai * HALF + m * 16) * ldc + col0;
                f32x4 c0 = nc0, c1 = nc1, s0 = ns0, s1 = ns1;
                if (do_rope) { if (fq < 2) { s0 = -s0; s1 = -s1; }
                    if (ai * 4 + m < 7) { const int gn = ai * 4 + m + 1; const int pos = (row0 + (gn >> 2) * HALF + (gn & 3) * 16) & posmask; const float* tc = rc + pos * 16 + 8 * (fq & 1); const float* ts = rs + pos * 16 + 8 * (fq & 1);
                        nc0 = *(const PG8_GAS f32x4*)tc; nc1 = *(const PG8_GAS f32x4*)(tc + 4); ns0 = *(const PG8_GAS f32x4*)ts; ns1 = *(const PG8_GAS f32x4*)(ts + 4); } }
                const float rsv = rsc.get(lds, slot, ai * HALF + wr * 64 + m * 16 + fr);
#pragma unroll
                for (int bj = 0; bj < 2; ++bj) { f32x4 v0 = PLAIN ? acc[ai][bj][m][0] * rsv : (acc[ai][bj][m][0] + bv[bj][0]) * rsv, v1 = PLAIN ? acc[ai][bj][m][1] * rsv : (acc[ai][bj][m][1] + bv[bj][1]) * rsv;
                    if (do_rope) {
#pragma unroll
                        for (int i = 0; i < 4; ++i) { const float p0 = other32(v0[i], fq >= 2), p1 = other32(v1[i], fq >= 2); v0[i] = v0[i] * c0[i] + p0 * s0[i]; v1[i] = v1[i] * c1[i] + p1 * s1[i]; } }
                    if (ACT == 1) { f32x2 a = gelu_pk((f32x2){v0[0], v0[1]}), b = gelu_pk((f32x2){v0[2], v0[3]}), c = gelu_pk((f32x2){v1[0], v1[1]}), d = gelu_pk((f32x2){v1[2], v1[3]});
                        v0 = (f32x4){a.x, a.y, b.x, b.y}; v1 = (f32x4){c.x, c.y, d.x, d.y}; }
                    if ((smask >> u.pn) & 1u) {
#pragma unroll
                        for (int i = 0; i < 4; ++i) { v0[i] = __builtin_amdgcn_rcpf(1.f + __builtin_amdgcn_exp2f(-1.4426950408889634f * v0[i])); v1[i] = __builtin_amdgcn_rcpf(1.f + __builtin_amdgcn_exp2f(-1.4426950408889634f * v1[i])); } }
                    if (!PLAIN) { v0 = v0 * sc; v1 = v1 * sc; } u32x4 w; w.x = cvt_pk_bf16(v0[0], v0[1]); w.y = cvt_pk_bf16(v0[2], v0[3]); w.z = cvt_pk_bf16(v1[0], v1[1]); w.w = cvt_pk_bf16(v1[2], v1[3]);
                    *(PG8_GAS u32x4*)(rowp + bj * HALF) = w; } }
    }
};
template <bool RF32, bool SC = false> struct EpiRes {
    static constexpr bool PERM = true, AFTER_DRAIN = false;
    bf16_t* X; const void* R; int ldc; float* SSQP; float osc = 1.f;
    const float* hssq = nullptr; int hM = 0;
    struct Pre { float v[8]; }; static constexpr bool SPLIT_PRE = EPI_SPLIT_RES;
    __device__ __forceinline__ void issue(const Unit& u, int tid, Pre& p) const {
        if (hssq != nullptr && tid < BM) { const PG8_GAS float* q = (const PG8_GAS float*)hssq + u.pm * BM + tid;
#pragma unroll
            for (int h = 0; h < 8; ++h) p.v[h] = q[(size_t)h * hM]; } }
    __device__ __forceinline__ void finish(const Pre& p, const Unit&, int slot, int tid, PG8_LAS unsigned char* lds) const {
        if (hssq != nullptr && tid < BM) { float s = 0.f;
#pragma unroll
            for (int h = 0; h < 8; ++h) s += p.v[h];
            ((PG8_LAS float*)(lds + RS_OFF))[slot * BM + tid] = 1.0f / sqrtf(s * (1.f / 1024.f) + 1e-6f); } }
    __device__ __forceinline__ void mid(f32x4 (&acc)[2][2][4][2], int wr, int fr, PG8_LAS unsigned char* lds, int slot) const {
#pragma unroll
        for (int ai = 0; ai < 2; ++ai)
#pragma unroll
            for (int m = 0; m < 4; ++m) { const float rs = ((const PG8_LAS float*)(lds + RS_OFF))[slot * BM + ai * HALF + wr * 64 + m * 16 + fr];
#pragma unroll
                for (int bj = 0; bj < 2; ++bj)
#pragma unroll
                    for (int n = 0; n < 2; ++n) acc[ai][bj][m][n] = acc[ai][bj][m][n] * rs; } }
    static __device__ __forceinline__ float sq8(const u32x4 w) { float s = 0.f; const unsigned a[4] = {w.x, w.y, w.z, w.w};
#pragma unroll
        for (int i = 0; i < 4; ++i) { const float lo = __builtin_bit_cast(float, a[i] << 16), hi = __builtin_bit_cast(float, a[i] & 0xffff0000u); s += lo * lo + hi * hi; } return s; }
    static constexpr int SQ_OFF = 136192;
    __device__ __forceinline__ void put_ssq(float ss, int rloc, int wc, int fq, PG8_LAS unsigned char* lds) const {
        ss += __builtin_bit_cast(float, __builtin_amdgcn_ds_swizzle(__builtin_bit_cast(int, ss), 0x401F));
        if ((fq & 1) == 0) ((PG8_LAS float*)(lds + SQ_OFF))[(wc * 2 + (fq >> 1)) * BM + rloc] = ss; }
    __device__ __forceinline__ void flush_ssq(const Unit& u, int wr, int wc, int fr, int fq, PG8_LAS unsigned char* lds) const {
        asm volatile("s_waitcnt lgkmcnt(0)" ::: "memory"); __builtin_amdgcn_s_barrier();
        if (wr == 0) { const int r = wc * 64 + fq * 16 + fr; const PG8_LAS float* t = (const PG8_LAS float*)(lds + SQ_OFF) + r; float s = 0.f;
#pragma unroll
            for (int j = 0; j < 8; ++j) s += t[j * BM];
            ((PG8_GAS float*)SSQP)[(size_t)(u.pm * BM + r) * 8 + u.pn] = s; } }
    __device__ __forceinline__ void operator()(const f32x4 (&acc)[2][2][4][2], const Unit& u, int wr, int wc, int fr, int fq, PG8_LAS unsigned char* lds, int slot) const {
        const int row0 = u.pm * BM + wr * 64 + fr, col0 = u.pn * BM + wc * 32 + 8 * fq;
#pragma unroll
        for (int ai = 0; ai < 2; ++ai) {
            if constexpr (RF32) {
                f32x4 rv[4][2][2];
#pragma unroll
                for (int m = 0; m < 4; ++m) { const size_t off = (size_t)(row0 + ai * HALF + m * 16) * ldc + col0;
#pragma unroll
                    for (int bj = 0; bj < 2; ++bj)
#pragma unroll
                        for (int n = 0; n < 2; ++n) rv[m][bj][n] = *(const PG8_GAS f32x4*)((const float*)R + off + bj * HALF + n * 4); }
#pragma unroll
                for (int m = 0; m < 4; ++m) { const size_t off = (size_t)(row0 + ai * HALF + m * 16) * ldc + col0; float ss = 0.f;
#pragma unroll
                    for (int bj = 0; bj < 2; ++bj) { const f32x4 v0 = acc[ai][bj][m][0] + rv[m][bj][0], v1 = acc[ai][bj][m][1] + rv[m][bj][1];
                        u32x4 w; w.x = cvt_pk_bf16(v0[0], v0[1]); w.y = cvt_pk_bf16(v0[2], v0[3]); w.z = cvt_pk_bf16(v1[0], v1[1]); w.w = cvt_pk_bf16(v1[2], v1[3]);
                        ss += sq8(w); *(PG8_GAS u32x4*)(X + off + bj * HALF) = w; }
                    put_ssq(ss, ai * HALF + wr * 64 + m * 16 + fr, wc, fq, lds); }
            } else {
                u32x4 rv[4][2];
#pragma unroll
                for (int m = 0; m < 4; ++m) { const size_t off = (size_t)(row0 + ai * HALF + m * 16) * ldc + col0;
#pragma unroll
                    for (int bj = 0; bj < 2; ++bj) rv[m][bj] = *(const PG8_GAS u32x4*)((const bf16_t*)R + off + bj * HALF); }
#pragma unroll
                for (int m = 0; m < 4; ++m) { const size_t off = (size_t)(row0 + ai * HALF + m * 16) * ldc + col0; float ss = 0.f;
#pragma unroll
                    for (int bj = 0; bj < 2; ++bj) { const u32x4 r = rv[m][bj];
                        const f32x4 r0 = (f32x4){__builtin_bit_cast(float, r.x << 16), __builtin_bit_cast(float, r.x & 0xffff0000u), __builtin_bit_cast(float, r.y << 16), __builtin_bit_cast(float, r.y & 0xffff0000u)};
                        const f32x4 r1 = (f32x4){__builtin_bit_cast(float, r.z << 16), __builtin_bit_cast(float, r.z & 0xffff0000u), __builtin_bit_cast(float, r.w << 16), __builtin_bit_cast(float, r.w & 0xffff0000u)};
                        const f32x4 v0 = SC ? acc[ai][bj][m][0] * osc + r0 : acc[ai][bj][m][0] + r0, v1 = SC ? acc[ai][bj][m][1] * osc + r1 : acc[ai][bj][m][1] + r1;
                        u32x4 w; w.x = cvt_pk_bf16(v0[0], v0[1]); w.y = cvt_pk_bf16(v0[2], v0[3]); w.z = cvt_pk_bf16(v1[0], v1[1]); w.w = cvt_pk_bf16(v1[2], v1[3]);
                        ss += sq8(w); *(PG8_GAS u32x4*)(X + off + bj * HALF) = w; }
                    put_ssq(ss, ai * HALF + wr * 64 + m * 16 + fr, wc, fq, lds); }
            }
            asm volatile("" ::: "memory");
        }
        flush_ssq(u, wr, wc, fr, fq, lds);
    }
};

struct EpiGate {
    static constexpr bool PERM = true, AFTER_DRAIN = false;
    RowScale rsc;
    static constexpr int TAP_OFF = 136192;
    struct Pre { RowScale::Pre r; float a0, a1, a2, a3; }; static constexpr bool SPLIT_PRE = EPI_SPLIT_GATE;
    __device__ __forceinline__ void issue(const Unit& u, int tid, Pre& p) const {
        const int ch = tid & 127, path = (tid >> 7) & 1;
        if (tid < BM) { const PG8_GAS float* pg_ = (const PG8_GAS float*)(cw + (size_t)path * dff + u.pn * 128 + ch); p.a0 = pg_[0]; p.a1 = pg_[2 * dff]; p.a2 = pg_[4 * dff]; p.a3 = ((const PG8_GAS float*)cb)[(size_t)path * dff + u.pn * 128 + ch]; }
        rsc.issue(u, tid, p.r); }
    __device__ __forceinline__ void finish(const Pre& p, const Unit&, int slot, int tid, PG8_LAS unsigned char* lds) const {
        rsc.finish(p.r, slot, tid, lds);
        if (tid < BM) { const int ch = tid & 127, path = (tid >> 7) & 1; PG8_LAS float* t = (PG8_LAS float*)(lds + TAP_OFF) + slot * 1024 + path * 512 + ch; t[0] = p.a0; t[128] = p.a1; t[256] = p.a2; t[384] = p.a3; } }
    bf16_t* G; int ldg; const float* cw; const float* cb; int dff; bf16_t* edge;
    __device__ __forceinline__ void operator()(const f32x4 (&acc)[2][2][4][2], const Unit& u, int wr, int wc, int fr, int fq, PG8_LAS unsigned char* lds, int slot) const {
        const int f0 = u.pn * 128 + wc * 32 + 8 * fq;
        const float m0 = fr == 0 ? 1.f : 0.f, m01 = fr < 2 ? 1.f : 0.f;
#define PG8_DPP(v, ctrl) __builtin_bit_cast(float, __builtin_amdgcn_update_dpp(0, __builtin_bit_cast(int, (v)), (ctrl), 0xf, 0xf, true))
#pragma unroll
        for (int ai = 0; ai < 2; ++ai) {
            const int rowb = u.pm * BM + ai * HALF + wr * 64;
            unsigned og[4][2];
            float rsv[4];
#pragma unroll
            for (int m = 0; m < 4; ++m) rsv[m] = rsc.get(lds, slot, ai * HALF + wr * 64 + 16 * m + fr);
#pragma unroll
            for (int n = 0; n < 2; ++n) {
                const PG8_LAS float* tp = (const PG8_LAS float*)(lds + TAP_OFF) + slot * 1024 + wc * 32 + 8 * fq + 4 * n;
                const f32x4 g0 = *(const PG8_LAS f32x4*)tp, g1 = *(const PG8_LAS f32x4*)(tp + 128), g2 = *(const PG8_LAS f32x4*)(tp + 256), gb = *(const PG8_LAS f32x4*)(tp + 384);
                const f32x4 u0 = *(const PG8_LAS f32x4*)(tp + 512), u1 = *(const PG8_LAS f32x4*)(tp + 640), u2 = *(const PG8_LAS f32x4*)(tp + 768), ub = *(const PG8_LAS f32x4*)(tp + 896);
                const f32x4 g1m = g1 * m0, g0m = g0 * m01, u1m = u1 * m0, u0m = u0 * m01;
#define PG8_TAPS(y, x, t1, t0, c1, c0) asm volatile("s_nop 1\n\t" \
                    "v_fmac_f32_dpp %0, %4, %8 " c1 " row_mask:0xf bank_mask:0xf bound_ctrl:1\n\tv_fmac_f32_dpp %1, %5, %9 " c1 " row_mask:0xf bank_mask:0xf bound_ctrl:1\n\t" \
                    "v_fmac_f32_dpp %2, %6, %10 " c1 " row_mask:0xf bank_mask:0xf bound_ctrl:1\n\tv_fmac_f32_dpp %3, %7, %11 " c1 " row_mask:0xf bank_mask:0xf bound_ctrl:1\n\t" \
                    "v_fmac_f32_dpp %0, %4, %12 " c0 " row_mask:0xf bank_mask:0xf bound_ctrl:1\n\tv_fmac_f32_dpp %1, %5, %13 " c0 " row_mask:0xf bank_mask:0xf bound_ctrl:1\n\t" \
                    "v_fmac_f32_dpp %2, %6, %14 " c0 " row_mask:0xf bank_mask:0xf bound_ctrl:1\n\tv_fmac_f32_dpp %3, %7, %15 " c0 " row_mask:0xf bank_mask:0xf bound_ctrl:1" \
                    : "+v"(y[0]), "+v"(y[1]), "+v"(y[2]), "+v"(y[3]) : "v"(x[0]), "v"(x[1]), "v"(x[2]), "v"(x[3]), "v"(t1[0]), "v"(t1[1]), "v"(t1[2]), "v"(t1[3]), "v"(t0[0]), "v"(t0[1]), "v"(t0[2]), "v"(t0[3]))
                f32x4 pg, pu;
#pragma unroll
                for (int m = 0; m < 4; ++m) {
                    float yo[4];
                    const f32x4 xg = acc[ai][0][m][n] * rsv[m], xu = acc[ai][1][m][n] * rsv[m];
                    f32x4 yg = gb + g2 * xg, yu = ub + u2 * xu;
                    PG8_TAPS(yg, xg, g1, g0, "row_shr:1", "row_shr:2"); PG8_TAPS(yu, xu, u1, u0, "row_shr:1", "row_shr:2");
                    if (m > 0) { PG8_TAPS(yg, pg, g1m, g0m, "row_ror:1", "row_ror:2"); PG8_TAPS(yu, pu, u1m, u0m, "row_ror:1", "row_ror:2"); }
                    pg = xg; pu = xu;
#pragma unroll
                    for (int i = 0; i < 4; ++i) {
                        const float sg = yg[i] * __builtin_amdgcn_rcpf(1.f + __builtin_amdgcn_exp2f(-1.4426950408889634f * yg[i]));
                        yo[i] = sg * yu[i];
                    }
                    og[m][n] = pk4_fp8(yo[0] * F8_GS, yo[1] * F8_GS, yo[2] * F8_GS, yo[3] * F8_GS);
                }
            }
#pragma unroll
            for (int m = 0; m < 4; ++m) {
                if (m > 0 || fr >= 2) { unsigned long long w = (unsigned long long)og[m][0] | ((unsigned long long)og[m][1] << 32); *(PG8_GAS unsigned long long*)((unsigned char*)G + (size_t)(rowb + 16 * m + fr) * ldg + f0) = w; }
            }
            if (fr < 2 || fr >= 14) { const int m = fr < 2 ? 0 : 3, e = fr < 2 ? fr : fr - 12;
                bf16_t* ep = edge + ((size_t)(rowb >> 6) * 4 + e) * (2 * dff) + f0;
                u32x4 wg, wu;
                if (fr < 2) { wg.x = cvt_pk_bf16((acc[ai][0][0][0][0] * rsv[0]), (acc[ai][0][0][0][1] * rsv[0])); wg.y = cvt_pk_bf16((acc[ai][0][0][0][2] * rsv[0]), (acc[ai][0][0][0][3] * rsv[0])); wg.z = cvt_pk_bf16((acc[ai][0][0][1][0] * rsv[0]), (acc[ai][0][0][1][1] * rsv[0])); wg.w = cvt_pk_bf16((acc[ai][0][0][1][2] * rsv[0]), (acc[ai][0][0][1][3] * rsv[0]));
                              wu.x = cvt_pk_bf16((acc[ai][1][0][0][0] * rsv[0]), (acc[ai][1][0][0][1] * rsv[0])); wu.y = cvt_pk_bf16((acc[ai][1][0][0][2] * rsv[0]), (acc[ai][1][0][0][3] * rsv[0])); wu.z = cvt_pk_bf16((acc[ai][1][0][1][0] * rsv[0]), (acc[ai][1][0][1][1] * rsv[0])); wu.w = cvt_pk_bf16((acc[ai][1][0][1][2] * rsv[0]), (acc[ai][1][0][1][3] * rsv[0])); }
                else {        wg.x = cvt_pk_bf16((acc[ai][0][3][0][0] * rsv[3]), (acc[ai][0][3][0][1] * rsv[3])); wg.y = cvt_pk_bf16((acc[ai][0][3][0][2] * rsv[3]), (acc[ai][0][3][0][3] * rsv[3])); wg.z = cvt_pk_bf16((acc[ai][0][3][1][0] * rsv[3]), (acc[ai][0][3][1][1] * rsv[3])); wg.w = cvt_pk_bf16((acc[ai][0][3][1][2] * rsv[3]), (acc[ai][0][3][1][3] * rsv[3]));
                              wu.x = cvt_pk_bf16((acc[ai][1][3][0][0] * rsv[3]), (acc[ai][1][3][0][1] * rsv[3])); wu.y = cvt_pk_bf16((acc[ai][1][3][0][2] * rsv[3]), (acc[ai][1][3][0][3] * rsv[3])); wu.z = cvt_pk_bf16((acc[ai][1][3][1][0] * rsv[3]), (acc[ai][1][3][1][1] * rsv[3])); wu.w = cvt_pk_bf16((acc[ai][1][3][1][2] * rsv[3]), (acc[ai][1][3][1][3] * rsv[3])); }
                (void)m; *(PG8_GAS u32x4*)ep = wg; *(PG8_GAS u32x4*)(ep + dff) = wu; }
        }
#undef PG8_DPP
#undef PG8_TAPS
    }
};

template <bool F8> struct Frag;
template <> struct Frag<false> { bf16x8 k[2]; __device__ __forceinline__ void ld(int i, const PG8_LAS unsigned char* p) { k[i] = *(const PG8_LAS bf16x8*)p; } };
template <> struct Frag<true> { i32x8 v; __device__ __forceinline__ void ld(int i, const PG8_LAS unsigned char* p) { if (i == 0) v.lo = *(const PG8_LAS i32x4*)p; else v.hi = *(const PG8_LAS i32x4*)p; } };
template <class Epi, class Sched, bool ALIGN_EPI = false, bool SP2 = false, bool F8 = false, bool KROT = false>
__device__ __forceinline__ void gemm_phase(PG8_LAS unsigned char* lds, const Gemm g, const Sched& S, const Epi& E, const int wave_id) {
    int lane_ = (int)__builtin_amdgcn_mbcnt_hi(~0u, __builtin_amdgcn_mbcnt_lo(~0u, 0u)); asm volatile("" : "+v"(lane_));
    const int tid = wave_id * 64 + lane_, wid = __builtin_amdgcn_readfirstlane(tid >> 6), lane = tid & 63, wr = wid >> 2, wc = wid & 3, fr = lane & 15, fq = lane >> 4;
    const int K = g.K, nt = K / BK;
    unsigned voffA[2], voffB[2];
#pragma unroll
    for (int i = 0; i < 2; ++i) { int R, C; stage_rc(tid * 16 + i * 8192, R, C); const int Rb = Epi::PERM ? ((R & ~31) + perm32(R & 31)) : R;
        voffA[i] = (unsigned)(R * K + C) * 2u; voffB[i] = (unsigned)(Rb * K + C) * 2u; }
    const size_t kstep = (size_t)(BK * 2);
    const size_t rot = KROT ? (size_t)(nt / 2) * kstep : 0;
#define PG8_KO(t) (KROT ? (size_t)(((t) + nt / 2) & (nt - 1)) * kstep : (size_t)(t) * kstep)
    const size_t hstep = (size_t)HALF * K * 2;
    const size_t tstep = 2 * hstep;
    const unsigned ldsw = (unsigned)wid * 1024u;
    const int aoff = lds_byte(wr * 64 + fr, fq * 8), boff = lds_byte(wc * 32 + fr, fq * 8);
#define PG8_SA(b, h) (((b) * 2 + (h)) * HTB)
#define PG8_SB(b, h) ((4 + (b) * 2 + (h)) * HTB)
#define PG8_STAGE(bufoff, gbase, voff) do { _Pragma("unroll") for (int _i = 0; _i < 2; ++_i) \
        __builtin_amdgcn_global_load_lds((const unsigned*)((const char*)(gbase) + (voff)[_i]), (PG8_LAS unsigned*)(lds + (bufoff) + ldsw + _i * 8192), 16, 0, 0); } while (0)
#define PG8_LDA(dst, b, h) do { _Pragma("unroll") for (int m = 0; m < 4; ++m) _Pragma("unroll") for (int k = 0; k < 2; ++k) dst[m].ld(k, lds + PG8_SA(b, h) + aoff + m * 2048 + k * 1024); } while (0)
#define PG8_LDB(dst, b, h) do { _Pragma("unroll") for (int n = 0; n < 2; ++n) _Pragma("unroll") for (int k = 0; k < 2; ++k) dst[n].ld(k, lds + PG8_SB(b, h) + boff + n * 2048 + k * 1024); } while (0)
#define PG8_MMA(ai, bj, At, Bt) do { __builtin_amdgcn_s_setprio(1); _Pragma("unroll") for (int m = 0; m < 4; ++m) _Pragma("unroll") for (int n = 0; n < 2; ++n) { \
        if constexpr (F8) asm volatile("v_mfma_f32_16x16x128_f8f6f4 %0, %1, %2, %0" : "+v"(acc[ai][bj][m][n]) : "v"(Bt[n].v), "v"(At[m].v));         \
        else { _Pragma("unroll") for (int k = 0; k < 2; ++k) acc[ai][bj][m][n] = __builtin_amdgcn_mfma_f32_16x16x32_bf16(Bt[n].k[k], At[m].k[k], acc[ai][bj][m][n], 0, 0, 0); } } __builtin_amdgcn_s_setprio(0); } while (0)
#define PG8_WAIT_V(n) asm volatile("s_waitcnt vmcnt(" #n ")" ::: "memory")
#define PG8_WAIT_L(n) asm volatile("s_waitcnt lgkmcnt(" #n ")" ::: "memory")
#define PG8_BAR __builtin_amdgcn_s_barrier()
#define PG8_SCHED __builtin_amdgcn_sched_barrier(0)
    Unit cur, nxt; int ui = 0;
    if (!S.next(0, cur)) return;
    f32x4 acc[2][2][4][2];
#pragma unroll
    for (int a = 0; a < 2; ++a)
#pragma unroll
        for (int b = 0; b < 2; ++b)
#pragma unroll
            for (int m = 0; m < 4; ++m)
#pragma unroll
                for (int n = 0; n < 2; ++n) acc[a][b][m][n] = (f32x4){0.f, 0.f, 0.f, 0.f};
    Frag<F8> At[4], B0[2], B1[2];
    const char* cA = (const char*)g.A + (size_t)cur.pm * tstep; const char* cB = (const char*)g.Bt + (size_t)cur.pn * tstep;
    S.a_ready(cur);
    { typename Epi::Pre pre0; E.issue(cur, tid, pre0); E.finish(pre0, cur, 0, tid, lds); }
    if constexpr (SP2) {
        PG8_STAGE(PG8_SB(0, 0), cB + rot, voffB); PG8_STAGE(PG8_SB(0, 1), cB + rot + hstep, voffB); PG8_STAGE(PG8_SA(0, 0), cA + rot, voffA); PG8_STAGE(PG8_SA(0, 1), cA + rot + hstep, voffA);
        if (wr == 1) PG8_BAR;
        PG8_WAIT_V(2); PG8_BAR;
        PG8_STAGE(PG8_SB(1, 0), cB + rot + kstep, voffB); PG8_STAGE(PG8_SA(1, 0), cA + rot + kstep, voffA); PG8_STAGE(PG8_SB(1, 1), cB + rot + hstep + kstep, voffB);
        PG8_WAIT_V(6); PG8_BAR;
    } else {
        PG8_STAGE(PG8_SB(0, 0), cB, voffB); PG8_STAGE(PG8_SA(0, 0), cA, voffA); PG8_STAGE(PG8_SB(0, 1), cB + hstep, voffB); PG8_STAGE(PG8_SA(0, 1), cA + hstep, voffA);
        if (wr == 1) PG8_BAR;
        PG8_WAIT_V(4); PG8_BAR;
        PG8_STAGE(PG8_SB(1, 0), cB + kstep, voffB); PG8_STAGE(PG8_SA(1, 0), cA + kstep, voffA); PG8_STAGE(PG8_SB(1, 1), cB + hstep + kstep, voffB);
        PG8_WAIT_V(6); PG8_BAR;
    }
    for (;;) {
        const bool has_next = S.next(ui + 1, nxt);
        const char* nA = has_next ? (const char*)g.A + (size_t)nxt.pm * tstep : cA; const char* nB = has_next ? (const char*)g.Bt + (size_t)nxt.pn * tstep : cB;
        for (int t = 0; t < nt; t += 2) {
            const bool last = (t == nt - 2);
            const char* a1 = cA + PG8_KO(t + 1);
            const char* a2 = last ? nA + rot : cA + PG8_KO(t + 2); const char* b2 = last ? nB + rot : cB + PG8_KO(t + 2);
            const char* a3 = a2 + kstep; const char* b3 = b2 + kstep;
            if (last && has_next) S.a_ready(nxt);
            if constexpr (SP2) {
            PG8_LDB(B0, 0, 0); PG8_LDB(B1, 0, 1); PG8_SCHED; PG8_LDA(At, 0, 0); PG8_STAGE(PG8_SA(1, 1), a1 + hstep, voffA);
            PG8_WAIT_V(8); PG8_WAIT_L(0); PG8_BAR; PG8_MMA(0, 0, At, B0); PG8_MMA(0, 1, At, B1); PG8_BAR; PG8_SCHED;
            PG8_LDA(At, 0, 1); PG8_STAGE(PG8_SB(0, 0), b2, voffB); PG8_STAGE(PG8_SB(0, 1), b2 + hstep, voffB); PG8_STAGE(PG8_SA(0, 0), a2, voffA);
            PG8_WAIT_V(8); PG8_WAIT_L(0); PG8_BAR; PG8_MMA(1, 0, At, B0); PG8_MMA(1, 1, At, B1); PG8_BAR; PG8_SCHED;
            PG8_LDB(B0, 1, 0); PG8_LDB(B1, 1, 1); PG8_SCHED; PG8_LDA(At, 1, 0); PG8_STAGE(PG8_SA(0, 1), a2 + hstep, voffA);
            PG8_WAIT_V(8); PG8_WAIT_L(0); PG8_BAR; PG8_MMA(0, 0, At, B0); PG8_MMA(0, 1, At, B1); PG8_BAR; PG8_SCHED;
            PG8_LDA(At, 1, 1); PG8_STAGE(PG8_SB(1, 0), b3, voffB); PG8_STAGE(PG8_SB(1, 1), b3 + hstep, voffB); PG8_STAGE(PG8_SA(1, 0), a3, voffA);
            PG8_WAIT_V(8); PG8_WAIT_L(0); PG8_BAR; PG8_MMA(1, 0, At, B0); PG8_MMA(1, 1, At, B1); PG8_BAR; PG8_SCHED;
            } else {
            PG8_LDB(B0, 0, 0); PG8_SCHED; PG8_LDA(At, 0, 0); PG8_STAGE(PG8_SA(1, 1), a1 + hstep, voffA);
            PG8_WAIT_L(8); PG8_BAR; PG8_WAIT_L(0); PG8_MMA(0, 0, At, B0); PG8_BAR; PG8_SCHED;
            PG8_LDB(B1, 0, 1); PG8_STAGE(PG8_SB(0, 0), b2, voffB);
            PG8_BAR; PG8_WAIT_L(0); PG8_MMA(0, 1, At, B1); PG8_BAR;
            PG8_LDA(At, 0, 1); PG8_STAGE(PG8_SA(0, 0), a2, voffA);
            PG8_BAR; PG8_WAIT_L(0); PG8_MMA(1, 0, At, B0); PG8_BAR; PG8_SCHED;
            PG8_STAGE(PG8_SB(0, 1), b2 + hstep, voffB);
            PG8_WAIT_V(6); PG8_BAR; PG8_MMA(1, 1, At, B1); PG8_BAR;
            PG8_LDB(B0, 1, 0); PG8_SCHED; PG8_LDA(At, 1, 0); PG8_STAGE(PG8_SA(0, 1), a2 + hstep, voffA);
            PG8_WAIT_L(8); PG8_BAR; PG8_WAIT_L(0); PG8_MMA(0, 0, At, B0); PG8_BAR; PG8_SCHED;
            PG8_LDB(B1, 1, 1); PG8_STAGE(PG8_SB(1, 0), b3, voffB);
            PG8_BAR; PG8_WAIT_L(0); PG8_MMA(0, 1, At, B1); PG8_BAR;
            PG8_LDA(At, 1, 1); PG8_STAGE(PG8_SA(1, 0), a3, voffA);
            PG8_BAR; PG8_WAIT_L(0); PG8_MMA(1, 0, At, B0); PG8_BAR; PG8_SCHED;
            PG8_STAGE(PG8_SB(1, 1), b3 + hstep, voffB);
            PG8_WAIT_V(6); PG8_BAR; PG8_MMA(1, 1, At, B1); PG8_BAR;
            }
            if constexpr (KROT) { if (t == nt / 2 - 2) E.mid(acc, wr, fr, lds, ui & 1); }
        }
        if constexpr (ALIGN_EPI) { if (wr == 0) PG8_BAR; }
        if constexpr (F8) asm volatile("s_nop 15\n\ts_nop 15" ::: "memory");
        typename Epi::Pre pre;
        if (has_next) { E.issue(nxt, tid, pre); if constexpr (!Epi::SPLIT_PRE) E.finish(pre, nxt, (ui + 1) & 1, tid, lds); }
        if constexpr (!Epi::AFTER_DRAIN) { int le = lane; asm volatile("" : "+v"(le));
            E(acc, cur, wr, wc, le & 15, le >> 4, lds, ui & 1); S.done(cur); }
        if constexpr (Epi::SPLIT_PRE) { if (has_next) E.finish(pre, nxt, (ui + 1) & 1, tid, lds); }
        if (!has_next) break;
#pragma unroll
        for (int a = 0; a < 2; ++a)
#pragma unroll
            for (int b = 0; b < 2; ++b)
#pragma unroll
                for (int m = 0; m < 4; ++m)
#pragma unroll
                    for (int n = 0; n < 2; ++n) acc[a][b][m][n] = (f32x4){0.f, 0.f, 0.f, 0.f};
        cur = nxt; cA = nA; cB = nB; ++ui;
        if constexpr (ALIGN_EPI) { if (wr == 1) PG8_BAR; }
    }
    PG8_WAIT_V(0);
    if constexpr (!ALIGN_EPI) { if (wr == 0) PG8_BAR; }
    PG8_BAR;
    if constexpr (Epi::AFTER_DRAIN) { E.fused(acc, cur, wr, wc, fr, fq, lds, wid, lane); S.done(cur); }
#undef PG8_KO
#undef PG8_SA
#undef PG8_SB
#undef PG8_STAGE
#undef PG8_LDA
#undef PG8_LDB
#undef PG8_MMA
#undef PG8_WAIT_V
#undef PG8_WAIT_L
#undef PG8_BAR
#undef PG8_SCHED
}
}

#ifndef PG8_SP2
#define PG8_SP2 true
#endif
#ifndef PG8_ALIGN
#define PG8_ALIGN true
#endif
constexpr int NWAVES = 8;
#ifndef MK_PER_PHASE
#define MK_PER_PHASE 0
#endif
constexpr int D_MODEL = 2048, BATCH = 8, SEQ = 2048, DEPTH = 2, M = BATCH * SEQ;
constexpr int NCMP = 127, NSEL = 32, TOPK = 16, WINDOW = 512;
constexpr int D_FF = 5632, N_IN = 6696, ZW = 6912;
constexpr float NORM_EPS = 1e-6f;
constexpr int ZC_MQ = 0, ZC_MK = 1024, ZC_MV = 2048, ZC_MO = 3072, ZC_NQ = 4096, ZC_KC = 5120, ZC_VC = 5376, ZC_KS = 5632, ZC_VS = 5888, ZC_KW = 6144, ZC_VW = 6400, ZC_MI = 6656, ZC_MF = 6664, ZC_NG = 6672;
__host__ __device__ __forceinline__ int colmap_in(int nd) {
    if (nd < 4096) return nd; if (nd < 6656) return nd + 16; if (nd < 6672) return nd - 2560; if (nd < N_IN) return nd; return -1; }
constexpr int PH_PER_LAYER = 11, N_PHASES = DEPTH * PH_PER_LAYER + 1;

constexpr size_t MiB = 1u << 20;
constexpr size_t WS_CTL = 0, CTL_ZERO_BYTES = 1 * MiB;
constexpr size_t WS_ROPE = 1 * MiB;
constexpr size_t WS_SSQ = WS_ROPE + 512 * 1024;
constexpr size_t WS_PBP = WS_ROPE + 640 * 1024, WS_PB = WS_ROPE + 768 * 1024;
constexpr size_t WS_WIN = 2 * MiB, WS_WOUT = 29 * MiB, WS_WUP = 37 * MiB, WS_WDN = 81 * MiB;
constexpr size_t WS_C1K = 103 * MiB, WS_C1V = 105 * MiB, WS_C2K = 107 * MiB, WS_C2V = 107 * MiB + 512 * 1024;
constexpr size_t WS_XN = 108 * MiB;
constexpr size_t WS_Z = 172 * MiB;
constexpr size_t WS_MIX = 388 * MiB;
constexpr size_t WS_KCMP = 452 * MiB, WS_VCMP = 453 * MiB;
constexpr size_t WS_OACC = 456 * MiB;
constexpr size_t WS_VTS = 520 * MiB, WS_VTW = 528 * MiB;
constexpr size_t WS_G = 172 * MiB;
constexpr size_t WS_EDGE = 348 * MiB;
constexpr size_t WS_L1 = 540 * MiB;
constexpr size_t WS_PBP1 = WS_L1 + 107 * MiB;
constexpr size_t WS_SSQP = 536 * MiB;
constexpr size_t WS_XR = 576 * MiB;
constexpr size_t WS_END = 700 * MiB;
constexpr int CW_BAR = 4096;
constexpr int CW_PB = 16384;

constexpr int RING_OFF = 0, RING_BYTES = 135168;
constexpr int LDSCTL_OFF = RING_BYTES, MISC_OFF = LDSCTL_OFF + 320;
constexpr int LDS_BYTES = 147456;

#define GAS __attribute__((address_space(1)))
#define LAS __attribute__((address_space(3)))
typedef unsigned short bf16;
typedef unsigned v4u __attribute__((ext_vector_type(4)));
typedef float f32x4 __attribute__((ext_vector_type(4)));
typedef short bf16x8 __attribute__((ext_vector_type(8)));
typedef GAS unsigned gu32;
#define RLX_AGENT __ATOMIC_RELAXED, __HIP_MEMORY_SCOPE_AGENT
#define LDS_WAIT() asm volatile("s_waitcnt lgkmcnt(0)" ::: "memory")
#define VM_WAIT() asm volatile("s_waitcnt vmcnt(0)" ::: "memory")
__device__ __forceinline__ unsigned f2bf(float f) { unsigned u = __builtin_bit_cast(unsigned, f); return (u + 0x7fffu + ((u >> 16) & 1u)) >> 16; }
__device__ __forceinline__ unsigned pk2(float lo, float hi) { return f2bf(lo) | (f2bf(hi) << 16); }
typedef float f32x2t_ __attribute__((ext_vector_type(2)));
typedef __bf16 bf16x2t_ __attribute__((ext_vector_type(2)));
__device__ __forceinline__ unsigned cvtpk(float lo, float hi) { const f32x2t_ v = {lo, hi}; return __builtin_bit_cast(unsigned, __builtin_convertvector(v, bf16x2t_)); }
__device__ __forceinline__ float bf2f(bf16 v) { return __builtin_bit_cast(float, (unsigned)v << 16); }
__device__ __forceinline__ float sigmoidf_(float x) { return __builtin_amdgcn_rcpf(1.f + __builtin_amdgcn_exp2f(-1.4426950408889634f * x)); }
__device__ __forceinline__ float siluf_(float x) { return x * __builtin_amdgcn_rcpf(1.f + __builtin_amdgcn_exp2f(-1.4426950408889634f * x)); }
__device__ __forceinline__ float gelu_tanh(float x) { const float u = 0.7978845608028654f * (x + 0.044715f * x * x * x); return 0.5f * x * (1.f + tanhf(u)); }
__device__ __forceinline__ float logsigmoidf_(float x) { return fminf(x, 0.f) - log1pf(__expf(-fabsf(x))); }
#define DPP_F(v, ctrl) __builtin_bit_cast(float, __builtin_amdgcn_update_dpp(0, __builtin_bit_cast(int, (v)), (ctrl), 0xf, 0xf, true))
#define DPP_F_ID(idv, v, ctrl, rmask) __builtin_bit_cast(float, __builtin_amdgcn_update_dpp(__builtin_bit_cast(int, (idv)), __builtin_bit_cast(int, (v)), (ctrl), (rmask), 0xf, false))
__device__ __forceinline__ float xor16_f(float v) { return __builtin_bit_cast(float, __builtin_amdgcn_ds_swizzle(__builtin_bit_cast(int, v), 0x401F)); }
__device__ __forceinline__ float swap32_other(float v) { auto rr = __builtin_amdgcn_permlane32_swap(__float_as_uint(v), __float_as_uint(v), false, false);
    return (__builtin_amdgcn_mbcnt_hi(~0u, __builtin_amdgcn_mbcnt_lo(~0u, 0u)) & 32u) ? __uint_as_float(rr[0]) : __uint_as_float(rr[1]); }
__device__ __forceinline__ float wave_sum(float v) {
    v += DPP_F(v, 0xB1); v += DPP_F(v, 0x4E); v += DPP_F(v, 0x124); v += DPP_F(v, 0x128);
    v += xor16_f(v);
    auto rr = __builtin_amdgcn_permlane32_swap(__float_as_uint(v), __float_as_uint(v), false, false); return __uint_as_float(rr[0]) + __uint_as_float(rr[1]);
}
__device__ __forceinline__ float wave_max(float v) {
    v = fmaxf(v, DPP_F(v, 0xB1)); v = fmaxf(v, DPP_F(v, 0x4E)); v = fmaxf(v, DPP_F(v, 0x124)); v = fmaxf(v, DPP_F(v, 0x128));
    v = fmaxf(v, xor16_f(v));
    auto rr = __builtin_amdgcn_permlane32_swap(__float_as_uint(v), __float_as_uint(v), false, false); return fmaxf(__uint_as_float(rr[0]), __uint_as_float(rr[1]));
}
__device__ __forceinline__ float q4_sum(float v) {
    v += xor16_f(v);
    auto rr = __builtin_amdgcn_permlane32_swap(__float_as_uint(v), __float_as_uint(v), false, false); return __uint_as_float(rr[0]) + __uint_as_float(rr[1]);
}
__device__ __forceinline__ float scan_sum(float v) {
    v += DPP_F_ID(0.f, v, 0x111, 0xf); v += DPP_F_ID(0.f, v, 0x112, 0xf); v += DPP_F_ID(0.f, v, 0x114, 0xf); v += DPP_F_ID(0.f, v, 0x118, 0xf);
    v += DPP_F_ID(0.f, v, 0x142, 0xa); v += DPP_F_ID(0.f, v, 0x143, 0xc); return v;
}
__device__ __forceinline__ float scan_max(float v) {
    const float ninf = -3.0e38f;
    v = fmaxf(v, DPP_F_ID(ninf, v, 0x111, 0xf)); v = fmaxf(v, DPP_F_ID(ninf, v, 0x112, 0xf)); v = fmaxf(v, DPP_F_ID(ninf, v, 0x114, 0xf)); v = fmaxf(v, DPP_F_ID(ninf, v, 0x118, 0xf));
    v = fmaxf(v, DPP_F_ID(ninf, v, 0x142, 0xa)); v = fmaxf(v, DPP_F_ID(ninf, v, 0x143, 0xc)); return v;
}
__device__ __forceinline__ float lane63(float v) { return __builtin_bit_cast(float, __builtin_amdgcn_readlane(__builtin_bit_cast(int, v), 63)); }

#define XB_TMO      128
#define XB_XCNT(j)  (256  + 64 * (j))
#define XB_XSUB(j)  (1280 + 64 * (j))
#define XB_XGEN(j)  (2304 + 64 * (j))
#define XB_TOP      3328
#define XB_TOPGEN   3392
#define XCD_BAR_WORDS 3456
#define XB_SPIN_CAP (1u << 22)

__device__ __forceinline__ unsigned xb_ld(unsigned* p)              { return __hip_atomic_load(p, __ATOMIC_RELAXED, __HIP_MEMORY_SCOPE_AGENT); }
__device__ __forceinline__ unsigned xb_add(unsigned* p, unsigned v) { return __hip_atomic_fetch_add(p, v, __ATOMIC_RELAXED, __HIP_MEMORY_SCOPE_AGENT); }
__device__ __forceinline__ unsigned xb_xcc_id() { return (unsigned)__builtin_amdgcn_s_getreg((3 << 11) | 20) & 0xFu; }
#define XB_SPIN(cond, bar) do { unsigned _sp = 0; while (cond) { __builtin_amdgcn_s_sleep(1); \
    if ((++_sp & 255u) == 0u) { if (xb_ld(&(bar)[XB_TMO])) break; if (_sp > XB_SPIN_CAP) { atomicAdd(&(bar)[XB_TMO], 1u); break; } } } } while (0)

struct XcdBarrier {
    unsigned* bar; unsigned x;
    volatile LAS unsigned* st;
};
__device__ __forceinline__ XcdBarrier xcd_barrier_post(unsigned* bar, volatile LAS unsigned* st) {
    XcdBarrier b; b.bar = bar; b.x = xb_xcc_id(); b.st = st;
    if (threadIdx.x == 0) (void)xb_add(&bar[XB_XCNT(b.x)], 1u);
    return b;
}
__device__ __forceinline__ void xcd_barrier_complete(unsigned* bar, unsigned x, unsigned& nloc, unsigned& nx) {
    const unsigned G = gridDim.x * gridDim.y * gridDim.z;
    unsigned sum, cnt, mine, sp = 0u;
    for (;;) {
        sum = 0u; cnt = 0u; mine = 0u;
#pragma unroll
        for (unsigned j = 0; j < 16; ++j) { const unsigned c = xb_ld(&bar[XB_XCNT(j)]); sum += c; cnt += (c > 0u) ? 1u : 0u; mine = (j == x) ? c : mine; }
        if (sum == G) break;
        __builtin_amdgcn_s_sleep(1);
        if ((++sp & 255u) == 0u) { if (xb_ld(&bar[XB_TMO])) break; if (sp > XB_SPIN_CAP) { atomicAdd(&bar[XB_TMO], 1u); break; } }
    }
    nloc = mine > 0u ? mine : 1u; nx = cnt > 0u ? cnt : 1u;
}
__device__ __attribute__((noinline)) void xcd_barrier_fn(unsigned* bar, unsigned lds_st, int tid0) {
    volatile LAS unsigned* st = (volatile LAS unsigned*)lds_st;
    asm volatile("s_waitcnt vmcnt(0)" ::: "memory");
    __syncthreads();
    if (tid0) {
        const unsigned bx = xb_xcc_id();
        __builtin_amdgcn_s_waitcnt(0);
        unsigned nloc = st[0], nx = st[1];
        if (nloc == 0u) { xcd_barrier_complete(bar, bx, nloc, nx); st[0] = nloc; st[1] = nx; }
        const unsigned old = xb_add(&bar[XB_XSUB(bx)], 1u);
        const unsigned gen = old / nloc;
        if (old + 1u == (gen + 1u) * nloc) {
            __builtin_amdgcn_fence(__ATOMIC_RELEASE, "agent");
            asm volatile("s_waitcnt vmcnt(0)" ::: "memory");
            const unsigned og = xb_add(&bar[XB_TOP], 1u);
            const unsigned tg = og / nx;
            if (og + 1u == (tg + 1u) * nx) xb_add(&bar[XB_TOPGEN], 1u);
            else XB_SPIN(xb_ld(&bar[XB_TOPGEN]) == tg, bar);
            __builtin_amdgcn_fence(__ATOMIC_ACQUIRE, "agent");
            xb_add(&bar[XB_XGEN(bx)], 1u);
            asm volatile("s_waitcnt vmcnt(0)" ::: "memory");
        } else {
            XB_SPIN(xb_ld(&bar[XB_XGEN(bx)]) == gen, bar);
            __builtin_amdgcn_fence(__ATOMIC_ACQUIRE, "agent");
            asm volatile("s_waitcnt vmcnt(0)" ::: "memory");
        }
    }
    __syncthreads();
}

struct Frame {
    LAS unsigned char* lds;
    volatile LAS unsigned* MISC;
    gu32* ctl;
    int tid, lane, wave;
    int bid, G;
    unsigned char* ws; float* out;
};
constexpr int PT_OFF = MISC_OFF + 256;
__device__ __forceinline__ const float* inptr(const Frame& F, int k) {
    const LAS unsigned* p = (const LAS unsigned*)(F.lds + PT_OFF) + 2 * k;
    const unsigned lo = p[0], hi = p[1];
    return (const float*)(((unsigned long long)hi << 32) | lo);
}

template <bool ACC>
__device__ __forceinline__ void lds_gemm(LAS float* C, int ldc, const LAS bf16* A, int lda, const LAS bf16* Bt, int ldb, int Mt, int Nt, int K, int wave, int lane) {
    const int tn = Nt >> 4, nt = (Mt >> 4) * tn;
    for (int t = wave; t < nt; t += NWAVES) {
        const int i = t / tn, j = t - i * tn;
        f32x4 acc = {0.f, 0.f, 0.f, 0.f};
        const LAS bf16* ap = A + (i * 16 + (lane & 15)) * lda + 8 * (lane >> 4);
        const LAS bf16* bp = Bt + (j * 16 + (lane & 15)) * ldb + 8 * (lane >> 4);
        for (int k0 = 0; k0 < K; k0 += 32) {
            const bf16x8 a = *(const LAS bf16x8*)(ap + k0), b = *(const LAS bf16x8*)(bp + k0);
            acc = __builtin_amdgcn_mfma_f32_16x16x32_bf16(a, b, acc, 0, 0, 0);
        }
        LAS float* cp = C + (i * 16 + 4 * (lane >> 4)) * ldc + j * 16 + (lane & 15);
#pragma unroll
        for (int r = 0; r < 4; ++r) cp[r * ldc] = (ACC ? cp[r * ldc] : 0.f) + acc[r];
    }
}

template <int MODE>
__device__ __forceinline__ void transpose_item(const float* W, int K, int Nsrc, int Ndst, bf16* WT, int item, int lane, const float* kg = nullptr) {
    asm volatile("" : "+v"(lane));
    const int nblk = Ndst / 64, kb = item / nblk, nb = item - kb * nblk, k0 = 64 * kb + 16 * (lane >> 4), n0 = 64 * nb + 4 * (lane & 15);
    const int ns = MODE == 1 ? colmap_in(n0) : (MODE == 2 ? ((n0 >> 7) & 1) * D_FF + (n0 >> 8) * 128 + (n0 & 127) : n0);
    f32x4 v[16];
    if (ns >= 0) { const float* p = W + (size_t)k0 * Nsrc + ns;
#pragma unroll
        for (int i = 0; i < 16; ++i) v[i] = *(const GAS f32x4*)(p + (size_t)i * Nsrc); }
    else {
#pragma unroll
        for (int i = 0; i < 16; ++i) v[i] = (f32x4){0.f, 0.f, 0.f, 0.f}; }
    if (kg != nullptr) {
#pragma unroll
        for (int i = 0; i < 4; ++i) { const f32x4 g4 = *(const GAS f32x4*)(kg + k0 + 4 * i);
#pragma unroll
            for (int j = 0; j < 4; ++j) v[4 * i + j] = v[4 * i + j] * g4[j]; } }
    if constexpr (MODE == 3) {
#pragma unroll
        for (int j = 0; j < 4; ++j) { unsigned char* o = (unsigned char*)WT + (size_t)(n0 + j) * K + k0; constexpr float s = pg8::F8_WS;
            *(GAS v4u*)o = (v4u){pg8::pk4_fp8(v[0][j] * s, v[1][j] * s, v[2][j] * s, v[3][j] * s), pg8::pk4_fp8(v[4][j] * s, v[5][j] * s, v[6][j] * s, v[7][j] * s),
                                 pg8::pk4_fp8(v[8][j] * s, v[9][j] * s, v[10][j] * s, v[11][j] * s), pg8::pk4_fp8(v[12][j] * s, v[13][j] * s, v[14][j] * s, v[15][j] * s)}; }
        return; }
#pragma unroll
    for (int j = 0; j < 4; ++j) { bf16* o = MODE == 4 ? WT + (size_t)(k0 >> 7) * (Ndst * 128) + (n0 + j) * 128 + (k0 & 127) : WT + (size_t)(n0 + j) * K + k0;
        *(GAS v4u*)o = (v4u){cvtpk(v[0][j], v[1][j]), cvtpk(v[2][j], v[3][j]), cvtpk(v[4][j], v[5][j]), cvtpk(v[6][j], v[7][j])};
        *(GAS v4u*)(o + 8) = (v4u){cvtpk(v[8][j], v[9][j]), cvtpk(v[10][j], v[11][j]), cvtpk(v[12][j], v[13][j]), cvtpk(v[14][j], v[15][j])}; }
}
__device__ __forceinline__ void rms_row_to_bf16(const float* xrow, const float* gain, bf16* orow, int lane) {
    const GAS f32x4* xr = (const GAS f32x4*)xrow + lane; const GAS f32x4* gr = (const GAS f32x4*)gain + lane;
    f32x4 v[8]; float s = 0.f;
#pragma unroll
    for (int j = 0; j < 8; ++j) { v[j] = xr[64 * j]; s += (v[j].x * v[j].x + v[j].y * v[j].y) + (v[j].z * v[j].z + v[j].w * v[j].w); }
    const float rstd = 1.f / sqrtf(wave_sum(s) * (1.f / D_MODEL) + NORM_EPS);
    GAS unsigned long long* o8 = (GAS unsigned long long*)orow + lane;
#pragma unroll
    for (int j = 0; j < 8; ++j) { const f32x4 g = gr[64 * j];
        o8[64 * j] = (unsigned long long)pk2(v[j].x * rstd * g.x, v[j].y * rstd * g.y) | ((unsigned long long)pk2(v[j].z * rstd * g.z, v[j].w * rstd * g.w) << 32); }
}
__device__ __forceinline__ void rms_brow_to_bf16(const bf16* xrow, const float* gain, bf16* orow, int lane) {
    const GAS v4u* xr = (const GAS v4u*)xrow + lane; v4u v[4]; float s = 0.f;
#pragma unroll
    for (int j = 0; j < 4; ++j) { v[j] = xr[64 * j]; const unsigned w[4] = {v[j].x, v[j].y, v[j].z, v[j].w};
#pragma unroll
        for (int i = 0; i < 4; ++i) { const float a = __builtin_bit_cast(float, w[i] << 16), b = __builtin_bit_cast(float, w[i] & 0xffff0000u); s += a * a + b * b; } }
    const float rstd = 1.f / sqrtf(wave_sum(s) * (1.f / D_MODEL) + NORM_EPS);
    GAS v4u* o = (GAS v4u*)orow + lane;
#pragma unroll
    for (int j = 0; j < 4; ++j) { const unsigned w[4] = {v[j].x, v[j].y, v[j].z, v[j].w}; const float* g = gain + 8 * (lane + 64 * j);
        const f32x4 g0 = *(const GAS f32x4*)g, g1 = *(const GAS f32x4*)(g + 4); const float gg[8] = {g0[0], g0[1], g0[2], g0[3], g1[0], g1[1], g1[2], g1[3]};
        unsigned ow[4];
#pragma unroll
        for (int i = 0; i < 4; ++i) ow[i] = cvtpk(__builtin_bit_cast(float, w[i] << 16) * rstd * gg[2 * i], __builtin_bit_cast(float, w[i] & 0xffff0000u) * rstd * gg[2 * i + 1]);
        o[64 * j] = (v4u){ow[0], ow[1], ow[2], ow[3]}; }
}
__device__ __forceinline__ void rms_brow_to_f32(const bf16* xrow, const float* gain, float* orow, int lane) {
    const GAS v4u* xr = (const GAS v4u*)xrow + lane; v4u v[4]; float s = 0.f;
#pragma unroll
    for (int j = 0; j < 4; ++j) { v[j] = xr[64 * j]; const unsigned w[4] = {v[j].x, v[j].y, v[j].z, v[j].w};
#pragma unroll
        for (int i = 0; i < 4; ++i) { const float a = __builtin_bit_cast(float, w[i] << 16), b = __builtin_bit_cast(float, w[i] & 0xffff0000u); s += a * a + b * b; } }
    const float rstd = 1.f / sqrtf(wave_sum(s) * (1.f / D_MODEL) + NORM_EPS);
#pragma unroll
    for (int j = 0; j < 4; ++j) { const unsigned w[4] = {v[j].x, v[j].y, v[j].z, v[j].w}; const float* g = gain + 8 * (lane + 64 * j); float* o = orow + 8 * (lane + 64 * j);
        const f32x4 g0 = *(const GAS f32x4*)g, g1 = *(const GAS f32x4*)(g + 4);
        *(GAS f32x4*)o = (f32x4){__builtin_bit_cast(float, w[0] << 16) * rstd * g0[0], __builtin_bit_cast(float, w[0] & 0xffff0000u) * rstd * g0[1], __builtin_bit_cast(float, w[1] << 16) * rstd * g0[2], __builtin_bit_cast(float, w[1] & 0xffff0000u) * rstd * g0[3]};
        *(GAS f32x4*)(o + 4) = (f32x4){__builtin_bit_cast(float, w[2] << 16) * rstd * g1[0], __builtin_bit_cast(float, w[2] & 0xffff0000u) * rstd * g1[1], __builtin_bit_cast(float, w[3] << 16) * rstd * g1[2], __builtin_bit_cast(float, w[3] & 0xffff0000u) * rstd * g1[3]}; }
}
__device__ __forceinline__ void rms_row_to_f32(const float* xrow, const float* gain, float* orow, int lane) {
    const GAS f32x4* xr = (const GAS f32x4*)xrow + lane; const GAS f32x4* gr = (const GAS f32x4*)gain + lane;
    f32x4 v[8]; float s = 0.f;
#pragma unroll
    for (int j = 0; j < 8; ++j) { v[j] = xr[64 * j]; s += (v[j].x * v[j].x + v[j].y * v[j].y) + (v[j].z * v[j].z + v[j].w * v[j].w); }
    const float rstd = 1.f / sqrtf(wave_sum(s) * (1.f / D_MODEL) + NORM_EPS);
    GAS f32x4* o = (GAS f32x4*)orow + lane;
#pragma unroll
    for (int j = 0; j < 8; ++j) { const f32x4 g = gr[64 * j]; o[64 * j] = v[j] * rstd * g; }
}

struct LayerPtrs {
    const float *attn_norm, *w_in, *qk_conv_w, *qk_conv_b, *i_bias, *f_bias, *mlstm_norm, *pe_k, *pe_v, *w1_k, *w2_k, *w1_v, *w2_v, *nsa_norm, *w_out, *ffn_norm, *w_up, *ffn_conv_w, *ffn_conv_b, *w_down;
};
struct WsPtrs {
    float *ropec, *ropes, *ssq, *oacc, *pbp, *ssqp;
    bf16 *win, *wout, *wup, *wdn, *c1k, *c1v, *c2k, *c2v, *xn, *z, *mix, *kcmp, *vcmpt, *vts, *vtw, *u, *g, *xr;
};

__device__ __forceinline__ LayerPtrs make_L(const Frame& F, int layer) {
    LayerPtrs L;
    L.attn_norm = inptr(F, 1) + (size_t)layer * D_MODEL; L.w_in = inptr(F, 2) + (size_t)layer * D_MODEL * N_IN;
    L.qk_conv_w = inptr(F, 3) + (size_t)layer * 4 * 2048; L.qk_conv_b = inptr(F, 4) + (size_t)layer * 2048;
    L.i_bias = inptr(F, 5) + layer * 8; L.f_bias = inptr(F, 6) + layer * 8; L.mlstm_norm = inptr(F, 7) + layer * 1024;
    L.pe_k = inptr(F, 8) + layer * 32 * 128; L.pe_v = inptr(F, 9) + layer * 32 * 128;
    L.w1_k = inptr(F, 10) + (size_t)layer * 4096 * 256; L.w2_k = inptr(F, 11) + (size_t)layer * 256 * 128;
    L.w1_v = inptr(F, 12) + (size_t)layer * 4096 * 256; L.w2_v = inptr(F, 13) + (size_t)layer * 256 * 128;
    L.nsa_norm = inptr(F, 14) + layer * 1024; L.w_out = inptr(F, 15) + (size_t)layer * D_MODEL * D_MODEL;
    L.ffn_norm = inptr(F, 16) + (size_t)layer * D_MODEL; L.w_up = inptr(F, 17) + (size_t)layer * D_MODEL * 2 * D_FF;
    L.ffn_conv_w = inptr(F, 18) + (size_t)layer * 3 * 2 * D_FF; L.ffn_conv_b = inptr(F, 19) + (size_t)layer * 2 * D_FF;
    L.w_down = inptr(F, 20) + (size_t)layer * D_FF * D_MODEL;
    return L;
}
__device__ __forceinline__ WsPtrs make_W(const Frame& F, int layer = 0) {
    const unsigned long long wsu = (unsigned long long)F.ws;
    unsigned wlo = __builtin_amdgcn_readfirstlane((unsigned)wsu), whi = __builtin_amdgcn_readfirstlane((unsigned)(wsu >> 32));
    asm volatile("" : "+s"(wlo), "+s"(whi));
    unsigned char* ws = (unsigned char*)(((unsigned long long)whi << 32) | wlo);
    WsPtrs W;
    W.ropec = (float*)(ws + WS_ROPE); W.ropes = W.ropec + SEQ * 16; W.ssq = (float*)(ws + 454 * MiB);     W.oacc = (float*)(ws + WS_OACC); W.ssqp = (float*)(ws + WS_SSQP);
    const size_t lo_ = layer ? (WS_L1 - WS_WIN) : 0; W.pbp = (float*)(ws + (layer ? WS_PBP1 : WS_PBP));
    W.win = (bf16*)(ws + WS_WIN + lo_); W.wout = (bf16*)(ws + WS_WOUT + lo_); W.wup = (bf16*)(ws + WS_WUP); W.wdn = (bf16*)(ws + WS_WDN);
    W.c1k = (bf16*)(ws + WS_C1K + lo_); W.c1v = (bf16*)(ws + WS_C1V + lo_); W.c2k = (bf16*)(ws + WS_C2K + lo_); W.c2v = (bf16*)(ws + WS_C2V + lo_);
    W.xn = (bf16*)(ws + WS_XN); W.z = (bf16*)(ws + WS_Z); W.mix = (bf16*)(ws + WS_MIX); W.kcmp = (bf16*)(ws + WS_KCMP); W.vcmpt = (bf16*)(ws + WS_VCMP); W.vts = (bf16*)(ws + WS_VTS); W.vtw = (bf16*)(ws + WS_VTW);
    W.u = (bf16*)(ws + WS_EDGE); W.xr = (bf16*)(ws + WS_XR); W.g = (bf16*)(ws + WS_G);
    return W;
}
constexpr int I_IN = (D_MODEL / 64) * (ZW / 64), I_OUT = (D_MODEL / 64) * (D_MODEL / 64), I_C1 = (4096 / 64) * (256 / 64), I_C2 = (256 / 64) * (128 / 64);
constexpr int NSMALL = I_IN + I_OUT + 2 * I_C1 + 2 * I_C2 + 512;
static_assert(NSMALL % 8 == 0, "small conversion items");
__device__ __forceinline__ void small_item(Frame& F, const LayerPtrs& L, const WsPtrs& W, int r, bool fold) {
    if (r < I_IN) { transpose_item<1>(L.w_in, D_MODEL, N_IN, ZW, W.win, r, F.lane, fold ? L.attn_norm : nullptr); return; } r -= I_IN;
    if (r < I_OUT) { transpose_item<0>(L.w_out, D_MODEL, D_MODEL, D_MODEL, W.wout, r, F.lane, r / (D_MODEL / 64) >= 16 ? L.nsa_norm - 1024 : nullptr); return; } r -= I_OUT;
    if (r < I_C1) { transpose_item<4>(L.w1_k, 4096, 256, 256, W.c1k, r, F.lane); return; } r -= I_C1;
    if (r < I_C1) { transpose_item<4>(L.w1_v, 4096, 256, 256, W.c1v, r, F.lane); return; } r -= I_C1;
    if (r < I_C2) { transpose_item<0>(L.w2_k, 256, 128, 128, W.c2k, r, F.lane); return; } r -= I_C2;
    if (r < I_C2) { transpose_item<0>(L.w2_v, 256, 128, 128, W.c2v, r, F.lane); return; } r -= I_C2;
    {
        const int br = r >> 8, cg = (r >> 6) & 3, kp = r & 63, col = 64 * cg + F.lane;
        const float* w1 = (br ? L.w1_v : L.w1_k) + (size_t)(64 * kp) * 256 + col; const float* pe = (br ? L.pe_v : L.pe_k) + 64 * kp;
        float a = 0.f;
#pragma unroll 16
        for (int i = 0; i < 64; ++i) a += pe[i] * w1[(size_t)i * 256];
        W.pbp[(br * 64 + kp) * 256 + col] = a;
    }
}
__device__ __forceinline__ void ph_prologue(Frame& F, const LayerPtrs& L, const WsPtrs& W, const float* xin, int layer) {
    const int gw = F.bid * NWAVES + F.wave, NGW = F.G * NWAVES;
    if (layer == 0) for (int it = gw; it < NSMALL; it += NGW) small_item(F, L, W, it, false);
    if (layer == 0) for (int i = F.bid * 512 + F.tid; i < SEQ * 16; i += F.G * 512) {
        const int pos = i >> 4, k = i & 15;
        const float inv = powf(500000.0f, -(float)(2 * k) / 32.0f);
        const float ang = (float)pos * inv;
        const double rev = (double)ang * 0.15915494309189535;
        const float fr = (float)(rev - floor(rev));
        W.ropec[i] = __builtin_amdgcn_cosf(fr); W.ropes[i] = __builtin_amdgcn_sinf(fr);
    }
    if (layer == 0) { for (int m = gw; m < M; m += NGW) rms_row_to_bf16(xin + (size_t)m * D_MODEL, L.attn_norm, W.xn + (size_t)m * D_MODEL, F.lane); }
    else { for (int m = gw; m < M; m += NGW) rms_brow_to_bf16(W.xr + (size_t)m * D_MODEL, L.attn_norm, W.xn + (size_t)m * D_MODEL, F.lane); }
}

__device__ __forceinline__ void ph_rope(Frame& F, const WsPtrs& W) {
    const size_t total = (size_t)M * 224;
    for (size_t i = (size_t)F.bid * 512 + F.tid; i < total; i += (size_t)F.G * 512) {
        const int m = (int)(i / 224), r = (int)(i - (size_t)m * 224), slot = r >> 4, k = r & 15;
        const int col = slot < 8 ? ZC_NQ + slot * 128 : (slot < 10 ? ZC_KC + (slot - 8) * 128 : (slot < 12 ? ZC_KS + (slot - 10) * 128 : ZC_KW + (slot - 12) * 128));
        const int pos = m & (SEQ - 1);
        const float c = W.ropec[pos * 16 + k], s = W.ropes[pos * 16 + k];
        bf16* p = W.z + (size_t)m * ZW + col + k;
        const float x1 = bf2f(p[0]), x2 = bf2f(p[16]);
        p[0] = (bf16)f2bf(x1 * c - x2 * s); p[16] = (bf16)f2bf(x2 * c + x1 * s);
    }
}

constexpr int M2_QB = 0, M2_KB = 17408, M2_KT = 34816, M2_VT = 53248, M2_PL = 71680, M2_SC = 80896;
__device__ __forceinline__ void mlstm2_unit(Frame& F, const LayerPtrs& L, const WsPtrs& W, int b, int hd) {
    LAS bf16* QB = (LAS bf16*)(F.lds + M2_QB);
    LAS bf16* KB = (LAS bf16*)(F.lds + M2_KB);
    LAS bf16* KT = (LAS bf16*)(F.lds + M2_KT);
    LAS bf16* VT = (LAS bf16*)(F.lds + M2_VT);
    LAS bf16* PL = (LAS bf16*)(F.lds + M2_PL);
    LAS float* SC = (LAS float*)(F.lds + M2_SC);
    LAS float *colf = SC, *rowf = SC + 64, *wi = SC + 128, *emt = SC + 192, *wkv = SC + 256, *nvec = SC + 320, *ssp = SC + 448, *ms = SC + 960, *dinv = SC + 2304;
    int lane_ = F.lane; asm volatile("" : "+v"(lane_));
    const int lane = lane_, wave = F.wave, tid = wave * 64 + lane, r = lane & 15, q4 = lane >> 4;
    const int d2 = tid & 63, sg = wave, dA = 2 * d2;
    const int coff = hd * 128 + dA;
    LAS float* CWL = SC + 1024;
    for (int e = tid; e < 10 * 128; e += 512) { const int k = e >> 7, d = e & 127, cq = hd * 128 + d;
        CWL[e] = k < 4 ? L.qk_conv_w[k * 2048 + cq] : (k < 8 ? L.qk_conv_w[(k - 4) * 2048 + 1024 + cq] : (k == 8 ? L.qk_conv_b[cq] : L.qk_conv_b[1024 + cq])); }
    const f32x4 gain = *(const GAS f32x4*)(L.mlstm_norm + hd * 128 + 16 * wave + 4 * q4);
    const float ibias = L.i_bias[hd], fbias = L.f_bias[hd];
    f32x4 cacc[8];
#pragma unroll
    for (int i = 0; i < 8; ++i) cacc[i] = (f32x4){0.f, 0.f, 0.f, 0.f};
    float nreg = 0.f;
    if (tid < 128) nvec[tid] = 0.f;
    if (tid == 0) ms[0] = 0.f;
    const bf16* zb = W.z + (size_t)b * SEQ * ZW;
    unsigned qraw[11], kraw[11], vraw[8]; bf16 graw0 = 0, graw1 = 0;
#pragma unroll
    for (int k = 0; k < 11; ++k) { const int t = 8 * sg - 3 + k;
        const bf16* rp = zb + (ptrdiff_t)(t >= 0 ? t : 0) * ZW;
        qraw[k] = t >= 0 ? *(const GAS unsigned*)(rp + ZC_MQ + coff) : 0u; kraw[k] = t >= 0 ? *(const GAS unsigned*)(rp + ZC_MK + coff) : 0u; }
#pragma unroll
    for (int k = 0; k < 8; ++k) { const bf16* rp = zb + (size_t)(8 * sg + k) * ZW; vraw[k] = *(const GAS unsigned*)(rp + ZC_MV + coff); }
    if (wave == 0) { graw0 = zb[(size_t)lane * ZW + ZC_MI + hd]; graw1 = zb[(size_t)lane * ZW + ZC_MF + hd]; }
    __syncthreads();
    for (int c = 0; c < SEQ / 64; ++c) {
        const int t0 = c * 64; const size_t row0 = (size_t)b * SEQ + t0;
        {
            unsigned kt0[4], kt1[4], vt0[4], vt1[4];
            typedef float f32x2_ __attribute__((ext_vector_type(2)));
            f32x2_ cw[10];
#pragma unroll
            for (int k = 0; k < 10; ++k) cw[k] = *(const LAS f32x2_*)(CWL + k * 128 + dA);
            f32x2_ xq[11], xk[11]; unsigned kprev = 0u;
#pragma unroll
            for (int k = 0; k < 11; ++k) { xq[k] = (f32x2_){__builtin_bit_cast(float, qraw[k] << 16), __builtin_bit_cast(float, qraw[k] & 0xffff0000u)}; xk[k] = (f32x2_){__builtin_bit_cast(float, kraw[k] << 16), __builtin_bit_cast(float, kraw[k] & 0xffff0000u)}; }
#pragma unroll
            for (int i = 0; i < 8; ++i) {
                f32x2_ yq = cw[8], yk = cw[9];
#pragma unroll
                for (int j = 0; j < 4; ++j) { yq += cw[j] * xq[i + j]; yk += cw[4 + j] * xk[i + j]; }
                f32x2_ tq = yq * -1.4426950408889634f, tk = yk * -1.4426950408889634f;
                f32x2_ eq = {__builtin_amdgcn_exp2f(tq[0]), __builtin_amdgcn_exp2f(tq[1])}, ek = {__builtin_amdgcn_exp2f(tk[0]), __builtin_amdgcn_exp2f(tk[1])};
                eq += 1.f; ek += 1.f;
                const f32x2_ rq = {__builtin_amdgcn_rcpf(eq[0]), __builtin_amdgcn_rcpf(eq[1])}, rk = {__builtin_amdgcn_rcpf(ek[0]), __builtin_amdgcn_rcpf(ek[1])};
                const f32x2_ sq2 = yq * rq, sk2 = (yk * 0.08838834764831845f) * rk;
                const int s = 8 * sg + i;
                *(LAS unsigned*)(QB + s * 136 + dA) = cvtpk(sq2[0], sq2[1]);
                const unsigned kpk = cvtpk(sk2[0], sk2[1]);
                *(LAS unsigned*)(KB + s * 136 + dA) = kpk;
                if (i & 1) {
                    kt0[i >> 1] = __builtin_amdgcn_perm(kpk, kprev, 0x05040100u); kt1[i >> 1] = __builtin_amdgcn_perm(kpk, kprev, 0x07060302u);
                    vt0[i >> 1] = __builtin_amdgcn_perm(vraw[i], vraw[i - 1], 0x05040100u); vt1[i >> 1] = __builtin_amdgcn_perm(vraw[i], vraw[i - 1], 0x07060302u); }
                kprev = kpk;
                __builtin_amdgcn_sched_barrier(0);
            }
            *(LAS v4u*)(KT + dA * 72 + 8 * sg) = (v4u){kt0[0], kt0[1], kt0[2], kt0[3]}; *(LAS v4u*)(KT + (dA + 1) * 72 + 8 * sg) = (v4u){kt1[0], kt1[1], kt1[2], kt1[3]};
            *(LAS v4u*)(VT + dA * 72 + 8 * sg) = (v4u){vt0[0], vt0[1], vt0[2], vt0[3]}; *(LAS v4u*)(VT + (dA + 1) * 72 + 8 * sg) = (v4u){vt1[0], vt1[1], vt1[2], vt1[3]};
        }
        if (wave == 0) {
            const float ig = bf2f(graw0) + ibias, fp = bf2f(graw1) + fbias;
            const float bsum = scan_sum(logsigmoidf_(fp));
            const float ibv = ig - bsum; const float pm = scan_max(ibv);
            const float mprev = ms[0];
            const float mtv = bsum + fmaxf(mprev, pm);
            const float bL = lane63(bsum), pmL = lane63(pm);
            const float mnew = bL + fmaxf(mprev, pmL);
            colf[lane] = __expf(ibv); rowf[lane] = __expf(bsum - mtv); wi[lane] = __expf(bsum + mprev - mtv); emt[lane] = __expf(-mtv); wkv[lane] = __expf(bL + ibv - mnew);
            if (lane == 0) { ms[1] = __expf(bL + mprev - mnew); ms[2] = mnew; }
        }
        if (c + 1 < SEQ / 64) { const bf16* zn = zb + (size_t)(t0 + 64) * ZW;
#pragma unroll
            for (int k = 0; k < 11; ++k) { const int t = 8 * sg - 3 + k;
                const bf16* rp = zn + (ptrdiff_t)t * ZW;
                qraw[k] = *(const GAS unsigned*)(rp + ZC_MQ + coff); kraw[k] = *(const GAS unsigned*)(rp + ZC_MK + coff); }
#pragma unroll
            for (int k = 0; k < 8; ++k) { const bf16* rp = zn + (size_t)(8 * sg + k) * ZW; vraw[k] = *(const GAS unsigned*)(rp + ZC_MV + coff); }
            if (wave == 0) { graw0 = zn[(size_t)lane * ZW + ZC_MI + hd]; graw1 = zn[(size_t)lane * ZW + ZC_MF + hd]; } }
        __syncthreads();
        unsigned long long mo4[4];
#pragma unroll
        for (int jj = 0; jj < 4; ++jj) mo4[jj] = *(const GAS unsigned long long*)(W.z + (row0 + 16 * jj + r) * ZW + ZC_MO + hd * 128 + 16 * wave + 4 * q4);
        { const int i = wave >> 1;
#pragma unroll
          for (int e = 0; e < 2; ++e) { const int jj = 2 * (wave & 1) + e; const int t = 16 * jj + r;
              f32x4 acc = {0.f, 0.f, 0.f, 0.f};
              if (i <= jj) { bf16x8 sa[4], sb[4];
#pragma unroll
                  for (int kk = 0; kk < 4; ++kk) { sa[kk] = *(const LAS bf16x8*)(KB + (16 * i + r) * 136 + 32 * kk + 8 * q4); sb[kk] = *(const LAS bf16x8*)(QB + t * 136 + 32 * kk + 8 * q4); }
                  __builtin_amdgcn_sched_barrier(0);
#pragma unroll
                  for (int kk = 0; kk < 4; ++kk) acc = __builtin_amdgcn_mfma_f32_16x16x32_bf16(sa[kk], sb[kk], acc, 0, 0, 0);
                  const f32x4 cf = *(const LAS f32x4*)(colf + 16 * i + 4 * q4); const float rf = rowf[t];
#pragma unroll
                  for (int g = 0; g < 4; ++g) acc[g] = (16 * i + 4 * q4 + g <= t) ? acc[g] * cf[g] * rf : 0.f;
              }
              *(LAS unsigned long long*)(PL + t * 72 + 16 * i + 4 * q4) = (unsigned long long)cvtpk(acc[0], acc[1]) | ((unsigned long long)cvtpk(acc[2], acc[3]) << 32); } }
        __syncthreads();
        f32x4 hout[4];
        {
            bf16x8 av[2];
#pragma unroll
            for (int ks = 0; ks < 2; ++ks) av[ks] = *(const LAS bf16x8*)(VT + (16 * wave + r) * 72 + 32 * ks + 8 * q4);
#pragma unroll
            for (int jj = 0; jj < 4; ++jj) { const int t = 16 * jj + r;
                f32x4 hi = {0.f, 0.f, 0.f, 0.f}, ha = {0.f, 0.f, 0.f, 0.f};
                unsigned long long qlo[4], qhi[4]; bf16x8 pw[2];
#pragma unroll
                for (int kk = 0; kk < 4; ++kk) { qlo[kk] = *(const LAS unsigned long long*)(QB + t * 136 + 32 * kk + 4 * q4); qhi[kk] = *(const LAS unsigned long long*)(QB + t * 136 + 32 * kk + 16 + 4 * q4); }
#pragma unroll
                for (int ks = 0; ks < 2; ++ks) pw[ks] = *(const LAS bf16x8*)(PL + t * 72 + 32 * ks + 8 * q4);
                __builtin_amdgcn_sched_barrier(0);
#pragma unroll
                for (int kk = 0; kk < 4; ++kk) {
                    const unsigned long long lo = qlo[kk], hi8 = qhi[kk];
                    v4u w; w.x = (unsigned)lo; w.y = (unsigned)(lo >> 32); w.z = (unsigned)hi8; w.w = (unsigned)(hi8 >> 32);
                    v4u cw4; cw4.x = cvtpk(cacc[2 * kk][0], cacc[2 * kk][1]); cw4.y = cvtpk(cacc[2 * kk][2], cacc[2 * kk][3]); cw4.z = cvtpk(cacc[2 * kk + 1][0], cacc[2 * kk + 1][1]); cw4.w = cvtpk(cacc[2 * kk + 1][2], cacc[2 * kk + 1][3]);
                    hi = __builtin_amdgcn_mfma_f32_16x16x32_bf16(__builtin_bit_cast(bf16x8, cw4), __builtin_bit_cast(bf16x8, w), hi, 0, 0, 0); }
#pragma unroll
                for (int ks = 0; ks < 2; ++ks) ha = __builtin_amdgcn_mfma_f32_16x16x32_bf16(av[ks], pw[ks], ha, 0, 0, 0);
                hout[jj] = hi * wi[t] + ha;
                float ss = (hout[jj][0] * hout[jj][0] + hout[jj][1] * hout[jj][1]) + (hout[jj][2] * hout[jj][2] + hout[jj][3] * hout[jj][3]);
                ss = q4_sum(ss);
                if (q4 == 0) ssp[wave * 64 + t] = ss; }
            { const int t = 8 * wave + (lane >> 3), p = lane & 7;
              float a = 0.f;
#pragma unroll
              for (int e = 0; e < 2; ++e) { const v4u w = *(const LAS v4u*)(QB + t * 136 + 16 * p + 8 * e); const f32x4 n0 = *(const LAS f32x4*)(nvec + 16 * p + 8 * e), n1 = *(const LAS f32x4*)(nvec + 16 * p + 8 * e + 4);
                  a += bf2f((bf16)(w.x & 0xffffu)) * n0[0] + bf2f((bf16)(w.x >> 16)) * n0[1] + bf2f((bf16)(w.y & 0xffffu)) * n0[2] + bf2f((bf16)(w.y >> 16)) * n0[3]
                     + bf2f((bf16)(w.z & 0xffffu)) * n1[0] + bf2f((bf16)(w.z >> 16)) * n1[1] + bf2f((bf16)(w.w & 0xffffu)) * n1[2] + bf2f((bf16)(w.w >> 16)) * n1[3]; }
              const v4u w = *(const LAS v4u*)(PL + t * 72 + 8 * p);
              float d = (bf2f((bf16)(w.x & 0xffffu)) + bf2f((bf16)(w.x >> 16))) + (bf2f((bf16)(w.y & 0xffffu)) + bf2f((bf16)(w.y >> 16))) + (bf2f((bf16)(w.z & 0xffffu)) + bf2f((bf16)(w.z >> 16))) + (bf2f((bf16)(w.w & 0xffffu)) + bf2f((bf16)(w.w >> 16)));
              float den = wi[t] * a + d;
              den += DPP_F(den, 0xB1); den += DPP_F(den, 0x4E); den += DPP_F(den, 0x141);
              if (p == 0) dinv[t] = 1.f / fmaxf(fabsf(den), emt[t]); }
        }
        __syncthreads();
        float sq[4][8], dv[4];
#pragma unroll
        for (int jj = 0; jj < 4; ++jj) {
#pragma unroll
            for (int w8 = 0; w8 < 8; ++w8) sq[jj][w8] = ssp[w8 * 64 + 16 * jj + r];
            dv[jj] = dinv[16 * jj + r]; }
        __builtin_amdgcn_sched_barrier(0);
#pragma unroll
        for (int jj = 0; jj < 4; ++jj) { const int t = 16 * jj + r;
            float tot = 0.f;
#pragma unroll
            for (int w8 = 0; w8 < 8; ++w8) tot += sq[jj][w8];
            const float iv = dv[jj]; const float rstd = iv * __builtin_amdgcn_rsqf(tot * iv * iv * (1.f / 128.f) + NORM_EPS);
            const unsigned long long mo = mo4[jj];
            const float o0 = hout[jj][0] * rstd * gain[0] * bf2f((bf16)(mo & 0xffffu)), o1 = hout[jj][1] * rstd * gain[1] * bf2f((bf16)((mo >> 16) & 0xffffu));
            const float o2 = hout[jj][2] * rstd * gain[2] * bf2f((bf16)((mo >> 32) & 0xffffu)), o3 = hout[jj][3] * rstd * gain[3] * bf2f((bf16)(mo >> 48));
            *(GAS unsigned long long*)(W.mix + (row0 + t) * 2048 + hd * 128 + 16 * wave + 4 * q4) = (unsigned long long)cvtpk(o0, o1) | ((unsigned long long)cvtpk(o2, o3) << 32); }
        {
            const float decay = ms[1];
            bf16x8 bv[2];
#pragma unroll
            for (int ks = 0; ks < 2; ++ks) { const v4u w = *(const LAS v4u*)(VT + (16 * wave + r) * 72 + 32 * ks + 8 * q4);
                const f32x4 k0 = *(const LAS f32x4*)(wkv + 32 * ks + 8 * q4), k1 = *(const LAS f32x4*)(wkv + 32 * ks + 8 * q4 + 4);
                v4u o; o.x = cvtpk(bf2f((bf16)(w.x & 0xffffu)) * k0[0], bf2f((bf16)(w.x >> 16)) * k0[1]); o.y = cvtpk(bf2f((bf16)(w.y & 0xffffu)) * k0[2], bf2f((bf16)(w.y >> 16)) * k0[3]);
                o.z = cvtpk(bf2f((bf16)(w.z & 0xffffu)) * k1[0], bf2f((bf16)(w.z >> 16)) * k1[1]); o.w = cvtpk(bf2f((bf16)(w.w & 0xffffu)) * k1[2], bf2f((bf16)(w.w >> 16)) * k1[3]);
                bv[ks] = __builtin_bit_cast(bf16x8, o); }
#define M2_KTF(i) (*(const LAS bf16x8*)(KT + (16 * ((i) >> 1) + r) * 72 + 32 * ((i) & 1) + 8 * q4))
            bf16x8 fa = M2_KTF(0), fb = M2_KTF(1);
            __builtin_amdgcn_sched_barrier(0);
#pragma unroll
            for (int i = 0; i < 16; ++i) { const int dt = i >> 1;
                bf16x8 fc = fb; if (i + 2 < 16) fc = M2_KTF(i + 2);
                if ((i & 1) == 0) cacc[dt] = cacc[dt] * decay;
                __builtin_amdgcn_sched_barrier(0);
                cacc[dt] = __builtin_amdgcn_mfma_f32_16x16x32_bf16(fa, bv[i & 1], cacc[dt], 0, 0, 0);
                __builtin_amdgcn_sched_barrier(0);
                fa = fb; fb = fc; }
#undef M2_KTF
            if (tid < 128) { float a = nreg * decay;
#pragma unroll
                for (int s8 = 0; s8 < 8; ++s8) { const v4u w = *(const LAS v4u*)(KT + tid * 72 + 8 * s8); const f32x4 k0 = *(const LAS f32x4*)(wkv + 8 * s8), k1 = *(const LAS f32x4*)(wkv + 8 * s8 + 4);
                    a += bf2f((bf16)(w.x & 0xffffu)) * k0[0] + bf2f((bf16)(w.x >> 16)) * k0[1] + bf2f((bf16)(w.y & 0xffffu)) * k0[2] + bf2f((bf16)(w.y >> 16)) * k0[3]
                       + bf2f((bf16)(w.z & 0xffffu)) * k1[0] + bf2f((bf16)(w.z >> 16)) * k1[1] + bf2f((bf16)(w.w & 0xffffu)) * k1[2] + bf2f((bf16)(w.w >> 16)) * k1[3]; }
                nreg = a; nvec[tid] = a; }
            if (tid == 0) ms[0] = ms[2];
        }
        __syncthreads();
    }
}

__device__ __forceinline__ void vt_tiles4(Frame& F, const WsPtrs& W, int tile0) {
    LAS bf16* T = (LAS bf16*)(F.lds + 90112);
    v4u ld[4][2];
#pragma unroll
    for (int q = 0; q < 4; ++q) { const int tile = tile0 + q * F.G;
        if (tile < 1024) { const int which = tile & 1, kvh = (tile >> 1) & 1, tb = (tile >> 2) & 31, b = tile >> 7;
            const int zc = (which ? ZC_VW : ZC_VS) + kvh * 128; const size_t r0 = (size_t)b * SEQ + tb * 64;
#pragma unroll
            for (int h = 0; h < 2; ++h) { const int e = F.tid + 512 * h, r = e >> 4, qd = e & 15; ld[q][h] = *(const GAS v4u*)(W.z + (r0 + r) * ZW + zc + 8 * qd); } } }
#pragma unroll
    for (int q = 0; q < 4; ++q) { const int tile = tile0 + q * F.G;
        if (tile < 1024) { const int which = tile & 1, kvh = (tile >> 1) & 1, tb = (tile >> 2) & 31, b = tile >> 7;
#pragma unroll
            for (int h = 0; h < 2; ++h) { const int e = F.tid + 512 * h, r = e >> 4, qd = e & 15; *(LAS v4u*)(T + r * 136 + 8 * qd) = ld[q][h]; }
            __syncthreads();
            bf16* dst = (which ? W.vtw : W.vts) + (size_t)(b * 2 + kvh) * 128 * SEQ + tb * 64;
            for (int e = F.tid; e < 128 * 8; e += 512) { const int d = e >> 3, u = e & 7, kb = 16 * (u >> 1) + 4 * (u & 1);
                unsigned w[4];
#pragma unroll
                for (int i = 0; i < 4; ++i) { const int k0 = kb + (i >> 1) * 8 + (i & 1) * 2; w[i] = (unsigned)T[k0 * 136 + d] | ((unsigned)T[(k0 + 1) * 136 + d] << 16); }
                v4u o; o.x = w[0]; o.y = w[1]; o.z = w[2]; o.w = w[3];
                *(GAS v4u*)(dst + (size_t)d * SEQ + 8 * u) = o; }
            __syncthreads(); } }
}
template <bool VT>
__device__ __forceinline__ void cmp_unit(Frame& F, const LayerPtrs& L, const WsPtrs& W, int u, int layer) {
    const int branch = u >> 7, rem = u & 127, bk = rem >> 3, b = bk >> 1, kvh = bk & 1, n0 = (rem & 7) * 16;
    LAS bf16* Hb = (LAS bf16*)(F.lds);
    int lane_ = F.lane; asm volatile("" : "+v"(lane_));
    const int lane = lane_, wave = F.wave, r = lane & 15, q4 = lane >> 4;
    const bf16* w1t = branch ? W.c1v : W.c1k; const bf16* w2t = branch ? W.c2v : W.c2k;
    const int zc = (branch ? ZC_VC : ZC_KC) + kvh * 128;
    const bf16* bp0 = w1t + (size_t)(32 * wave + r) * 128 + 8 * q4; const bf16* bp1 = bp0 + (size_t)16 * 128;
    f32x4 acc0 = {0.f, 0.f, 0.f, 0.f}, acc1 = {0.f, 0.f, 0.f, 0.f};
    bf16x8 fb[4][2][4];
    const GAS float* pb = (const GAS float*)(W.pbp + branch * 64 * 256 + 32 * wave + r);
    float pr[4][4], b0 = 0.f, b1 = 0.f;
#define CMP_LDB(s, l) do { _Pragma("unroll") for (int i = 0; i < 4; ++i) { fb[s][0][i] = *(const GAS bf16x8*)(bp0 + 32768 * (l) + 32 * i); fb[s][1][i] = *(const GAS bf16x8*)(bp1 + 32768 * (l) + 32 * i); } \
        pr[s][0] = pb[(2 * (l)) * 256]; pr[s][1] = pb[(2 * (l) + 1) * 256]; pr[s][2] = pb[(2 * (l)) * 256 + 16]; pr[s][3] = pb[(2 * (l) + 1) * 256 + 16]; } while (0)
    CMP_LDB(0, 0); CMP_LDB(1, 1); CMP_LDB(2, 2);
    LAS unsigned char* As = F.lds + 8448;
    { const int tid = wave * 64 + lane; v4u t[9];
#pragma unroll
      for (int j = 0; j < 9; ++j) { const int c = tid + 512 * j, rho = c >> 4; int row = 16 * n0 + rho; row = row < SEQ ? row : SEQ - 1;
          if (c < 272 * 16) t[j] = *(const GAS v4u*)(W.z + ((size_t)b * SEQ + row) * ZW + zc + 8 * (c & 15)); }
      if (VT) vt_tiles4(F, W, F.bid);
#pragma unroll
      for (int j = 0; j < 9; ++j) { const int c = tid + 512 * j, rho = c >> 4;
          if (c < 272 * 16) *(LAS v4u*)(As + ((rho & 15) * 18 + (rho >> 4)) * 272 + 16 * (c & 15)) = t[j]; } }
    __syncthreads();
    const LAS unsigned char* ar = As + r * 272 + q4 * 16;
#pragma unroll 1
    for (int l4 = 0; l4 < 32; l4 += 4) {
#pragma unroll
        for (int s = 0; s < 4; ++s) { const int l = l4 + s, lp = l + 3 < 32 ? l + 3 : 31;
            CMP_LDB((s + 3) & 3, lp);
            b0 += pr[s][0] + pr[s][1]; b1 += pr[s][2] + pr[s][3];
            bf16x8 fa[4];
#pragma unroll
            for (int i = 0; i < 4; ++i) fa[i] = *(const LAS bf16x8*)(ar + ((l & 15) * 18 + (l >> 4)) * 272 + 64 * i);
#pragma unroll
            for (int i = 0; i < 4; ++i) { acc0 = __builtin_amdgcn_mfma_f32_16x16x32_bf16(fa[i], fb[s][0][i], acc0, 0, 0, 0); acc1 = __builtin_amdgcn_mfma_f32_16x16x32_bf16(fa[i], fb[s][1][i], acc1, 0, 0, 0); } }
    }
#undef CMP_LDB
    bf16x8 w2f[8];
#pragma unroll
    for (int kk = 0; kk < 8; ++kk) w2f[kk] = *(const GAS bf16x8*)(w2t + (size_t)(16 * wave + r) * 256 + 32 * kk + 8 * q4);
    {
#pragma unroll
      for (int g = 0; g < 4; ++g) { Hb[(4 * q4 + g) * 264 + 32 * wave + r] = (bf16)(cvtpk(gelu_tanh(acc0[g] + b0), 0.f) & 0xffffu); Hb[(4 * q4 + g) * 264 + 32 * wave + 16 + r] = (bf16)(cvtpk(gelu_tanh(acc1[g] + b1), 0.f) & 0xffffu); } }
    __syncthreads();
    f32x4 o = {0.f, 0.f, 0.f, 0.f};
#pragma unroll
    for (int kk = 0; kk < 8; ++kk) { const bf16x8 a = *(const LAS bf16x8*)(Hb + r * 264 + 32 * kk + 8 * q4);
        o = __builtin_amdgcn_mfma_f32_16x16x32_bf16(a, w2f[kk], o, 0, 0, 0); }
    bf16* dst = (branch ? W.vcmpt : W.kcmp) + (size_t)bk * 128 * 128;
    const int d = 16 * wave + r;
#pragma unroll
    for (int g = 0; g < 4; ++g) { const int n = n0 + 4 * q4 + g; const bf16 ov = n < NCMP ? (bf16)(cvtpk(o[g], 0.f) & 0xffffu) : (bf16)0;
        if (branch) ((GAS bf16*)dst)[d * 128 + ((n & ~12) | ((n & 4) << 1) | ((n & 8) >> 1))] = ov; else ((GAS bf16*)dst)[n * 128 + d] = ov; }
    __syncthreads();
}

typedef float f32x16 __attribute__((ext_vector_type(16)));
struct NsaOff { unsigned base, x; __device__ __forceinline__ unsigned at(int s) const { return base + 32u * ((unsigned)s ^ x); } };
constexpr int N2_IMPW = 65536;
constexpr int N2_IMP = N2_IMPW + 33792;
constexpr int N2_SEL = N2_IMP + 8448;
#define N2_KOFF(buf) ((buf) * 32768)
#define N2_VOFF(buf) ((buf) * 32768 + 16384)
__device__ __forceinline__ float xhalf_max(float v) { auto rr = __builtin_amdgcn_permlane32_swap(__float_as_uint(v), __float_as_uint(v), false, false); return fmaxf(__uint_as_float(rr[0]), __uint_as_float(rr[1])); }
__device__ __forceinline__ float xhalf_sum(float v) { auto rr = __builtin_amdgcn_permlane32_swap(__float_as_uint(v), __float_as_uint(v), false, false); return __uint_as_float(rr[0]) + __uint_as_float(rr[1]); }
__device__ __forceinline__ float xhalf_other(float v) { return swap32_other(v); }
__device__ __forceinline__ void nsa2_stage(LAS unsigned char* lds, int kb, int vb, const bf16* kbase, int krs, const bf16* vtbase, int vrs, int wave, int lane) {
    asm volatile("" : "+v"(lane));
#pragma unroll
    for (int i = 0; i < 2; ++i) {
        const int p = wave * 2 + i;
        const int row = 4 * p + (lane >> 4), ch = (lane & 15) ^ (((row & 3) << 2) | ((row >> 2) & 3));
        __builtin_amdgcn_global_load_lds((const unsigned*)(kbase + (size_t)row * krs + 8 * ch), (LAS unsigned*)(lds + kb + p * 1024), 16, 0, 0);
        const int vrow = 8 * p + (lane >> 3), vc = (lane & 7) ^ ((vrow >> 1) & 7);
        __builtin_amdgcn_global_load_lds((const unsigned*)(vtbase + (size_t)vrow * vrs + 8 * vc), (LAS unsigned*)(lds + vb + p * 1024), 16, 0, 0);
    }
}
__device__ __forceinline__ void nsa2_qk(LAS unsigned char* lds, int kb, const bf16x8 (&Qf)[8], const NsaOff koff, f32x16 (&st)[2]) {
#pragma unroll
    for (int kt = 0; kt < 2; ++kt)
#pragma unroll
        for (int r = 0; r < 16; ++r) st[kt][r] = 0.f;
#define N2_KFRAG(i) (*(const LAS bf16x8*)(lds + kb + ((i) >> 3) * 8192 + koff.at((i) & 7)))
    bf16x8 fa = N2_KFRAG(0), fb = N2_KFRAG(1);
    __builtin_amdgcn_sched_barrier(0);
#pragma unroll
    for (int i = 0; i < 16; ++i) {
        bf16x8 fc = fb; if (i + 2 < 16) fc = N2_KFRAG(i + 2);
        __builtin_amdgcn_sched_barrier(0);
        st[i >> 3] = __builtin_amdgcn_mfma_f32_32x32x16_bf16(fa, Qf[i & 7], st[i >> 3], 0, 0, 0);
        __builtin_amdgcn_sched_barrier(0);
        fa = fb; fb = fc;
    }
#undef N2_KFRAG
}
__device__ __forceinline__ void nsa2_pv(LAS unsigned char* lds, int vb, const f32x16 (&st)[2], const NsaOff voff, f32x16 (&O)[4]) {
    bf16x8 pf[4];
#pragma unroll
    for (int ks = 0; ks < 4; ++ks) { const int kt = ks >> 1, b0 = (ks & 1) * 8;
        v4u w; w.x = cvtpk(st[kt][b0 + 0], st[kt][b0 + 1]); w.y = cvtpk(st[kt][b0 + 2], st[kt][b0 + 3]); w.z = cvtpk(st[kt][b0 + 4], st[kt][b0 + 5]); w.w = cvtpk(st[kt][b0 + 6], st[kt][b0 + 7]);
        pf[ks] = __builtin_bit_cast(bf16x8, w); }
#define N2_VFRAG(i) (*(const LAS bf16x8*)(lds + vb + ((i) >> 2) * 4096 + voff.at((i) & 3)))
    bf16x8 fa = N2_VFRAG(0), fb = N2_VFRAG(1);
    __builtin_amdgcn_sched_barrier(0);
#pragma unroll
    for (int i = 0; i < 16; ++i) {
        bf16x8 fc = fb; if (i + 2 < 16) fc = N2_VFRAG(i + 2);
        __builtin_amdgcn_sched_barrier(0);
        O[i >> 2] = __builtin_amdgcn_mfma_f32_32x32x16_bf16(fa, pf[i & 3], O[i >> 2], 0, 0, 0);
        __builtin_amdgcn_sched_barrier(0);
        fa = fb; fb = fc;
    }
#undef N2_VFRAG
}
template <bool FAST>
__device__ __forceinline__ void nsa2_sm(f32x16 (&st)[2], f32x16 (&O)[4], float& m2, float& l, int lo_k, int hi_k, int h) {
    constexpr float C = 0.08838834764831845f * 1.4426950408889634f;
    const bool full = lo_k < 0 && hi_k >= 63, off = hi_k < 0 || lo_k >= 63;
    const int mode = !FAST ? 2 : (__builtin_amdgcn_ballot_w64(!full) == 0ull ? 0 : (__builtin_amdgcn_ballot_w64(!(full || off)) == 0ull ? 1 : 2));
    const bool masked = mode == 2;
    float mx = -1e30f;
    if (mode == 1) {
#pragma unroll
        for (int kt = 0; kt < 2; ++kt)
#pragma unroll
            for (int r = 0; r < 16; ++r) { const float sv = full ? st[kt][r] : -1e30f; st[kt][r] = sv; mx = fmaxf(mx, sv); }
        mx *= C;
    } else if (masked) {
#pragma unroll
        for (int kt = 0; kt < 2; ++kt)
#pragma unroll
            for (int r = 0; r < 16; ++r) { const int kk = 32 * kt + (r & 3) + 8 * (r >> 2) + 4 * h; const bool valid = (kk > lo_k) && (kk <= hi_k);
                const float sv = valid ? st[kt][r] * C : -1e30f; st[kt][r] = sv; mx = fmaxf(mx, sv); }
    } else {
#pragma unroll
        for (int kt = 0; kt < 2; ++kt)
#pragma unroll
            for (int r = 0; r < 16; ++r) mx = fmaxf(mx, st[kt][r]);
        mx *= C;
    }
    mx = xhalf_max(mx);
    const bool resc = !FAST || __builtin_amdgcn_ballot_w64(mx > m2 + 11.5415603f) != 0ull;
    float mnew = m2, alpha = 1.f;
    if (resc) { mnew = fmaxf(m2, mx); alpha = __builtin_amdgcn_exp2f(m2 - mnew); m2 = mnew; }
    float ps = 0.f;
    if (mode == 1) {
        const float nms = -fmaxf(mnew, -1e28f);
#pragma unroll
        for (int kt = 0; kt < 2; ++kt)
#pragma unroll
            for (int r = 0; r < 16; ++r) { const float p = __builtin_amdgcn_exp2f(__builtin_fmaf(st[kt][r], C, nms)); st[kt][r] = p; ps += p; }
    } else if (masked) {
#pragma unroll
        for (int kt = 0; kt < 2; ++kt)
#pragma unroll
            for (int r = 0; r < 16; ++r) { const float p = st[kt][r] > -5e29f ? __builtin_amdgcn_exp2f(st[kt][r] - mnew) : 0.f; st[kt][r] = p; ps += p; }
    } else {
#pragma unroll
        for (int kt = 0; kt < 2; ++kt)
#pragma unroll
            for (int r = 0; r < 16; ++r) { const float p = __builtin_amdgcn_exp2f(__builtin_fmaf(st[kt][r], C, -mnew)); st[kt][r] = p; ps += p; }
    }
    l = l * alpha + ps;
    if (resc) {
#pragma unroll
        for (int db = 0; db < 4; ++db) O[db] = O[db] * alpha;
    }
}
template <bool FAST>
__device__ __forceinline__ void nsa2_flash(LAS unsigned char* lds, int buf, const bf16x8 (&Qf)[8], const NsaOff koff, const NsaOff voff, f32x16 (&O)[4], float& m2, float& l, int lo_k, int hi_k, int h) {
    f32x16 st[2];
    nsa2_qk(lds, N2_KOFF(buf), Qf, koff, st);
    nsa2_sm<FAST>(st, O, m2, l, lo_k, hi_k, h);
    nsa2_pv(lds, N2_VOFF(buf), st, voff, O);
}
__device__ __forceinline__ void nsa2_unit(Frame& F, const WsPtrs& W, int b, int kvh, int c, int pass) {
    LAS unsigned char* lds = F.lds;
    LAS float* IMPW = (LAS float*)(lds + N2_IMPW); LAS float* IMP = (LAS float*)(lds + N2_IMP); LAS unsigned* SEL = (LAS unsigned*)(lds + N2_SEL);
    int lane_ = F.lane; asm volatile("" : "+v"(lane_));
    const int lane = lane_, wave = F.wave, tid = wave * 64 + lane, g = wave >> 1, qh = wave & 1, q = lane & 31, h = lane >> 5, hq = kvh * 4 + g;
    const int rq = 32 * qh + q, t = c * 64 + rq; const size_t row = (size_t)b * SEQ + t;
    const int xr = ((q & 3) << 2) | ((q >> 2) & 3), xv = (q >> 1) & 7;
    const NsaOff koff = {(unsigned)(256 * q + 16 * ((h ^ xr) & 1)), (unsigned)(xr >> 1)}, voff = {(unsigned)(128 * q + 16 * ((h ^ xv) & 1)), (unsigned)(xv >> 1)};
    const bf16* kcb = W.kcmp + (size_t)(b * 2 + kvh) * 128 * 128; const bf16* vcb = W.vcmpt + (size_t)(b * 2 + kvh) * 128 * 128;
    nsa2_stage(lds, N2_KOFF(0), N2_VOFF(0), kcb, 128, vcb, 128, wave, lane);
    nsa2_stage(lds, N2_KOFF(1), N2_VOFF(1), kcb + 64 * 128, 128, vcb + 64, 128, wave, lane);
    bf16x8 Qf[8];
    { const bf16* qp = W.z + row * ZW + ZC_NQ + hq * 128 + 8 * h;
#pragma unroll
      for (int s = 0; s < 8; ++s) Qf[s] = *(const GAS bf16x8*)(qp + 16 * s); }
    const GAS bf16* zg_ = (const GAS bf16*)(W.z + row * ZW + ZC_NG + hq * 3);
    const float g0 = sigmoidf_(bf2f(zg_[0])), g1 = sigmoidf_(bf2f(zg_[1])), g2 = sigmoidf_(bf2f(zg_[2]));
    if (tid < 65) SEL[tid] = 0u;
    float* op = W.oacc + row * 1024 + hq * 128 + 4 * h;
    asm volatile("s_waitcnt vmcnt(0)" ::: "memory");
    __syncthreads();
    constexpr float C = 0.08838834764831845f * 1.4426950408889634f;
    f32x16 O[4];
    {
        const int lim = t >= 31 ? ((t - 31) >> 4) : -1;
        const int limc = lim < NCMP - 1 ? lim : NCMP - 1;
        float m2 = -1e30f, l = 0.f;
#pragma unroll
        for (int db = 0; db < 4; ++db)
#pragma unroll
            for (int r = 0; r < 16; ++r) O[db][r] = 0.f;
        nsa2_flash<false>(lds, 0, Qf, koff, voff, O, m2, l, -1, limc, h);
        nsa2_flash<false>(lds, 1, Qf, koff, voff, O, m2, l, -1, limc - 64, h);
        const float lt = xhalf_sum(l), inv = lt > 0.f ? 1.f / lt : 0.f, og = inv * g0;
#pragma unroll
        for (int db = 0; db < 4; ++db)
#pragma unroll
            for (int r4 = 0; r4 < 4; ++r4) *(GAS f32x4*)(op + 32 * db + 8 * r4) = (f32x4){O[db][4 * r4] * og, O[db][4 * r4 + 1] * og, O[db][4 * r4 + 2] * og, O[db][4 * r4 + 3] * og};
        LAS float* iw = IMPW + (wave * 32 + q) * 33 + h;
        float prev = 0.f;
#pragma unroll
        for (int blk = 0; blk < 2; ++blk) {
            f32x16 st[2];
            nsa2_qk(lds, N2_KOFF(blk), Qf, koff, st);
#pragma unroll
            for (int kt = 0; kt < 2; ++kt)
#pragma unroll
                for (int r4 = 0; r4 < 4; ++r4) {
                    float pv[4];
#pragma unroll
                    for (int i = 0; i < 4; ++i) { const int kk = 64 * blk + 32 * kt + 8 * r4 + 4 * h + i; pv[i] = kk <= limc ? __builtin_amdgcn_exp2f(st[kt][4 * r4 + i] * C - m2) * inv : 0.f; }
                    const float s4 = (pv[0] + pv[1]) + (pv[2] + pv[3]);
                    const float o = xhalf_other(pv[3]);
                    const float add = h ? o : prev; prev = o;
                    iw[2 * (8 * blk + 4 * kt + r4)] = s4 + add;
                }
        }
    }
    __syncthreads();
    const bf16* ksb = W.z + (size_t)b * SEQ * ZW + ZC_KS + kvh * 128; const bf16* vsb = W.vts + (size_t)(b * 2 + kvh) * 128 * SEQ;
    const bf16* kwb = W.z + (size_t)b * SEQ * ZW + ZC_KW + kvh * 128; const bf16* vwb = W.vtw + (size_t)(b * 2 + kvh) * 128 * SEQ;
    nsa2_stage(lds, N2_KOFF(0), N2_VOFF(0), ksb, ZW, vsb, SEQ, wave, lane);
    for (int e = tid; e < 64 * 32; e += 512) { const int q64 = e >> 5, j = e & 31; const int wq = (q64 >> 5), ql = q64 & 31;
        IMP[q64 * 33 + j] = ((IMPW[((0 + wq) * 32 + ql) * 33 + j] + IMPW[((2 + wq) * 32 + ql) * 33 + j]) + IMPW[((4 + wq) * 32 + ql) * 33 + j]) + IMPW[((6 + wq) * 32 + ql) * 33 + j]; }
    __syncthreads();
    for (int e = tid; e < 64 * 32; e += 512) { const int q64 = e >> 5, j = e & 31;
        float vv[32];
#pragma unroll
        for (int i = 0; i < 32; ++i) vv[i] = IMP[q64 * 33 + i];
        const float vjr = IMP[q64 * 33 + j];
        __builtin_amdgcn_sched_barrier(0);
        const float vj = (j == 0 || j == c || j == c - 1) ? 1e4f : (j > c ? -1.f : vjr);
        int rank = 0;
#pragma unroll
        for (int i = 0; i < 32; ++i) { const float vi = (i == 0 || i == c || i == c - 1) ? 1e4f : (i > c ? -1.f : vv[i]); rank += (vi > vj || (vi == vj && i < j)) ? 1 : 0; }
        if (j <= c && rank < TOPK) { __hip_atomic_fetch_or(&SEL[q64], 1u << j, __ATOMIC_RELAXED, __HIP_MEMORY_SCOPE_WORKGROUP); __hip_atomic_fetch_or(&SEL[64], 1u << j, __ATOMIC_RELAXED, __HIP_MEMORY_SCOPE_WORKGROUP); } }
    __syncthreads();
    const unsigned mysel = SEL[rq];
    const unsigned anysel = __builtin_amdgcn_readfirstlane(SEL[64]);
    const int j0w = c > 8 ? c - 8 : 0, nsl = __builtin_popcount(anysel), nit = nsl + (c - j0w + 1);
    unsigned rem = anysel & ~1u;
    float m2 = -1e30f, l = 0.f;
#pragma unroll
    for (int db = 0; db < 4; ++db)
#pragma unroll
        for (int r = 0; r < 16; ++r) O[db][r] = 0.f;
    int jcur = 0;
    const bool early = wave < 4;
    f32x16 st[2];
    int p_lo = -1, p_hi = 63, p_vb = N2_VOFF(0), vsl = 0; bool p_any = false;
    for (int it = 0; it <= nit; ++it) {
        const int kb = (it & 1) * 32768, vb = vsl == 0 ? 16384 : (vsl == 1 ? 49152 : 65536);
        const int vsn = vsl == 2 ? 0 : vsl + 1, vbn = vsn == 0 ? 16384 : (vsn == 1 ? 49152 : 65536);
        const bool is_sel = it < nsl;
        int jn = 0; const int itn = it + 1;
        if (itn < nit) {
            if (itn < nsl) { jn = __builtin_ctz(rem); rem &= rem - 1u; nsa2_stage(lds, (itn & 1) * 32768, vbn, ksb + (size_t)jn * 64 * ZW, ZW, vsb + jn * 64, SEQ, wave, lane); }
            else { jn = j0w + (itn - nsl); nsa2_stage(lds, (itn & 1) * 32768, vbn, kwb + (size_t)jn * 64 * ZW, ZW, vwb + jn * 64, SEQ, wave, lane); }
        }
        const int j = jcur;
        int lo_k = -1, hi_k = 63; bool lane_on = it < nit;
        if (j == c) hi_k = rq;
        if (is_sel) lane_on = (mysel >> j) & 1u; else if (j == c - 8) lo_k = rq;
        if (!lane_on) hi_k = -1;
        const bool any = it < nit && __builtin_amdgcn_ballot_w64(lane_on) != 0ull;
        if (it > 0 && p_any) { if (!early) nsa2_sm<true>(st, O, m2, l, p_lo, p_hi, h); nsa2_pv(lds, p_vb, st, voff, O); }
        const int e = it - 1;
        if (e >= 0 && (e == nsl - 1 || e == nit - 1)) {
            const float lt = xhalf_sum(l); const float sc = (e == nsl - 1 ? g1 : g2) / lt;
            if (e == nsl - 1) {
#pragma unroll
                for (int hb = 0; hb < 4; ++hb) { f32x4 tv[4];
#pragma unroll
                    for (int q8 = 0; q8 < 4; ++q8) tv[q8] = *(const GAS f32x4*)(op + 32 * hb + 8 * q8);
                    __builtin_amdgcn_sched_barrier(0);
#pragma unroll
                    for (int q8 = 0; q8 < 4; ++q8) { const int db = hb, r4 = q8; f32x4 v = tv[q8];
                        v.x += O[db][4 * r4] * sc; v.y += O[db][4 * r4 + 1] * sc; v.z += O[db][4 * r4 + 2] * sc; v.w += O[db][4 * r4 + 3] * sc; *(GAS f32x4*)(op + 32 * db + 8 * r4) = v; }
                    __builtin_amdgcn_sched_barrier(0); }
                m2 = -1e30f; l = 0.f;
#pragma unroll
                for (int db = 0; db < 4; ++db)
#pragma unroll
                    for (int r = 0; r < 16; ++r) O[db][r] = 0.f;
            } else {
                float ss = 0.f; bf16* mp = W.mix + row * 2048 + 1024 + hq * 128 + 4 * h;
#pragma unroll
                for (int hb = 0; hb < 4; ++hb) { f32x4 tv[4];
#pragma unroll
                    for (int q8 = 0; q8 < 4; ++q8) tv[q8] = *(const GAS f32x4*)(op + 32 * hb + 8 * q8);
                    __builtin_amdgcn_sched_barrier(0);
#pragma unroll
                    for (int q8 = 0; q8 < 4; ++q8) { const int db = hb, r4 = q8; const f32x4 v = tv[q8];
                        const float a0 = v.x + O[db][4 * r4] * sc, a1 = v.y + O[db][4 * r4 + 1] * sc, a2 = v.z + O[db][4 * r4 + 2] * sc, a3 = v.w + O[db][4 * r4 + 3] * sc;
                        ss += (a0 * a0 + a1 * a1) + (a2 * a2 + a3 * a3);
                        *(GAS unsigned long long*)(mp + 32 * db + 8 * r4) = (unsigned long long)pk2(a0, a1) | ((unsigned long long)pk2(a2, a3) << 32); }
                    __builtin_amdgcn_sched_barrier(0); }
                ss = xhalf_sum(ss);
                if (h == 0) W.ssq[(size_t)hq * M + row] = ss;
            }
        }
        if (any) { nsa2_qk(lds, kb, Qf, koff, st); if (early) nsa2_sm<true>(st, O, m2, l, lo_k, hi_k, h); }
        p_lo = lo_k; p_hi = hi_k; p_any = any; p_vb = vb; vsl = vsn;
        jcur = jn;
        asm volatile("s_waitcnt vmcnt(0)" ::: "memory");
        __syncthreads();
    }
}

__device__ __forceinline__ void ph_vt(Frame& F, const WsPtrs& W) {
    LAS bf16* T = (LAS bf16*)F.lds;
    for (int tile = F.bid; tile < 1024; tile += F.G) {
        const int which = tile & 1, kvh = (tile >> 1) & 1, tb = (tile >> 2) & 31, b = tile >> 7;
        const int zc = (which ? ZC_VW : ZC_VS) + kvh * 128; const size_t r0 = (size_t)b * SEQ + tb * 64;
        for (int e = F.tid; e < 64 * 16; e += 512) { const int r = e >> 4, qd = e & 15; *(LAS v4u*)(T + r * 136 + 8 * qd) = *(const GAS v4u*)(W.z + (r0 + r) * ZW + zc + 8 * qd); }
        __syncthreads();
        bf16* dst = (which ? W.vtw : W.vts) + (size_t)(b * 2 + kvh) * 128 * SEQ + tb * 64;
        for (int e = F.tid; e < 128 * 8; e += 512) { const int d = e >> 3, u = e & 7, kb = 16 * (u >> 1) + 4 * (u & 1);
            unsigned w[4];
#pragma unroll
            for (int i = 0; i < 4; ++i) { const int k0 = kb + (i >> 1) * 8 + (i & 1) * 2; w[i] = (unsigned)T[k0 * 136 + d] | ((unsigned)T[(k0 + 1) * 136 + d] << 16); }
            v4u o; o.x = w[0]; o.y = w[1]; o.z = w[2]; o.w = w[3];
            *(GAS v4u*)(dst + (size_t)d * SEQ + 8 * u) = o; }
        __syncthreads();
    }
}

__device__ __forceinline__ void ph_nsa_norm(Frame& F, const LayerPtrs& L, const WsPtrs& W) {
    const size_t total = (size_t)M * 128;
    for (size_t i = (size_t)F.bid * 512 + F.tid; i < total; i += (size_t)F.G * 512) {
        const int m = (int)(i >> 7), q = (int)(i & 127);
        float sq = 0.f;
#pragma unroll
        for (int hh = 0; hh < 8; ++hh) sq += W.ssq[(size_t)hh * M + m];
        const float rstd = 1.f / sqrtf(sq * (1.f / 1024.f) + NORM_EPS);
        GAS v4u* p = (GAS v4u*)(W.mix + (size_t)m * 2048 + 1024 + 8 * q); v4u v = *p; const float* gn = L.nsa_norm + 8 * q;
        unsigned w[4] = {v.x, v.y, v.z, v.w};
#pragma unroll
        for (int k = 0; k < 4; ++k) { const float lo = bf2f((bf16)(w[k] & 0xffffu)) * rstd * gn[2 * k], hi = bf2f((bf16)(w[k] >> 16)) * rstd * gn[2 * k + 1]; w[k] = pk2(lo, hi); }
        v.x = w[0]; v.y = w[1]; v.z = w[2]; v.w = w[3]; *p = v;
    }
}
__device__ __forceinline__ void ph_ffn_gate(Frame& F, const LayerPtrs& L, const WsPtrs& W) {
    constexpr int FG = D_FF / 8, NITEM = FG * (M / 64);
    for (int it = F.bid * 512 + F.tid; it < NITEM; it += F.G * 512) {
        const int blk = it / FG, q = it - blk * FG, f0 = 8 * q; const bool first = (blk & (SEQ / 64 - 1)) == 0;
        const bf16* e0 = W.u + (size_t)blk * 4 * (2 * D_FF) + f0; const bf16* ep = e0 - 4 * (2 * D_FF);
        v4u r[2][4];
#pragma unroll
        for (int s = 0; s < 2; ++s) { r[s][2] = *(const GAS v4u*)(e0 + s * D_FF); r[s][3] = *(const GAS v4u*)(e0 + (2 * D_FF) + s * D_FF);
            if (first) { r[s][0] = (v4u){0u, 0u, 0u, 0u}; r[s][1] = r[s][0]; } else { r[s][0] = *(const GAS v4u*)(ep + 2 * (2 * D_FF) + s * D_FF); r[s][1] = *(const GAS v4u*)(ep + 3 * (2 * D_FF) + s * D_FF); } }
        float wg[3][8], wu[3][8], bg[8], bu[8];
#pragma unroll
        for (int j = 0; j < 3; ++j) { const GAS f32x4* p = (const GAS f32x4*)(L.ffn_conv_w + (size_t)j * (2 * D_FF) + f0); const GAS f32x4* pu = (const GAS f32x4*)(L.ffn_conv_w + (size_t)j * (2 * D_FF) + D_FF + f0);
            const f32x4 a0 = p[0], a1 = p[1], c0 = pu[0], c1 = pu[1];
#pragma unroll
            for (int i = 0; i < 4; ++i) { wg[j][i] = a0[i]; wg[j][4 + i] = a1[i]; wu[j][i] = c0[i]; wu[j][4 + i] = c1[i]; } }
        { const GAS f32x4* p = (const GAS f32x4*)(L.ffn_conv_b + f0); const GAS f32x4* pu = (const GAS f32x4*)(L.ffn_conv_b + D_FF + f0); const f32x4 a0 = p[0], a1 = p[1], c0 = pu[0], c1 = pu[1];
#pragma unroll
          for (int i = 0; i < 4; ++i) { bg[i] = a0[i]; bg[4 + i] = a1[i]; bu[i] = c0[i]; bu[4 + i] = c1[i]; } }
#pragma unroll
        for (int e = 0; e < 2; ++e) {
            float yy[8];
#pragma unroll
            for (int k2 = 0; k2 < 4; ++k2) { float y[2];
#pragma unroll
                for (int hh = 0; hh < 2; ++hh) { const int i = 2 * k2 + hh;
                    const unsigned g2 = ((const unsigned*)&r[0][e])[k2], g1 = ((const unsigned*)&r[0][e + 1])[k2], gc = ((const unsigned*)&r[0][e + 2])[k2];
                    const unsigned u2 = ((const unsigned*)&r[1][e])[k2], u1 = ((const unsigned*)&r[1][e + 1])[k2], uc = ((const unsigned*)&r[1][e + 2])[k2];
                    const float ga = bg[i] + wg[0][i] * bf2f((bf16)(hh ? g2 >> 16 : g2 & 0xffffu)) + wg[1][i] * bf2f((bf16)(hh ? g1 >> 16 : g1 & 0xffffu)) + wg[2][i] * bf2f((bf16)(hh ? gc >> 16 : gc & 0xffffu));
                    const float ua = bu[i] + wu[0][i] * bf2f((bf16)(hh ? u2 >> 16 : u2 & 0xffffu)) + wu[1][i] * bf2f((bf16)(hh ? u1 >> 16 : u1 & 0xffffu)) + wu[2][i] * bf2f((bf16)(hh ? uc >> 16 : uc & 0xffffu));
                    y[hh] = siluf_(ga) * ua; }
                yy[2 * k2] = y[0] * pg8::F8_GS; yy[2 * k2 + 1] = y[1] * pg8::F8_GS; }
            *(GAS unsigned long long*)((unsigned char*)W.g + ((size_t)blk * 64 + e) * D_FF + f0) = (unsigned long long)pg8::pk4_fp8(yy[0], yy[1], yy[2], yy[3]) | ((unsigned long long)pg8::pk4_fp8(yy[4], yy[5], yy[6], yy[7]) << 32);
        }
    }
}


__device__ __forceinline__ void call_prologue(Frame& F, int layer) {
    const LayerPtrs L = make_L(F, layer); const WsPtrs W = make_W(F, layer); ph_prologue(F, L, W, layer == 0 ? inptr(F, 0) : (const float*)F.out, layer);
}
__device__ __forceinline__ void call_mix1(Frame& F, int layer) {
    const LayerPtrs L = make_L(F, layer); const WsPtrs W = make_W(F, layer);
    if (F.bid < 256) cmp_unit<true>(F, L, W, F.bid, layer); else vt_tiles4(F, W, F.bid);
    for (int t0 = F.bid + 4 * F.G; t0 < 1024; t0 += 4 * F.G) vt_tiles4(F, W, t0);
    for (int u = F.bid + F.G; u < 256; u += F.G) cmp_unit<false>(F, L, W, u, layer);
}
constexpr int I_UP = (D_MODEL / 64) * (2 * D_FF / 64), I_DN = (D_FF / 64) * (D_MODEL / 64), NCONV = (I_UP + I_DN) / 8;
static_assert((I_UP + I_DN) % 8 == 0, "conversion items");
constexpr int CW_QUEUE = 8192;
__device__ __forceinline__ void call_nsa(Frame& F, int layer, int pass) {
    const WsPtrs W = make_W(F, layer);
    if (F.bid < 64) { const LayerPtrs L = make_L(F, layer); for (int rep = 0; rep < (PROBE_DUP == 41 ? 2 : 1); ++rep) for (int u = F.bid; u < 64; u += (F.G < 64 ? F.G : 64)) mlstm2_unit(F, L, W, u >> 3, u & 7); }
    unsigned* head = (unsigned*)(F.ws + WS_CTL) + CW_QUEUE + 64 * layer + 256 * (1 - pass);
    unsigned* hq = (unsigned*)(F.ws + WS_CTL) + CW_QUEUE + 1024 + 256 * layer;
    const int xs = (int)(xb_xcc_id() & 7u);
    LAS int* slot = (LAS int*)(F.lds + MISC_OFF + 64);
    int kq = pass == 1 ? 0 : 8;
    for (;;) {
        unsigned* hp = kq < 8 ? hq + 32 * ((xs + kq) & 7) : head;
        __syncthreads();
        if (F.tid == 0) *slot = (int)__hip_atomic_fetch_add(hp, 1u, __ATOMIC_RELAXED, __HIP_MEMORY_SCOPE_AGENT);
        __syncthreads();
        int u = *slot;
        if (kq < 8) {
            if (u >= 64) { ++kq; continue; }
            nsa2_unit(F, W, (xs + kq) & 7, u & 1, 31 - (u >> 1), 1);
            continue;
        }
        u += 512;
        if (u >= 512 + NCONV + (layer + 1 < DEPTH ? NSMALL / 8 : 0)) break;
        if (u >= 512 + NCONV) { const LayerPtrs L1 = make_L(F, layer + 1); const WsPtrs W1 = make_W(F, layer + 1); small_item(F, L1, W1, (u - 512 - NCONV) * 8 + F.wave, true); continue; }
        {
            const int wt = (u - 512) * 8 + F.wave;
            if (wt < I_UP) transpose_item<2>(inptr(F, 17) + (size_t)layer * D_MODEL * 2 * D_FF, D_MODEL, 2 * D_FF, 2 * D_FF, W.wup, wt, F.lane, inptr(F, 16) + (size_t)layer * D_MODEL);
            else transpose_item<3>(inptr(F, 20) + (size_t)layer * D_FF * D_MODEL, D_FF, D_MODEL, D_MODEL, W.wdn, wt - I_UP, F.lane);
        }
    }
}

struct Args { const float* in[22]; float* out; unsigned char* ws; int ph_lo, ph_hi, pad0, pad1; };
__global__ void __launch_bounds__(NWAVES * 64, 2) hymba_fwd(Args args) {
    extern __shared__ __attribute__((aligned(16))) unsigned char lds[];
    Frame F;
    F.lds = (LAS unsigned char*)lds;
    F.MISC = (volatile LAS unsigned*)(F.lds + MISC_OFF);
    F.tid = threadIdx.x; F.lane = F.tid & 63; F.wave = __builtin_amdgcn_readfirstlane(F.tid >> 6);
    F.G = gridDim.x; F.bid = blockIdx.x;
    unsigned char* ws = args.ws;
    F.ws = args.ws; F.out = args.out;
    F.ctl = (gu32*)(ws + WS_CTL);
    for (int u = F.tid; u < (LDS_BYTES - LDSCTL_OFF) / 4; u += NWAVES * 64) ((LAS unsigned*)(F.lds + LDSCTL_OFF))[u] = 0u;
    __syncthreads();
    if (F.tid < 22) ((LAS unsigned long long*)(F.lds + PT_OFF))[F.tid] = (unsigned long long)args.in[F.tid];
    __syncthreads();
    if (!MK_PER_PHASE) (void)xcd_barrier_post((unsigned*)(F.ctl + CW_BAR), F.MISC + 8);
#define GRID_BAR() do { if (MK_PER_PHASE) { if (F.tid == 0) __hip_atomic_store(F.ctl + 0, 0xBADBA0u, RLX_AGENT); } else { const WsPtrs Wb_ = make_W(F); unsigned st_ = (unsigned)(__UINTPTR_TYPE__)(F.lds + MISC_OFF + 32); asm volatile("" : "+s"(st_)); xcd_barrier_fn((unsigned*)Wb_.ropec - (WS_ROPE - WS_CTL) / 4 + CW_BAR, st_, (int)(F.tid == 0)); } } while (0)
    const int lo = args.ph_lo, hi = args.ph_hi;
#ifndef PH_MASK
#define PH_MASK 0xFFFFFF
#endif
#define PH_EN(k) ((PH_MASK >> (k)) & 1)
#define IN(k) (lo <= (k) && (k) < hi)
#define xcd_barrier_dummy() do { } while (0)
#define SEAM(k) do { if (IN((k) + 1)) GRID_BAR(); } while (0)
#define PHASE_FRAME(Fp) Frame Fp = F; { int l_ = (int)__builtin_amdgcn_mbcnt_hi(~0u, __builtin_amdgcn_mbcnt_lo(~0u, 0u)); asm volatile("" : "+v"(l_)); Fp.lane = l_; Fp.tid = F.wave * 64 + l_; int b_ = F.bid, g_ = F.G; asm volatile("" : "+s"(b_), "+s"(g_)); Fp.bid = b_; Fp.G = g_; }
#define LAYER_BODY(layer) { \
        const int pb = layer * PH_PER_LAYER; \
        if (layer == 0 && PH_EN(0) && IN(pb + 0)) { PHASE_FRAME(Fp); call_prologue(Fp, layer); if (PROBE_DUP == 0) { PHASE_FRAME(Fq); call_prologue(Fq, layer); } SEAM(pb + 0); } \
        if (PH_EN(1) && IN(pb + 1)) { \
            const WsPtrs W = make_W(F, layer); \
            pg8::Gemm g{layer == 0 ? W.xn : W.xr, W.win, M, ZW, D_MODEL}; pg8::StaticOrder S; S.init(M, ZW, F.G, F.bid); \
            pg8::EpiBf16<0, true> E{W.z, ZW, nullptr, 0, 0, 1.f, pg8::RowScale{layer == 0 ? (const float*)nullptr : (const float*)W.ssqp, 1.f / D_MODEL, NORM_EPS}, W.ropec, W.ropes, 0x15F0000u, SEQ - 1, 0xF000u}; \
            pg8::gemm_phase<pg8::EpiBf16<0, true>, pg8::StaticOrder, PG8_ALIGN, PG8_SP2>(F.lds + RING_OFF, g, S, E, F.wave); \
            if (PROBE_DUP == 1) pg8::gemm_phase<pg8::EpiBf16<0, true>, pg8::StaticOrder, PG8_ALIGN, PG8_SP2>(F.lds + RING_OFF, g, S, E, F.wave); \
            SEAM(pb + 1); \
        } \
        if (PH_EN(2) && IN(pb + 2)) { PHASE_FRAME(Fp); call_mix1(Fp, layer); SEAM(pb + 2); } \
        if (PH_EN(4) && IN(pb + 4)) { for (int pass_ = (PROBE_DUP == 4 ? 0 : 1); pass_ < 2; ++pass_) { PHASE_FRAME(Fp); call_nsa(Fp, layer, pass_); } SEAM(pb + 4); } \
        if (PH_EN(6) && IN(pb + 6)) { \
            const WsPtrs W = make_W(F, layer); \
            pg8::Gemm g{W.mix, W.wout, M, D_MODEL, D_MODEL}; pg8::StaticOrder S; S.init(M, D_MODEL, F.G, F.bid); \
            if (layer == 0) { pg8::EpiRes<true> E{W.xr, (const void*)inptr(F, 0), D_MODEL, W.ssqp, 1.f, W.ssq, M}; pg8::gemm_phase<pg8::EpiRes<true>, pg8::StaticOrder, PG8_ALIGN, PG8_SP2, false, true>(F.lds + RING_OFF, g, S, E, F.wave); } \
            else { pg8::EpiRes<false> E{W.xr, (const void*)W.xr, D_MODEL, W.ssqp, 1.f, W.ssq, M}; pg8::gemm_phase<pg8::EpiRes<false>, pg8::StaticOrder, PG8_ALIGN, PG8_SP2, false, true>(F.lds + RING_OFF, g, S, E, F.wave); } \
            SEAM(pb + 6); \
        } \
        if (PH_EN(8) && IN(pb + 8)) { \
            const WsPtrs W = make_W(F, layer); \
            pg8::Gemm g{W.xr, W.wup, M, 2 * D_FF, D_MODEL}; pg8::StaticOrder S; S.init(M, 2 * D_FF, F.G, F.bid); \
            pg8::EpiGate E{pg8::RowScale{W.ssqp, 1.f / D_MODEL, NORM_EPS}, W.g, D_FF, inptr(F, 18) + (size_t)layer * 3 * 2 * D_FF, inptr(F, 19) + (size_t)layer * 2 * D_FF, D_FF, W.u}; \
            pg8::gemm_phase<pg8::EpiGate, pg8::StaticOrder, PG8_ALIGN, PG8_SP2>(F.lds + RING_OFF, g, S, E, F.wave); \
            SEAM(pb + 8); \
        } \
        if (PH_EN(9) && IN(pb + 9)) { PHASE_FRAME(Fp); const LayerPtrs L = make_L(Fp, layer); const WsPtrs W = make_W(Fp, layer); ph_ffn_gate(Fp, L, W); SEAM(pb + 9); } \
        if (PH_EN(10) && IN(pb + 10)) { \
            const WsPtrs W = make_W(F, layer); \
            pg8::Gemm g{W.g, W.wdn, M, D_MODEL, D_FF / 2}; pg8::StaticOrder S; S.init(M, D_MODEL, F.G, F.bid);     \
            pg8::EpiRes<false, true> E{W.xr, (const void*)W.xr, D_MODEL, W.ssqp, 1.f / (pg8::F8_GS * pg8::F8_WS)}; \
            pg8::gemm_phase<pg8::EpiRes<false, true>, pg8::StaticOrder, PG8_ALIGN, PG8_SP2, true>(F.lds + RING_OFF, g, S, E, F.wave); \
            SEAM(pb + 10); \
        } \
     \
    }
    LAYER_BODY(0)
    LAYER_BODY(1)
#undef LAYER_BODY
    if (IN(DEPTH * PH_PER_LAYER)) {
        PHASE_FRAME(Fp); const float* gain = inptr(Fp, 21);
        const int gw = Fp.bid * NWAVES + Fp.wave, NGW = Fp.G * NWAVES;
        const WsPtrs Wf = make_W(Fp, 0);
        for (int m = gw; m < M; m += NGW) rms_brow_to_f32(Wf.xr + (size_t)m * D_MODEL, gain, Fp.out + (size_t)m * D_MODEL, Fp.lane);
    }
#undef IN
#undef SEAM
}

extern "C" void kernel_launch(void* const* d_in, const int* in_sizes, int n_in, void* d_out, int out_size, void* d_ws, size_t ws_size, hipStream_t stream) {
    static int grid = 0;
    if (grid == 0) {
        if (n_in != 22 || in_sizes[0] != M * D_MODEL || out_size != M * D_MODEL || ws_size < WS_END) { fprintf(stderr, "kernel_launch: unexpected shapes (n_in %d, in0 %d, out %d, ws %zu < %zu); nothing launched\n", n_in, n_in > 0 ? in_sizes[0] : -1, out_size, ws_size, (size_t)WS_END); grid = -1; return; }
        int dev = 0, cus = 0, per_cu = 0;
        if (hipGetDevice(&dev) != hipSuccess || hipDeviceGetAttribute(&cus, hipDeviceAttributeMultiprocessorCount, dev) != hipSuccess) { fprintf(stderr, "kernel_launch: device query failed\n"); grid = -1; return; }
        if (hipFuncSetAttribute((const void*)hymba_fwd, hipFuncAttributeMaxDynamicSharedMemorySize, LDS_BYTES) != hipSuccess) { fprintf(stderr, "kernel_launch: hipFuncSetAttribute failed\n"); grid = -1; return; }
        if (hipOccupancyMaxActiveBlocksPerMultiprocessor(&per_cu, (const void*)hymba_fwd, NWAVES * 64, LDS_BYTES) != hipSuccess || per_cu < 1)
            fprintf(stderr, "kernel_launch: note: occupancy query reports %d workgroups per CU\n", per_cu);
        (void)hipGetLastError();
        grid = cus;
    }
    if (grid < 0) return;
    if (hipMemsetAsync((char*)d_ws + WS_CTL, 0, CTL_ZERO_BYTES, stream) != hipSuccess) { fprintf(stderr, "kernel_launch: memset failed\n"); return; }
    Args a{};
    for (int i = 0; i < 22; ++i) a.in[i] = (const float*)d_in[i];
    a.out = (float*)d_out; a.ws = (unsigned char*)d_ws; a.pad0 = 0; a.pad1 = 0;
#if MK_PER_PHASE
    for (int p = 0; p < N_PHASES; ++p) { a.ph_lo = p; a.ph_hi = p + 1; hipLaunchKernelGGL(hymba_fwd, dim3(grid), dim3(NWAVES * 64), LDS_BYTES, stream, a); }
#else
    a.ph_lo = 0; a.ph_hi = N_PHASES; hipLaunchKernelGGL(hymba_fwd, dim3(grid), dim3(NWAVES * 64), LDS_BYTES, stream, a);
#endif
    const hipError_t le = hipPeekAtLastError();
    if (le != hipSuccess) fprintf(stderr, "kernel_launch: launch failed: %s\n", hipGetErrorName(le));
}
```
